# Optimizing an MI355X kernel written in HIP

```python
import jax, jax.numpy as jnp
from jax import lax
import numpy as np

D_MODEL = 2048
BATCH = 1
SEQ = 8192
DEPTH = 4

BRANCH_WIDTH = D_MODEL // 2
N_BRANCH = 3
MLA_NOPE = 128
MLA_ROPE = 64
MLA_V = 128
MLA_HEADS = BRANCH_WIDTH // MLA_V
MLA_Q_RANK = 512
MLA_KV_RANK = 512
ROPE_THETA = 10000.0
GLA_HEADS = 4
GLA_DV = BRANCH_WIDTH // GLA_HEADS
GLA_DK = GLA_DV // 2
GLA_GATE_RANK = 16
GLA_TAU = 16.0
GLA_CHUNK = 64
FOX_DH = 128
FOX_HEADS = BRANCH_WIDTH // FOX_DH
FORGET_BIAS_INIT = 3.0
FFN_HIDDEN = ((8 * D_MODEL + 3 * 256 - 1) // (3 * 256)) * 256
Q_BLOCK = 128
EPS = 1e-6
NEG_INF = -1e30

SPLIT_SIZES = (
    MLA_Q_RANK,
    MLA_KV_RANK,
    MLA_ROPE,
    GLA_HEADS * GLA_DK,
    GLA_HEADS * GLA_DK,
    GLA_HEADS * GLA_DV,
    GLA_GATE_RANK,
    GLA_HEADS * GLA_DV,
    FOX_HEADS * FOX_DH,
    FOX_HEADS * FOX_DH,
    FOX_HEADS * FOX_DH,
    FOX_HEADS,
    N_BRANCH * D_MODEL,
)
D_IN = sum(SPLIT_SIZES)
SPLIT_IDX = tuple(int(v) for v in np.cumsum(SPLIT_SIZES)[:-1])

kernel_name = "hybrid_mla_gla_fox_gated_block"


def rms_norm(x, g):
    xf = x.astype(jnp.float32)
    y = xf * lax.rsqrt(jnp.mean(xf * xf, axis=-1, keepdims=True) + EPS)
    return (y * g.astype(jnp.float32)).astype(x.dtype)


def rope(x, pos):
    half = x.shape[-1] // 2
    inv = ROPE_THETA ** (-jnp.arange(half, dtype=jnp.float32) / half)
    ang = pos.astype(jnp.float32)[:, :, None] * inv
    cos = jnp.cos(ang)[:, :, None, :]
    sin = jnp.sin(ang)[:, :, None, :]
    x1 = x[..., :half].astype(jnp.float32)
    x2 = x[..., half:].astype(jnp.float32)
    return jnp.concatenate([x1 * cos - x2 * sin, x2 * cos + x1 * sin], axis=-1).astype(x.dtype)


def block_causal_attention(q, k, v, scale, log_f_cum=None):
    B, S, H, dk = q.shape
    nb = S // Q_BLOCK
    q_blocks = q.reshape(B, nb, Q_BLOCK, H, dk).swapaxes(0, 1)
    key_pos = jnp.arange(S)
    use_forget = log_f_cum is not None
    if use_forget:
        f_keys = log_f_cum.astype(jnp.float32).swapaxes(1, 2)
        f_blocks = log_f_cum.astype(jnp.float32).reshape(B, nb, Q_BLOCK, H).swapaxes(0, 1)
        xs = (jnp.arange(nb), q_blocks, f_blocks)
    else:
        xs = (jnp.arange(nb), q_blocks)

    def one_block(args):
        i, q_blk = args[0], args[1]
        s = jnp.einsum('bqhd,bkhd->bhqk', q_blk, k, preferred_element_type=jnp.float32) * scale
        if use_forget:
            s = s + args[2].swapaxes(1, 2)[..., None] - f_keys[:, :, None, :]
        q_pos = i * Q_BLOCK + jnp.arange(Q_BLOCK)
        s = jnp.where(key_pos[None, :] <= q_pos[:, None], s, NEG_INF)
        p = jax.nn.softmax(s, axis=-1).astype(v.dtype)
        return jnp.einsum('bhqk,bkhd->bqhd', p, v)

    out = lax.map(one_block, xs)
    return out.swapaxes(0, 1).reshape(B, S, H, v.shape[-1])


def gla_chunked(q, k, v, log_a):
    B, S, H, dk = q.shape
    dv = v.shape[-1]
    C = GLA_CHUNK
    n = S // C

    def to_chunks(t):
        return t.astype(jnp.float32).reshape(B, n, C, H, t.shape[-1]).transpose(1, 0, 3, 2, 4)

    qc, kc, vc, ac = to_chunks(q), to_chunks(k), to_chunks(v), to_chunks(log_a)
    causal = jnp.tril(jnp.ones((C, C), dtype=bool))[:, :, None]

    def step(state, inp):
        qi, ki, vi, ai = inp
        b = jnp.cumsum(ai, axis=-2)
        diff = b[:, :, :, None, :] - b[:, :, None, :, :]
        decay = jnp.exp(jnp.where(causal, diff, -jnp.inf))
        attn = jnp.einsum('bhid,bhjd,bhijd->bhij', qi, ki, decay)
        o = (jnp.einsum('bhij,bhjv->bhiv', attn, vi)
             + jnp.einsum('bhid,bhdv->bhiv', qi * jnp.exp(b), state))
        b_last = b[:, :, -1:, :]
        new_state = (jnp.exp(b_last[:, :, 0, :])[..., None] * state
                     + jnp.einsum('bhjd,bhjv->bhdv', ki * jnp.exp(b_last - b), vi))
        return new_state, o

    init = jnp.zeros((B, H, dk, dv), jnp.float32)
    _, o = lax.scan(step, init, (qc, kc, vc, ac))
    return o.transpose(1, 0, 3, 2, 4).reshape(B, S, H, dv)


def hybrid_layer(x, pos, g_mix, w_in, g_cq, w_uq, g_ckv, w_ukv, g_mla_q, g_mla_k,
                 w_a2, b_a, g_gla_o, g_fox_q, g_fox_k, b_f, w_branch, w_out,
                 g_ffn, w_gu, w_down):
    B, S, _ = x.shape
    h = rms_norm(x, g_mix)
    proj = h @ w_in
    (cq, ckv, kr, gq, gk, gv, ga, gr, fq, fk, fv, fl, gates) = jnp.split(proj, SPLIT_IDX, axis=-1)

    q_a = (rms_norm(cq, g_cq) @ w_uq).reshape(B, S, MLA_HEADS, MLA_NOPE + MLA_ROPE)
    kv_a = (rms_norm(ckv, g_ckv) @ w_ukv).reshape(B, S, MLA_HEADS, MLA_NOPE + MLA_V)
    k_nope, v_a = kv_a[..., :MLA_NOPE], kv_a[..., MLA_NOPE:]
    k_a = jnp.concatenate([k_nope, jnp.broadcast_to(kr[:, :, None, :], (B, S, MLA_HEADS, MLA_ROPE))], axis=-1)
    q_a = rms_norm(q_a, g_mla_q)
    k_a = rms_norm(k_a, g_mla_k)
    q_a = jnp.concatenate([q_a[..., :MLA_NOPE], rope(q_a[..., MLA_NOPE:], pos)], axis=-1)
    k_a = jnp.concatenate([k_a[..., :MLA_NOPE], rope(k_a[..., MLA_NOPE:], pos)], axis=-1)
    o_a = block_causal_attention(q_a, k_a, v_a, (MLA_NOPE + MLA_ROPE) ** -0.5)

    q_b = gq.reshape(B, S, GLA_HEADS, GLA_DK) * (GLA_DK ** -0.5)
    k_b = gk.reshape(B, S, GLA_HEADS, GLA_DK)
    v_b = gv.reshape(B, S, GLA_HEADS, GLA_DV)
    log_a = (jax.nn.log_sigmoid((ga @ w_a2 + b_a).astype(jnp.float32)) / GLA_TAU).reshape(B, S, GLA_HEADS, GLA_DK)
    o_b = gla_chunked(q_b, k_b, v_b, log_a).astype(x.dtype)
    o_b = rms_norm(o_b, g_gla_o) * jax.nn.silu(gr.reshape(B, S, GLA_HEADS, GLA_DV))

    q_c = rms_norm(fq.reshape(B, S, FOX_HEADS, FOX_DH), g_fox_q)
    k_c = rms_norm(fk.reshape(B, S, FOX_HEADS, FOX_DH), g_fox_k)
    v_c = fv.reshape(B, S, FOX_HEADS, FOX_DH)
    log_f_cum = jnp.cumsum(jax.nn.log_sigmoid((fl + b_f).astype(jnp.float32)), axis=1)
    o_c = block_causal_attention(q_c, k_c, v_c, FOX_DH ** -0.5, log_f_cum)

    branches = jnp.stack([o_a.reshape(B, S, BRANCH_WIDTH), o_b.reshape(B, S, BRANCH_WIDTH),
                          o_c.reshape(B, S, BRANCH_WIDTH)], axis=2)
    y = jnp.einsum('bsnc,ncd->bsnd', branches, w_branch)
    g = jax.nn.sigmoid(gates.reshape(B, S, N_BRANCH, D_MODEL))
    merged = jnp.einsum('bsnd,bsnd->bsd', y, g)
    x = x + merged @ w_out

    h2 = rms_norm(x, g_ffn)
    gate, up = jnp.split(h2 @ w_gu, 2, axis=-1)
    return x + (jax.nn.silu(gate) * up) @ w_down


def setup_inputs(seed: int = 0) -> dict:
    key = jax.random.key(seed)
    ks = jax.random.split(key, 24)
    f32 = jnp.float32

    def w(k, shape, fan_in):
        return jax.random.normal(k, shape, f32) * (fan_in ** -0.5)

    def gain(k, shape):
        return 1.0 + 0.02 * jax.random.normal(k, shape, f32)

    L = DEPTH
    x = jax.random.normal(ks[0], (BATCH, SEQ, D_MODEL), f32)
    offset = jax.random.randint(ks[1], (BATCH, 1), 0, SEQ, dtype=jnp.int32)
    positions = (jnp.arange(SEQ, dtype=jnp.int32)[None, :] + offset).astype(jnp.int32)
    return {
        "x": x,
        "positions": positions,
        "g_mix": gain(ks[2], (L, D_MODEL)),
        "w_in": w(ks[3], (L, D_MODEL, D_IN), D_MODEL),
        "g_cq": gain(ks[4], (L, MLA_Q_RANK)),
        "w_uq": w(ks[5], (L, MLA_Q_RANK, MLA_HEADS * (MLA_NOPE + MLA_ROPE)), MLA_Q_RANK),
        "g_ckv": gain(ks[6], (L, MLA_KV_RANK)),
        "w_ukv": w(ks[7], (L, MLA_KV_RANK, MLA_HEADS * (MLA_NOPE + MLA_V)), MLA_KV_RANK),
        "g_mla_q": gain(ks[8], (L, MLA_NOPE + MLA_ROPE)),
        "g_mla_k": gain(ks[9], (L, MLA_NOPE + MLA_ROPE)),
        "w_a2": w(ks[10], (L, GLA_GATE_RANK, GLA_HEADS * GLA_DK), GLA_GATE_RANK),
        "b_a": 0.1 * jax.random.normal(ks[11], (L, GLA_HEADS * GLA_DK), f32),
        "g_gla_o": gain(ks[12], (L, GLA_DV)),
        "g_fox_q": gain(ks[13], (L, FOX_DH)),
        "g_fox_k": gain(ks[14], (L, FOX_DH)),
        "b_f": FORGET_BIAS_INIT + 0.1 * jax.random.normal(ks[15], (L, FOX_HEADS), f32),
        "w_branch": w(ks[16], (L, N_BRANCH, BRANCH_WIDTH, D_MODEL), BRANCH_WIDTH),
        "w_out": w(ks[17], (L, D_MODEL, D_MODEL), D_MODEL),
        "g_ffn": gain(ks[18], (L, D_MODEL)),
        "w_gu": w(ks[19], (L, D_MODEL, 2 * FFN_HIDDEN), D_MODEL),
        "w_down": w(ks[20], (L, FFN_HIDDEN, D_MODEL), FFN_HIDDEN),
    }


def reference(x, positions, g_mix, w_in, g_cq, w_uq, g_ckv, w_ukv, g_mla_q, g_mla_k,
              w_a2, b_a, g_gla_o, g_fox_q, g_fox_k, b_f, w_branch, w_out,
              g_ffn, w_gu, w_down):
    h = x
    for l in range(DEPTH):
        h = hybrid_layer(h, positions, g_mix[l], w_in[l], g_cq[l], w_uq[l], g_ckv[l], w_ukv[l],
                         g_mla_q[l], g_mla_k[l], w_a2[l], b_a[l], g_gla_o[l], g_fox_q[l],
                         g_fox_k[l], b_f[l], w_branch[l], w_out[l], g_ffn[l], w_gu[l], w_down[l])
    return h
```

```cpp
#include <hip/hip_runtime.h>
#include <cstdio>
#include <cstdint>

constexpr int S = 8192, DM = 2048, DEPTH = 4;
constexpr int D_IN = 13400, FFH = 5632;
constexpr int C_CQ = 0, C_CKV = 512, C_KR = 1024, C_GQ = 1088, C_GK = 1600, C_GV = 2112, C_GA = 3136, C_GR = 3152,
              C_FQ = 4176, C_FK = 5200, C_FV = 6224, C_FL = 7248, C_GATES = 7256;
constexpr float EPS = 1e-6f;
#define MK_WSTRIDE 149946368ull
constexpr int NP_G = 13568;


namespace pg8 {
#define PG8_LAS __attribute__((address_space(3)))
typedef unsigned short bf16_t;
typedef short bf16x8 __attribute__((ext_vector_type(8)));
typedef float f32x4 __attribute__((ext_vector_type(4)));
typedef unsigned u32x4 __attribute__((ext_vector_type(4)));
constexpr int BM = 256, BK = 64, HALF = 128, HTB = HALF * BK * 2  , STAGE_BYTES = 8 * HTB, NXCD = 8, WGM = 8;

__host__ __device__ __forceinline__ int lds_byte(int r, int c) { const int st = (r >> 4) * 2 + (c >> 5), rr = r & 15, cc = c & 31, ob = rr * 64 + cc * 2; return st * 1024 + (ob ^ (((ob >> 9) & 1) << 5)); }
__host__ __device__ __forceinline__ void stage_rc(int b, int& R, int& C) { const int st = b / 1024, sb = b % 1024, swz = sb ^ (((sb >> 9) & 1) << 5); R = (st >> 1) * 16 + swz / 64; C = (st & 1) * 32 + (swz % 64) / 2; }
__host__ __device__ __forceinline__ int perm32(int rho) { const int n = rho >> 4, i = rho & 15; return 8 * (i >> 2) + 4 * n + (i & 3); }

struct Unit { int pm, pn; };
struct Gemm { const bf16_t* A; const bf16_t* Bt; int M, N, K, lda, ldb; };

struct StaticOrder {
    int nM, nN, nwg, G, c;
    __host__ __device__ void init(int M, int N, int G_, int c_) { nM = M / BM; nN = N / BM; nwg = nM * nN; G = G_; c = c_; }
    __host__ __device__ bool next(int i, Unit& u) const {
        const long L = (long)i * G + c; if (L >= nwg) return false;
        int wgid = (int)L; { const int q = nwg / NXCD, r = nwg % NXCD, xcd = wgid % NXCD, off = wgid / NXCD; wgid = (xcd < r ? xcd * (q + 1) : r * (q + 1) + (xcd - r) * q) + off; }
        const int nig = WGM * nN, gid = wgid / nig, fm = gid * WGM, gsz = (nM - fm) < WGM ? (nM - fm) : WGM;
        u.pm = fm + ((wgid % nig) % gsz); u.pn = (wgid % nig) / gsz; return true;
    }
    __device__ __forceinline__ void a_ready(const Unit&) const {}
    __device__ __forceinline__ void done(const Unit&) const {}
};

__device__ __forceinline__ unsigned cvt_pk_bf16(float lo, float hi) { unsigned r; asm volatile("v_cvt_pk_bf16_f32 %0, %1, %2" : "=v"(r) : "v"(lo), "v"(hi)); return r; }
template <class Epi, class Sched, bool ALIGN_EPI = false, bool SP2 = false>
__device__ __forceinline__ void gemm_phase(PG8_LAS unsigned char* lds, const Gemm g, const Sched& S, const Epi& E) {
    int tid_ = threadIdx.x; asm volatile("" : "+v"(tid_));
    const int tid = tid_, wid = __builtin_amdgcn_readfirstlane(tid >> 6), lane = tid & 63, wr = wid >> 2, wc = wid & 3, fr = lane & 15, fq = lane >> 4;
    const int K = g.K, nt = K / BK;
    unsigned voffA[2], voffB[2];
#pragma unroll
    for (int i = 0; i < 2; ++i) { int R, C; stage_rc(tid * 16 + i * 8192, R, C); const int Rb = Epi::PERM ? ((R & ~31) + perm32(R & 31)) : R;
        voffA[i] = (unsigned)(R * g.lda + C) * 2u; voffB[i] = (unsigned)(Rb * g.ldb + C) * 2u; }
    const size_t kstep = (size_t)(BK * 2);
    const size_t hstepA = (size_t)HALF * g.lda * 2, hstepB = (size_t)HALF * g.ldb * 2;
    const size_t tstepA = 2 * hstepA, tstepB = 2 * hstepB;
    const unsigned ldsw = (unsigned)wid * 1024u;
    const int aoff = lds_byte(wr * 64 + fr, fq * 8), boff = lds_byte(wc * 32 + fr, fq * 8);
#define PG8_SA(b, h) (((b) * 2 + (h)) * HTB)
#define PG8_SB(b, h) ((4 + (b) * 2 + (h)) * HTB)
#define PG8_STAGE(bufoff, gbase, voff) do { _Pragma("unroll") for (int _i = 0; _i < 2; ++_i) \
        __builtin_amdgcn_global_load_lds((const unsigned*)((const char*)(gbase) + (voff)[_i]), (PG8_LAS unsigned*)(lds + (bufoff) + ldsw + _i * 8192), 16, 0, 0); } while (0)
#define PG8_LDA(dst, b, h) do { _Pragma("unroll") for (int m = 0; m < 4; ++m) _Pragma("unroll") for (int k = 0; k < 2; ++k) dst[m][k] = *(const PG8_LAS bf16x8*)(lds + PG8_SA(b, h) + aoff + m * 2048 + k * 1024); } while (0)
#define PG8_LDB(dst, b, h) do { _Pragma("unroll") for (int n = 0; n < 2; ++n) _Pragma("unroll") for (int k = 0; k < 2; ++k) dst[n][k] = *(const PG8_LAS bf16x8*)(lds + PG8_SB(b, h) + boff + n * 2048 + k * 1024); } while (0)
#define PG8_MMA(ai, bj, At, Bt) do { __builtin_amdgcn_s_setprio(1); _Pragma("unroll") for (int m = 0; m < 4; ++m) _Pragma("unroll") for (int n = 0; n < 2; ++n) _Pragma("unroll") for (int k = 0; k < 2; ++k) \
        acc[ai][bj][m][n] = __builtin_amdgcn_mfma_f32_16x16x32_bf16(Bt[n][k], At[m][k], acc[ai][bj][m][n], 0, 0, 0); __builtin_amdgcn_s_setprio(0); } while (0)
#define PG8_WAIT_V(n) asm volatile("s_waitcnt vmcnt(" #n ")" ::: "memory")
#define PG8_WAIT_L(n) asm volatile("s_waitcnt lgkmcnt(" #n ")" ::: "memory")
#define PG8_BAR __builtin_amdgcn_s_barrier()
#define PG8_SCHED __builtin_amdgcn_sched_barrier(0)
    Unit cur, nxt; int ui = 0;
    if (!S.next(0, cur)) return;
    f32x4 acc[2][2][4][2];
#pragma unroll
    for (int a = 0; a < 2; ++a)
#pragma unroll
        for (int b = 0; b < 2; ++b)
#pragma unroll
            for (int m = 0; m < 4; ++m)
#pragma unroll
                for (int n = 0; n < 2; ++n) acc[a][b][m][n] = (f32x4){0.f, 0.f, 0.f, 0.f};
    bf16x8 At[4][2], B0[2][2], B1[2][2];
    const char* cA = (const char*)g.A + (size_t)cur.pm * tstepA; const char* cB = (const char*)g.Bt + (size_t)cur.pn * tstepB;
    S.a_ready(cur);
    if constexpr (SP2) {
        PG8_STAGE(PG8_SB(0, 0), cB, voffB); PG8_STAGE(PG8_SB(0, 1), cB + hstepB, voffB); PG8_STAGE(PG8_SA(0, 0), cA, voffA); PG8_STAGE(PG8_SA(0, 1), cA + hstepA, voffA);
        if (wr == 1) PG8_BAR;
        PG8_WAIT_V(2); PG8_BAR;
        PG8_STAGE(PG8_SB(1, 0), cB + kstep, voffB); PG8_STAGE(PG8_SA(1, 0), cA + kstep, voffA); PG8_STAGE(PG8_SB(1, 1), cB + hstepB + kstep, voffB);
        PG8_WAIT_V(6); PG8_BAR;
    } else {
        PG8_STAGE(PG8_SB(0, 0), cB, voffB); PG8_STAGE(PG8_SA(0, 0), cA, voffA); PG8_STAGE(PG8_SB(0, 1), cB + hstepB, voffB); PG8_STAGE(PG8_SA(0, 1), cA + hstepA, voffA);
        if (wr == 1) PG8_BAR;
        PG8_WAIT_V(4); PG8_BAR;
        PG8_STAGE(PG8_SB(1, 0), cB + kstep, voffB); PG8_STAGE(PG8_SA(1, 0), cA + kstep, voffA); PG8_STAGE(PG8_SB(1, 1), cB + hstepB + kstep, voffB);
        PG8_WAIT_V(6); PG8_BAR;
    }
    for (;;) {
        const bool has_next = S.next(ui + 1, nxt);
        const char* nA = has_next ? (const char*)g.A + (size_t)nxt.pm * tstepA : cA; const char* nB = has_next ? (const char*)g.Bt + (size_t)nxt.pn * tstepB : cB;
        for (int t = 0; t < nt; t += 2) {
            const bool last = (t == nt - 2);
            const char* a1 = cA + (size_t)(t + 1) * kstep;
            const char* a2 = last ? nA : cA + (size_t)(t + 2) * kstep; const char* b2 = last ? nB : cB + (size_t)(t + 2) * kstep;
            const char* a3 = a2 + kstep; const char* b3 = b2 + kstep;
            if (last && has_next) S.a_ready(nxt);
            if constexpr (SP2) {
            PG8_LDB(B0, 0, 0); PG8_LDB(B1, 0, 1); PG8_SCHED; PG8_LDA(At, 0, 0); PG8_STAGE(PG8_SA(1, 1), a1 + hstepA, voffA);
            PG8_WAIT_V(8); PG8_WAIT_L(0); PG8_BAR; PG8_MMA(0, 0, At, B0); PG8_MMA(0, 1, At, B1); PG8_BAR; PG8_SCHED;
            PG8_LDA(At, 0, 1); PG8_STAGE(PG8_SB(0, 0), b2, voffB); PG8_STAGE(PG8_SB(0, 1), b2 + hstepB, voffB); PG8_STAGE(PG8_SA(0, 0), a2, voffA);
            PG8_WAIT_V(8); PG8_WAIT_L(0); PG8_BAR; PG8_MMA(1, 0, At, B0); PG8_MMA(1, 1, At, B1); PG8_BAR; PG8_SCHED;
            PG8_LDB(B0, 1, 0); PG8_LDB(B1, 1, 1); PG8_SCHED; PG8_LDA(At, 1, 0); PG8_STAGE(PG8_SA(0, 1), a2 + hstepA, voffA);
            PG8_WAIT_V(8); PG8_WAIT_L(0); PG8_BAR; PG8_MMA(0, 0, At, B0); PG8_MMA(0, 1, At, B1); PG8_BAR; PG8_SCHED;
            PG8_LDA(At, 1, 1); PG8_STAGE(PG8_SB(1, 0), b3, voffB); PG8_STAGE(PG8_SB(1, 1), b3 + hstepB, voffB); PG8_STAGE(PG8_SA(1, 0), a3, voffA);
            PG8_WAIT_V(8); PG8_WAIT_L(0); PG8_BAR; PG8_MMA(1, 0, At, B0); PG8_MMA(1, 1, At, B1); PG8_BAR; PG8_SCHED;
            } else {
            PG8_LDB(B0, 0, 0); PG8_SCHED; PG8_LDA(At, 0, 0); PG8_STAGE(PG8_SA(1, 1), a1 + hstepA, voffA);
            PG8_WAIT_L(8); PG8_BAR; PG8_WAIT_L(0); PG8_MMA(0, 0, At, B0); PG8_BAR; PG8_SCHED;
            PG8_LDB(B1, 0, 1); PG8_STAGE(PG8_SB(0, 0), b2, voffB);
            PG8_BAR; PG8_WAIT_L(0); PG8_MMA(0, 1, At, B1); PG8_BAR;
            PG8_LDA(At, 0, 1); PG8_STAGE(PG8_SA(0, 0), a2, voffA);
            PG8_BAR; PG8_WAIT_L(0); PG8_MMA(1, 0, At, B0); PG8_BAR; PG8_SCHED;
            PG8_STAGE(PG8_SB(0, 1), b2 + hstepB, voffB);
            PG8_WAIT_V(6); PG8_BAR; PG8_MMA(1, 1, At, B1); PG8_BAR;
            PG8_LDB(B0, 1, 0); PG8_SCHED; PG8_LDA(At, 1, 0); PG8_STAGE(PG8_SA(0, 1), a2 + hstepA, voffA);
            PG8_WAIT_L(8); PG8_BAR; PG8_WAIT_L(0); PG8_MMA(0, 0, At, B0); PG8_BAR; PG8_SCHED;
            PG8_LDB(B1, 1, 1); PG8_STAGE(PG8_SB(1, 0), b3, voffB);
            PG8_BAR; PG8_WAIT_L(0); PG8_MMA(0, 1, At, B1); PG8_BAR;
            PG8_LDA(At, 1, 1); PG8_STAGE(PG8_SA(1, 0), a3, voffA);
            PG8_BAR; PG8_WAIT_L(0); PG8_MMA(1, 0, At, B0); PG8_BAR; PG8_SCHED;
            PG8_STAGE(PG8_SB(1, 1), b3 + hstepB, voffB);
            PG8_WAIT_V(6); PG8_BAR; PG8_MMA(1, 1, At, B1); PG8_BAR;
            }
        }
        if constexpr (ALIGN_EPI) { if (wr == 0) PG8_BAR; }
        if constexpr (!Epi::AFTER_DRAIN) { E(acc, cur, wr, wc, fr, fq); S.done(cur); }
        if (!has_next) break;
#pragma unroll
        for (int a = 0; a < 2; ++a)
#pragma unroll
            for (int b = 0; b < 2; ++b)
#pragma unroll
                for (int m = 0; m < 4; ++m)
#pragma unroll
                    for (int n = 0; n < 2; ++n) acc[a][b][m][n] = (f32x4){0.f, 0.f, 0.f, 0.f};
        cur = nxt; cA = nA; cB = nB; ++ui;
        if constexpr (ALIGN_EPI) { if (wr == 1) PG8_BAR; }
    }
    PG8_WAIT_V(0);
    if constexpr (!ALIGN_EPI) { if (wr == 0) PG8_BAR; }
    PG8_BAR;
    if constexpr (Epi::AFTER_DRAIN) { E.fused(acc, cur, wr, wc, fr, fq, lds, wid, lane); S.done(cur); }
#undef PG8_SA
#undef PG8_SB
#undef PG8_STAGE
#undef PG8_LDA
#undef PG8_LDB
#undef PG8_MMA
#undef PG8_WAIT_V
#undef PG8_WAIT_L
#undef PG8_BAR
#undef PG8_SCHED
}
}

#define GAS __attribute__((address_space(1)))
#define LAS __attribute__((address_space(3)))
#define XB_TMO      128
#define XB_XCNT(j)  (256  + 64 * (j))
#define XB_XSUB(j)  (1280 + 64 * (j))
#define XB_XGEN(j)  (2304 + 64 * (j))
#define XB_TOP      3328
#define XB_TOPGEN   3392
#define XCD_BAR_WORDS 3456
#define XB_SPIN_CAP (1u << 18)

__device__ __forceinline__ unsigned xb_ld(unsigned* p)              { return __hip_atomic_load(p, __ATOMIC_RELAXED, __HIP_MEMORY_SCOPE_AGENT); }
__device__ __forceinline__ unsigned xb_add(unsigned* p, unsigned v) { return __hip_atomic_fetch_add(p, v, __ATOMIC_RELAXED, __HIP_MEMORY_SCOPE_AGENT); }
__device__ __forceinline__ unsigned xb_xcc_id() { return (unsigned)__builtin_amdgcn_s_getreg((3 << 11) | 20) & 0xFu; }
#define XB_SPIN(cond, bar) do { unsigned _sp = 0; while (cond) { __builtin_amdgcn_s_sleep(1); \
    if ((++_sp & 255u) == 0u) { if (xb_ld(&(bar)[XB_TMO])) break; if (_sp > XB_SPIN_CAP) { atomicAdd(&(bar)[XB_TMO], 1u); break; } } } } while (0)

struct XcdBarrier {
    unsigned* bar; unsigned x;
    volatile LAS unsigned* st;
};

__device__ __forceinline__ XcdBarrier xcd_barrier_post(unsigned* bar, volatile LAS unsigned* st) {
    XcdBarrier b; b.bar = bar; b.x = xb_xcc_id(); b.st = st;
    if (threadIdx.x == 0) (void)xb_add(&bar[XB_XCNT(b.x)], 1u);
    return b;
}
__device__ __forceinline__ void xcd_barrier_complete(unsigned* bar, unsigned x, unsigned& nloc, unsigned& nx) {
    const unsigned G = gridDim.x * gridDim.y * gridDim.z;
    unsigned sum, cnt, mine, sp = 0u;
    for (;;) {
        sum = 0u; cnt = 0u; mine = 0u;
#pragma unroll
        for (unsigned j = 0; j < 16; ++j) { const unsigned c = xb_ld(&bar[XB_XCNT(j)]); sum += c; cnt += (c > 0u) ? 1u : 0u; mine = (j == x) ? c : mine; }
        if (sum == G) break;
        __builtin_amdgcn_s_sleep(1);
        if ((++sp & 255u) == 0u) { if (xb_ld(&bar[XB_TMO])) break; if (sp > XB_SPIN_CAP) { atomicAdd(&bar[XB_TMO], 1u); break; } }
    }
    nloc = mine > 0u ? mine : 1u; nx = cnt > 0u ? cnt : 1u;
}

__device__ __forceinline__ void xcd_barrier(const XcdBarrier& b) {
    asm volatile("s_waitcnt vmcnt(0)" ::: "memory");
    __syncthreads();
    if (threadIdx.x == 0) {
        unsigned* bar = b.bar;
        __builtin_amdgcn_s_waitcnt(0);
        unsigned nloc = b.st[0], nx = b.st[1];
        if (nloc == 0u) { xcd_barrier_complete(bar, b.x, nloc, nx); b.st[0] = nloc; b.st[1] = nx; }
        const unsigned old = xb_add(&bar[XB_XSUB(b.x)], 1u);
        const unsigned gen = old / nloc;
        if (old + 1u == (gen + 1u) * nloc) {
            __builtin_amdgcn_fence(__ATOMIC_RELEASE, "agent");
            asm volatile("s_waitcnt vmcnt(0)" ::: "memory");
            const unsigned og = xb_add(&bar[XB_TOP], 1u);
            const unsigned tg = og / nx;
            if (og + 1u == (tg + 1u) * nx) xb_add(&bar[XB_TOPGEN], 1u);
            else XB_SPIN(xb_ld(&bar[XB_TOPGEN]) == tg, bar);
            __builtin_amdgcn_fence(__ATOMIC_ACQUIRE, "agent");
            xb_add(&bar[XB_XGEN(b.x)], 1u);
            asm volatile("s_waitcnt vmcnt(0)" ::: "memory");
        } else {
            XB_SPIN(xb_ld(&bar[XB_XGEN(b.x)]) == gen, bar);
            __builtin_amdgcn_fence(__ATOMIC_ACQUIRE, "agent");
            asm volatile("s_waitcnt vmcnt(0)" ::: "memory");
        }
    }
    __syncthreads();
}

namespace att {
__device__ __forceinline__ int mk_lnd_v(int v) { asm volatile("" : "+v"(v)); return v; }
typedef short bf16x8 __attribute__((ext_vector_type(8)));
typedef short s16x4 __attribute__((ext_vector_type(4)));
typedef float f32x16 __attribute__((ext_vector_type(16)));
typedef float f32x4 __attribute__((ext_vector_type(4)));
typedef unsigned u32x4 __attribute__((ext_vector_type(4)));
typedef unsigned short bf16;
constexpr int NW = 8, QBLK = 32, KVBLK = 64, QB = NW * QBLK;
constexpr int SHM_V = KVBLK * 128 * 2, SHM_K = 16 * 1152, SHM_KR = 8 * 1152;
constexpr int L_V = 0, L_K = 2 * SHM_V, L_KR = L_K + 2 * SHM_K, L_WS = L_KR + 2 * SHM_KR, L_X = L_WS + NW * 64 * 4;
constexpr int L_FB = L_X + 32768, L_END = L_X + 65536;
static_assert(L_END <= 163840 - 512, "attention LDS");
constexpr float THR = 8.f;
#define KLAY(row, chunk) ((chunk) * 1152 + (((chunk) & 7) + (row)) * 16)
#define SBAR() __builtin_amdgcn_sched_barrier(0)
__device__ __forceinline__ int v_st(int k, int c) { const int kk = (k & ~0xC) | ((k & 4) << 1) | ((k & 8) >> 1); return ((kk >> 3) * 4 + (c >> 5)) * 512 + ((kk & 7) * 32 + (c & 31)) * 2; }
__device__ __forceinline__ int v_rd_base(int lane) { return ((lane & 3) << 3) | (((lane >> 2) & 3) << 6) | (((lane >> 4) & 1) << 5) | (((lane >> 5) & 1) << 8); }
constexpr int v_rd_off(int d0, int ks, int half) { return d0 * 512 + ks * 4096 + half * 2048; }
__device__ __forceinline__ int crow(int r, int hi) { return (r & 3) + 8 * (r >> 2) + 4 * hi; }
__device__ __forceinline__ unsigned cvtpk(float lo, float hi) { unsigned r; asm volatile("v_cvt_pk_bf16_f32 %0, %1, %2" : "=v"(r) : "v"(lo), "v"(hi)); return r; }
__device__ __forceinline__ bf16x8 load8(const bf16* p) { return *reinterpret_cast<const bf16x8*>(p); }
typedef float f32x2c_t __attribute__((ext_vector_type(2))); typedef __bf16 bf16x2c_t __attribute__((ext_vector_type(2)));
__device__ __forceinline__ unsigned cvtpk_c(float lo, float hi) { f32x2c_t v = {lo, hi}; bf16x2c_t b = __builtin_convertvector(v, bf16x2c_t); return __builtin_bit_cast(unsigned, b); }

__device__ __forceinline__ void mask_tile(f32x16& p0, f32x16& p1, int dq) {
    const float NEG = -__builtin_inff();
#pragma unroll
    for (int r = 0; r < 16; ++r) {
        const int c = (r & 3) + 8 * (r >> 2);
        if (dq - c < 0) p0[r] = NEG;
        if (dq - c - 32 < 0) p1[r] = NEG;
    }
}
template <bool MLA>
__device__ __forceinline__ void partialSM(f32x16& p0, f32x16& p1, float& m_reg, float& mn, float& alpha) {
    constexpr float SCALE = MLA ? 0.07216878364870322f : 0.08838834764831845f;
    float pmax = p0[0];
#pragma unroll
    for (int r = 1; r < 16; ++r) pmax = fmaxf(pmax, p0[r]);
#pragma unroll
    for (int r = 0; r < 16; ++r) pmax = fmaxf(pmax, p1[r]);
    { auto rr = __builtin_amdgcn_permlane32_swap(__float_as_uint(pmax), __float_as_uint(pmax), false, false);
      pmax = fmaxf(__uint_as_float(rr[0]), __uint_as_float(rr[1])); }
    constexpr float C2 = 1.4426950408889634f * SCALE;
    if (__builtin_expect(__all((pmax - m_reg) * SCALE <= THR), 1)) { mn = m_reg; alpha = 1.f; }
    else { mn = fmaxf(m_reg, pmax); alpha = __builtin_amdgcn_exp2f((m_reg - mn) * C2); m_reg = mn; }
    const float mnL = -mn * C2;
#pragma unroll
    for (int r = 0; r < 16; ++r) p0[r] = fmaf(p0[r], C2, mnL);
#pragma unroll
    for (int r = 0; r < 16; ++r) p1[r] = fmaf(p1[r], C2, mnL);
#pragma unroll
    for (int r = 0; r < 16; ++r) p0[r] = __builtin_amdgcn_exp2f(p0[r]);
}
#define PK4(P, B_, OUT) do { unsigned a0 = cvtpk(P[B_+0], P[B_+1]), a1 = cvtpk(P[B_+2], P[B_+3]);                          \
        unsigned b0 = cvtpk(P[B_+4], P[B_+5]), b1 = cvtpk(P[B_+6], P[B_+7]);                                             \
        auto r0 = __builtin_amdgcn_permlane32_swap(a0, b0, false, false); auto r1 = __builtin_amdgcn_permlane32_swap(a1, b1, false, false); \
        u32x4 w = {r0[0], r1[0], r0[1], r1[1]}; OUT = *reinterpret_cast<bf16x8*>(&w); } while (0)
__device__ __forceinline__ void finishSM(f32x16& p0, f32x16& p1, float alpha, float& l_reg, bf16x8& pa0, bf16x8& pa1, bf16x8& pa2, bf16x8& pa3) {
#pragma unroll
    for (int r = 0; r < 16; ++r) p1[r] = __builtin_amdgcn_exp2f(p1[r]);
    float ps = 0;
#pragma unroll
    for (int r = 0; r < 16; ++r) ps += p0[r];
#pragma unroll
    for (int r = 0; r < 16; ++r) ps += p1[r];
    { auto rr = __builtin_amdgcn_permlane32_swap(__float_as_uint(ps), __float_as_uint(ps), false, false);
      ps = __uint_as_float(rr[0]) + __uint_as_float(rr[1]); }
    l_reg = l_reg * alpha + ps;
    PK4(p0, 0, pa0); PK4(p0, 8, pa1); PK4(p1, 0, pa2); PK4(p1, 8, pa3);
}
template <int KB, bool MLA, bool BIAS>
__device__ __forceinline__ void qkt(f32x16& p0, f32x16& p1, const char* lds, int r32, int hi, const bf16x8* qr, int krb, int qrb, int fbb) {
    if constexpr (BIAS) {
        const char* fbp = lds + L_FB + fbb;
#pragma unroll
        for (int g_ = 0; g_ < 4; ++g_) { const f32x4 b0_ = *(const f32x4*)(fbp + g_ * 32), b1_ = *(const f32x4*)(fbp + 128 + g_ * 32);
#pragma unroll
            for (int e_ = 0; e_ < 4; ++e_) { p0[4 * g_ + e_] = b0_[e_]; p1[4 * g_ + e_] = b1_[e_]; } }
    } else { p0 = f32x16{}; p1 = f32x16{}; }
    const char* K_lds = lds + L_K;
    const char* kbase = K_lds + KB * SHM_K + r32 * 16 + hi * 1168;
    constexpr int NQR = MLA ? 12 : 8;
    const char* qq = lds + L_X + qrb;
#pragma unroll
    for (int d0 = 0; d0 < 8; ++d0) {
        bf16x8 b0 = *reinterpret_cast<const bf16x8*>(kbase + KLAY(0, 2 * d0));
        bf16x8 b1 = *reinterpret_cast<const bf16x8*>(kbase + KLAY(32, 2 * d0));
        bf16x8 q; if (d0 < NQR) q = qr[d0]; else q = *reinterpret_cast<const bf16x8*>(qq + (d0 - NQR) * 1024);
        p0 = __builtin_amdgcn_mfma_f32_32x32x16_bf16(b0, q, p0, 0, 0, 0);
        p1 = __builtin_amdgcn_mfma_f32_32x32x16_bf16(b1, q, p1, 0, 0, 0); }
    if constexpr (MLA) {
        const char* kr = lds + L_KR + KB * SHM_KR + krb;
#pragma unroll
        for (int dr = 0; dr < 4; ++dr) {
            bf16x8 b0 = *reinterpret_cast<const bf16x8*>(kr + KLAY(0, 2 * dr));
            bf16x8 b1 = *reinterpret_cast<const bf16x8*>(kr + KLAY(32, 2 * dr));
            bf16x8 q; if (8 + dr < NQR) q = qr[8 + dr]; else q = *reinterpret_cast<const bf16x8*>(qq + (8 + dr - NQR) * 1024);
            p0 = __builtin_amdgcn_mfma_f32_32x32x16_bf16(b0, q, p0, 0, 0, 0);
            p1 = __builtin_amdgcn_mfma_f32_32x32x16_bf16(b1, q, p1, 0, 0, 0); }
    }
}
template <int VB>
__device__ __forceinline__ void pv_tile(f32x16* o, int vb0, bf16x8 pa0, bf16x8 pa1, bf16x8 pa2, bf16x8 pa3) {
#define TRRD(dst, off) asm volatile("ds_read_b64_tr_b16 %0, %1 offset:%2" : "=&v"(dst) : "v"(vb0), "i"(off) : "memory")
#define PV_D0(d0) do { s16x4 l0, l1, l2, l3, h0, h1, h2, h3; constexpr int b_ = VB * SHM_V + v_rd_off(d0, 0, 0);   \
        TRRD(l0, b_); TRRD(h0, b_ + 2048); TRRD(l1, b_ + 4096); TRRD(h1, b_ + 6144); TRRD(l2, b_ + 8192); TRRD(h2, b_ + 10240); TRRD(l3, b_ + 12288); TRRD(h3, b_ + 14336); \
        asm volatile("s_waitcnt lgkmcnt(0)" ::: "memory"); SBAR();   \
        o[d0] = __builtin_amdgcn_mfma_f32_32x32x16_bf16(pa0, (bf16x8){l0[0], l0[1], l0[2], l0[3], h0[0], h0[1], h0[2], h0[3]}, o[d0], 0, 0, 0);   \
        o[d0] = __builtin_amdgcn_mfma_f32_32x32x16_bf16(pa1, (bf16x8){l1[0], l1[1], l1[2], l1[3], h1[0], h1[1], h1[2], h1[3]}, o[d0], 0, 0, 0);   \
        o[d0] = __builtin_amdgcn_mfma_f32_32x32x16_bf16(pa2, (bf16x8){l2[0], l2[1], l2[2], l2[3], h2[0], h2[1], h2[2], h2[3]}, o[d0], 0, 0, 0);   \
        o[d0] = __builtin_amdgcn_mfma_f32_32x32x16_bf16(pa3, (bf16x8){l3[0], l3[1], l3[2], l3[3], h3[0], h3[1], h3[2], h3[3]}, o[d0], 0, 0, 0); } while (0)
    PV_D0(0); PV_D0(1); PV_D0(2); PV_D0(3);
#undef PV_D0
#undef TRRD
}

struct HeadRef { const bf16* Q; const bf16* K; const bf16* V; bf16* O; const float* FS; };
template <bool MLA> struct Seam { bf16x8 qr[MLA ? 12 : 8]; bf16x8 st_v0, st_v1, st_k0, st_k1; bf16x8 st_kr; bf16x8 ql[1]; };
template <bool MLA> struct Geo {
    static constexpr int QP = MLA ? 192 : 128, KP = MLA ? 192 : 128, VP = MLA ? 128 : NP_G, OP = 1024;
};
#define VMW() asm volatile("s_waitcnt vmcnt(0)" ::: "memory")
#define VMWN(n) asm volatile("s_waitcnt vmcnt(%0)" :: "i"(n) : "memory")
#define SLOAD_H(Kp, Vp, k0) do { S.st_v0 = load8((Vp) + (size_t)((k0) + sr) * G::VP + sc); S.st_v1 = load8((Vp) + (size_t)((k0) + 32 + sr) * G::VP + sc);              \
                         S.st_k0 = load8((Kp) + (size_t)((k0) + sr) * G::KP + sc); S.st_k1 = load8((Kp) + (size_t)((k0) + 32 + sr) * G::KP + sc);              \
                         if constexpr (MLA) S.st_kr = load8((Kp) + (size_t)((k0) + (tid >> 3)) * G::KP + 128 + (tid & 7) * 8); } while (0)
#define SWRITE_HK(bf) do { *(bf16x8*)(K_lds + (bf) * SHM_K + kws) = S.st_k0; *(bf16x8*)(K_lds + (bf) * SHM_K + kws1) = S.st_k1;  \
                           if constexpr (MLA) *(bf16x8*)(lds + L_KR + (bf) * SHM_KR + krw) = S.st_kr; } while (0)
#define SWRITE_HV(bf) do { *(bf16x8*)(V_lds + (bf) * SHM_V + vst0) = S.st_v0; *(bf16x8*)(V_lds + (bf) * SHM_V + vst1) = S.st_v1; } while (0)
#define SWRITE_H(bf) do { SWRITE_HV(bf); SWRITE_HK(bf); } while (0)
#define QLOAD_R(ref) do { _Pragma("unroll") for (int d0 = 0; d0 < NQR; ++d0) S.qr[d0] = load8((ref) + (size_t)(wid * QBLK + r32) * G::QP + d0 * 16 + hi * 8); } while (0)
#define QLOAD_L(ref) do { _Pragma("unroll") for (int dr = 0; dr < NQLDS; ++dr) S.ql[dr] = load8((ref) + (size_t)(wid * QBLK + r32) * G::QP + NQR * 16 + dr * 16 + hi * 8); } while (0)
#define QROPE_TO_LDS() do { _Pragma("unroll") for (int dr = 0; dr < NQLDS; ++dr) *(bf16x8*)(lds + L_X + qrb + dr * 1024) = S.ql[dr]; } while (0)

template <bool MLA>
__device__ __forceinline__ void prime(const HeadRef& H, int qb_cur, char* lds, Seam<MLA>& S) {
    typedef Geo<MLA> G;
    const int tid = mk_lnd_v(threadIdx.x), wid = __builtin_amdgcn_readfirstlane(tid >> 6), lane = tid & 63, r32 = lane & 31, hi = lane >> 5;
    const int sr = tid >> 4, sc = (tid & 15) * 8, kws = KLAY(sr, tid & 15), kws1 = KLAY(32 + sr, tid & 15); char* K_lds = lds + L_K;
    constexpr int NQLDS = 0, NQR = MLA ? 12 : 8;
    const int krw = KLAY(tid >> 3, tid & 7), qrb = wid * (NQLDS * 1024) + lane * 16;
    const bf16* Qc = H.Q + (size_t)qb_cur * QB * G::QP;
    QLOAD_R(Qc); QLOAD_L(Qc);
    SLOAD_H(H.K, H.V, 0); VMW(); SWRITE_HK(0); QROPE_TO_LDS();
    __syncthreads();
}
template <bool MLA>
__device__ __forceinline__ void block(const HeadRef& H, int qb_cur, int qb_nxt, char* lds, Seam<MLA>& S) {
    typedef Geo<MLA> G;
    constexpr bool BIAS = !MLA; constexpr int NQLDS = 0, NQR = MLA ? 12 : 8;
    const int tid = mk_lnd_v(threadIdx.x), wid = __builtin_amdgcn_readfirstlane(tid >> 6), lane = tid & 63, r32 = lane & 31, hi = lane >> 5;
    const int P0 = qb_cur * QB;
    const int NT = (P0 + QB - 1) / KVBLK + 1;
    const int qlo = P0 + wid * QBLK, qm = qlo + r32 - 4 * hi;
    char* V_lds = lds + L_V; char* K_lds = lds + L_K;
    float* ws = (float*)(lds + L_WS) + wid * 64; float* li_l = ws, * al_l = ws + 32;
    float m_reg = -1e30f, l_reg = 0; f32x16 o[4] = {};
    const int sr = tid >> 4, sc = (tid & 15) * 8, vst0 = v_st(sr, sc), vst1 = v_st(32 + sr, sc), kws = KLAY(sr, tid & 15), kws1 = KLAY(32 + sr, tid & 15);
    const int krw = KLAY(tid >> 3, tid & 7), qrb = wid * (NQLDS * 1024) + lane * 16, krb = r32 * 16 + hi * 1168, fbh = hi * 16;
    const int vb0 = (int)(uintptr_t)V_lds + v_rd_base(lane);
    const bf16* Kh = H.K; const bf16* Vh = H.V;
    if constexpr (BIAS) {
        const int nk4 = (P0 + QB) / 4;
        for (int i = tid; i < nk4; i += NW * 64) *(f32x4*)(lds + L_FB + i * 16) = -*(const f32x4*)(H.FS + i * 4);
        __syncthreads();
    }
#define RESC(a) do { if (__any((a) < 1.f)) { if (hi == 0) al_l[r32] = (a); asm volatile("s_waitcnt lgkmcnt(0)" ::: "memory");              \
                     for (int d_ = 0; d_ < 4; ++d_) for (int r = 0; r < 16; ++r) o[d_][r] *= al_l[crow(r, hi)]; } } while (0)
#define KBASE(t) ((t) * KVBLK)
#define MASKT(P0_, P1_, t) do { const int kb_ = KBASE(t); if (kb_ + KVBLK - 1 > qlo) mask_tile(P0_, P1_, qm - kb_); } while (0)
    f32x16 pA0, pA1, pB0, pB1; float mnA, mnB, alA, alB; bf16x8 pa0, pa1, pa2, pa3;
    SWRITE_HV(0); SBAR();
    if (NT > 1) { SLOAD_H(Kh, Vh, KBASE(1)); }
    SBAR(); qkt<0, MLA, BIAS>(pA0, pA1, lds, r32, hi, S.qr, krb, qrb, fbh + KBASE(0) * 4);
    MASKT(pA0, pA1, 0); partialSM<MLA>(pA0, pA1, m_reg, mnA, alA);
    if (NT > 1) { VMW(); SWRITE_H(1); }
    __syncthreads();
#define HALF_STEP(PX0, PX1, mnX, alX, PY0, PY1, alY, t, KB, VB, SB) do {                                                      \
        SBAR(); qkt<KB, MLA, BIAS>(PX0, PX1, lds, r32, hi, S.qr, krb, qrb, fbh + KBASE(t) * 4);                                                         \
        finishSM(PY0, PY1, alY, l_reg, pa0, pa1, pa2, pa3); SBAR();                                                           \
        if ((t) + 1 < NT) { SLOAD_H(Kh, Vh, KBASE((t) + 1)); SBAR(); }                                                        \
        pv_tile<VB>(o, vb0, pa0, pa1, pa2, pa3); MASKT(PX0, PX1, (t)); partialSM<MLA>(PX0, PX1, m_reg, mnX, alX);             \
        __syncthreads();                                                                                                      \
        if ((t) + 1 < NT) { VMW(); SWRITE_H(SB); }                                                                            \
        RESC(alX); __syncthreads(); } while (0)
    for (int t = 1; t + 1 < NT; t += 2) {
        HALF_STEP(pB0, pB1, mnB, alB, pA0, pA1, alA, t, 1, 0, 0);
        HALF_STEP(pA0, pA1, mnA, alA, pB0, pB1, alB, t + 1, 0, 1, 1);
    }
    const bool even = (NT & 1) == 0;
    if (even) { SBAR(); qkt<1, MLA, BIAS>(pB0, pB1, lds, r32, hi, S.qr, krb, qrb, fbh + KBASE(NT - 1) * 4); SBAR(); }
    finishSM(pA0, pA1, alA, l_reg, pa0, pa1, pa2, pa3); SBAR();
    pv_tile<0>(o, vb0, pa0, pa1, pa2, pa3);
    if (even) { MASKT(pB0, pB1, NT - 1); partialSM<MLA>(pB0, pB1, m_reg, mnB, alB); __syncthreads(); RESC(alB);
        finishSM(pB0, pB1, alB, l_reg, pa0, pa1, pa2, pa3); SBAR(); pv_tile<1>(o, vb0, pa0, pa1, pa2, pa3); }
    SBAR();
    const bf16* Qn = H.Q + (size_t)qb_nxt * QB * G::QP;
    SLOAD_H(Kh, Vh, 0); QLOAD_R(Qn); SBAR();
    if (hi == 0) li_l[r32] = l_reg; asm volatile("s_waitcnt lgkmcnt(0)" ::: "memory");
    float rli[16];
#pragma unroll
    for (int r = 0; r < 16; ++r) rli[r] = __builtin_amdgcn_rcpf(li_l[crow(r, hi)]);
    bf16* Ow = H.O + (size_t)(P0 + wid * QBLK) * G::OP;
#pragma unroll
    for (int r = 0; r < 16; ++r) { const int orow = crow(r, hi);
#pragma unroll
        for (int d0 = 0; d0 < 4; ++d0) { const float v = o[d0][r] * rli[r];
            const float vn = __shfl_xor(v, 1);
            if ((r32 & 1) == 0) *(unsigned*)(Ow + (size_t)orow * G::OP + d0 * 32 + r32) = cvtpk(v, vn); } }
    SBAR(); QLOAD_L(Qn); VMW(); SWRITE_HK(0); QROPE_TO_LDS();
    __syncthreads();
#undef RESC
#undef KBASE
#undef MASKT
#undef HALF_STEP
}
#undef VMW
#undef VMWN
#undef SLOAD_H
#undef SWRITE_HK
#undef SWRITE_HV
#undef SWRITE_H
#undef QLOAD_R
#undef QLOAD_L
#undef QROPE_TO_LDS
#undef PK4
}


namespace mk {
using pg8::bf16_t; using pg8::f32x4; using pg8::u32x4; using pg8::bf16x8; using pg8::Unit; using pg8::cvt_pk_bf16;
typedef GAS unsigned gu32;
#define RLX_AGENT __ATOMIC_RELAXED, __HIP_MEMORY_SCOPE_AGENT
constexpr int NWAVES = 8, NTHREADS = 512;
constexpr int NP = NP_G;
constexpr int P_CQ = 0, P_CKV = 512, P_GQ = 1024, P_GK = 1536, P_GV = 2048, P_GR = 3072, P_FQ = 4096, P_FK = 5120, P_FV = 6144, P_GATES = 7168, P_KR = 13312, P_GA = 13376, P_FL = 13392;
__host__ __device__ __forceinline__ int map_in(int n) {
    if (n < 1024) return n;
    if (n < 1088) return P_KR + (n - 1024);
    if (n < 3136) return n - 1088 + 1024;
    if (n < 3152) return P_GA + (n - 3136);
    if (n < 7248) return n - 3152 + 3072;
    if (n < 7256) return P_FL + (n - 7248);
    return n - 7256 + P_GATES;
}
__host__ __device__ __forceinline__ int rope_pos(int i) { const int half = i >> 5, jj = i & 31; return 32 * (jj >> 4) + 8 * ((jj >> 2) & 3) + 4 * half + (jj & 3); }
__host__ __device__ __forceinline__ int map_uq(int n) { const int h = n / 192, j = n % 192; return h * 256 + (j < 128 ? j : 128 + rope_pos(j - 128)); }
__host__ __device__ __forceinline__ int map_gu(int n) { const int up = n >= FFH, j = up ? n - FFH : n; return (j >> 7) * 256 + up * 128 + (j & 127); }
__host__ __device__ __forceinline__ int map_id(int n) { return n; }

constexpr size_t MiB = 1u << 20;
constexpr size_t WS_CTL = 0, CTL_ZERO_BYTES = 64 * 1024;
constexpr size_t LW_WIN = 0, LW_WUQ = 53 * MiB, LW_WUKV = 55 * MiB, LW_WBR = 57 * MiB, LW_WOUT = 69 * MiB, LW_WGU = 77 * MiB, LW_WDN = 121 * MiB, LW_BYTES = 143 * MiB;
static_assert((size_t)NP * DM * 2 == 53 * MiB && (size_t)2 * FFH * DM * 2 == 44 * MiB && (size_t)DM * FFH * 2 == 22 * MiB, "weight sizes");
constexpr size_t WS_W = 1 * MiB;
constexpr int CW_TMO = 0, CW_CODE = 1, CW_BAR = 4096, CW_QUEUE = 65536;

constexpr int RING_OFF = 0, LDS_BYTES = 163840, LDSCTL_OFF = LDS_BYTES - 512, MISC_OFF = LDSCTL_OFF + 320;

__device__ __forceinline__ float wave_sum(float v) {
#pragma unroll
    for (int o = 1; o < 64; o <<= 1) v += __shfl_xor(v, o);
    return v;
}
__device__ __forceinline__ unsigned f2bf(float f) { unsigned u = __builtin_bit_cast(unsigned, f); return (u + 0x7fffu + ((u >> 16) & 1u)) >> 16; }
__device__ __forceinline__ unsigned pk2(float lo, float hi) { return f2bf(lo) | (f2bf(hi) << 16); }
__device__ __forceinline__ float bf2f(unsigned short b) { return __builtin_bit_cast(float, (unsigned)b << 16); }
__device__ __forceinline__ float bflo(unsigned w) { return __builtin_bit_cast(float, w << 16); }
__device__ __forceinline__ float bfhi(unsigned w) { return __builtin_bit_cast(float, w & 0xffff0000u); }
__device__ __forceinline__ float fast_sigmoid(float x) { return __builtin_amdgcn_rcpf(1.f + __builtin_amdgcn_exp2f(-1.4426950408889634f * x)); }

struct EpiStoreBf16 {
    static constexpr bool PERM = true, AFTER_DRAIN = false;
    bf16_t* O; int ldc; const LAS float* RT;
    __device__ __forceinline__ void operator()(const f32x4 (&acc)[2][2][4][2], const Unit& u, int wr, int wc, int fr, int fq) const {
        const int row0 = u.pm * 256 + wr * 64 + fr, col0 = u.pn * 256 + wc * 32 + 8 * fq;
#pragma unroll
        for (int ai = 0; ai < 2; ++ai)
#pragma unroll
            for (int m = 0; m < 4; ++m) { const int row = row0 + ai * 128 + m * 16; bf16_t* rowp = O + (size_t)row * ldc + col0;
                const float r = RT[wr * 64 + fr + ai * 128 + m * 16];
#pragma unroll
                for (int bj = 0; bj < 2; ++bj) { const f32x4 v0 = acc[ai][bj][m][0] * r, v1 = acc[ai][bj][m][1] * r;
                    u32x4 w; w.x = cvt_pk_bf16(v0[0], v0[1]); w.y = cvt_pk_bf16(v0[2], v0[3]); w.z = cvt_pk_bf16(v1[0], v1[1]); w.w = cvt_pk_bf16(v1[2], v1[3]);
                    *(u32x4*)(rowp + bj * 128) = w; } }
    }
};
struct EpiSwiglu {
    static constexpr bool PERM = true, AFTER_DRAIN = false;
    bf16_t* O; int ldc; const LAS float* RT;
    __device__ __forceinline__ void operator()(const f32x4 (&acc)[2][2][4][2], const Unit& u, int wr, int wc, int fr, int fq) const {
        const int row0 = u.pm * 256 + wr * 64 + fr, col0 = u.pn * 128 + wc * 32 + 8 * fq;
#pragma unroll
        for (int ai = 0; ai < 2; ++ai)
#pragma unroll
            for (int m = 0; m < 4; ++m) { const int row = row0 + ai * 128 + m * 16; bf16_t* rowp = O + (size_t)row * ldc + col0;
                const float rs = RT[wr * 64 + fr + ai * 128 + m * 16];
                float r[8];
#pragma unroll
                for (int n = 0; n < 2; ++n)
#pragma unroll
                    for (int e = 0; e < 4; ++e) { const float g = acc[ai][0][m][n][e] * rs, up = acc[ai][1][m][n][e] * rs; r[n * 4 + e] = g * fast_sigmoid(g) * up; }
                u32x4 w; w.x = cvt_pk_bf16(r[0], r[1]); w.y = cvt_pk_bf16(r[2], r[3]); w.z = cvt_pk_bf16(r[4], r[5]); w.w = cvt_pk_bf16(r[6], r[7]);
                *(u32x4*)rowp = w; }
    }
};
struct EpiResidF32 {
    static constexpr bool PERM = false, AFTER_DRAIN = false;
    const float* R; float* C; int ldc;
    __device__ __forceinline__ void operator()(const f32x4 (&acc)[2][2][4][2], const Unit& u, int wr, int wc, int fr, int fq) const {
        const int row0 = u.pm * 256 + wr * 64 + fr, col0 = u.pn * 256 + wc * 32 + 4 * fq;
#pragma unroll
        for (int ai = 0; ai < 2; ++ai)
#pragma unroll
            for (int m = 0; m < 4; ++m) { const size_t ro = (size_t)(row0 + ai * 128 + m * 16) * ldc + col0;
#pragma unroll
                for (int bj = 0; bj < 2; ++bj)
#pragma unroll
                    for (int n = 0; n < 2; ++n) { const f32x4 r = *(const f32x4*)(R + ro + bj * 128 + n * 16); *(f32x4*)(C + ro + bj * 128 + n * 16) = r + acc[ai][bj][m][n]; } }
    }
};
struct EpiResidNorm {
    static constexpr bool PERM = true, AFTER_DRAIN = true;
    const float* R; float* C; int ldc; bf16_t* XB; float* SSP; const float* g; int emit;
    __device__ __forceinline__ void operator()(const f32x4 (&)[2][2][4][2], const Unit&, int, int, int, int) const {}
    __device__ __forceinline__ void fused(const f32x4 (&acc)[2][2][4][2], const Unit& u, int wr, int wc, int fr, int fq, LAS unsigned char* lds, int wid, int lane) const {
        LAS float* P = (LAS float*)lds;
        const int col0 = u.pn * 256 + wc * 32 + 8 * fq;
        f32x4 g0[2], g1[2];
#pragma unroll
        for (int bj = 0; bj < 2; ++bj) { g0[bj] = emit ? *(const f32x4*)(g + col0 + bj * 128) : (f32x4){0.f, 0.f, 0.f, 0.f}; g1[bj] = emit ? *(const f32x4*)(g + col0 + bj * 128 + 4) : (f32x4){0.f, 0.f, 0.f, 0.f}; }
#pragma unroll
        for (int ai = 0; ai < 2; ++ai) {
            f32x4 rv[4][2][2];
#pragma unroll
            for (int m = 0; m < 4; ++m)
#pragma unroll
                for (int bj = 0; bj < 2; ++bj) { const size_t ro = (size_t)(u.pm * 256 + ai * 128 + wr * 64 + m * 16 + fr) * ldc + col0;
                    rv[m][bj][0] = *(const f32x4*)(R + ro + bj * 128); rv[m][bj][1] = *(const f32x4*)(R + ro + bj * 128 + 4); }
#pragma unroll
            for (int m = 0; m < 4; ++m) { const int rl = ai * 128 + wr * 64 + m * 16 + fr; const size_t ro = (size_t)(u.pm * 256 + rl) * ldc + col0; float s = 0.f;
#pragma unroll
                for (int bj = 0; bj < 2; ++bj) {
                    const f32x4 x0 = rv[m][bj][0] + acc[ai][bj][m][0], x1 = rv[m][bj][1] + acc[ai][bj][m][1];
                    *(f32x4*)(C + ro + bj * 128) = x0; *(f32x4*)(C + ro + bj * 128 + 4) = x1;
                    if (emit) { s += ((x0[0] * x0[0] + x0[1] * x0[1]) + (x0[2] * x0[2] + x0[3] * x0[3])) + ((x1[0] * x1[0] + x1[1] * x1[1]) + (x1[2] * x1[2] + x1[3] * x1[3]));
                        const f32x4 y0 = x0 * g0[bj], y1 = x1 * g1[bj];
                        u32x4 w; w.x = cvt_pk_bf16(y0[0], y0[1]); w.y = cvt_pk_bf16(y0[2], y0[3]); w.z = cvt_pk_bf16(y1[0], y1[1]); w.w = cvt_pk_bf16(y1[2], y1[3]);
                        *(u32x4*)(XB + ro + bj * 128) = w; } }
                if (emit) { s += __shfl_xor(s, 16); s += __shfl_xor(s, 32); if (fq == 0) P[rl * 4 + wc] = s; } }
            asm volatile("" ::: "memory"); }
        if (emit) {
            asm volatile("s_waitcnt lgkmcnt(0)" ::: "memory"); __builtin_amdgcn_s_barrier(); asm volatile("" ::: "memory");
            const int t = wid * 64 + lane;
            if (t < 256) { const f32x4 p = *(const LAS f32x4*)(P + t * 4); SSP[(size_t)(u.pm * 256 + t) * 8 + u.pn] = (p.x + p.y) + (p.z + p.w); }
            asm volatile("s_waitcnt lgkmcnt(0)" ::: "memory"); __builtin_amdgcn_s_barrier(); asm volatile("" ::: "memory");
        }
    }
};

struct BranchOrder {
    pg8::StaticOrder T;
    __device__ void init(int G, int c) { T.init(S, DM, G, c); }
    __device__ bool next(int i, Unit& u) const { Unit t; const int n = i % 3; if (!T.next(i / 3, t)) return false; u.pm = 32 * n + t.pm; u.pn = 8 * n + t.pn; return true; }
    __device__ __forceinline__ void a_ready(const Unit&) const {}
    __device__ __forceinline__ void done(const Unit&) const {}
};
struct EpiGateMergeAll {
    static constexpr bool PERM = true, AFTER_DRAIN = false;
    const bf16_t* G; int ldg; bf16_t* PART; bf16_t* Mb; int ldc;
    __device__ __forceinline__ void operator()(const f32x4 (&acc)[2][2][4][2], const Unit& u, int wr, int wc, int fr, int fq) const {
        const int n = u.pn >> 3, pm = u.pm & 31, pn = u.pn & 7;
        const int row0 = pm * 256 + wr * 64 + fr, col0 = pn * 256 + wc * 32 + 8 * fq;
        bf16_t* dst = (n < 2) ? PART : Mb;
#pragma unroll
        for (int ai = 0; ai < 2; ++ai) {
            u32x4 gw[4][2], pw[4][2];
#pragma unroll
            for (int m = 0; m < 4; ++m)
#pragma unroll
                for (int bj = 0; bj < 2; ++bj) { const size_t row = (size_t)(row0 + ai * 128 + m * 16);
                    gw[m][bj] = *(const u32x4*)(G + row * ldg + n * DM + col0 + bj * 128);
                    pw[m][bj] = (n > 0) ? *(const u32x4*)(PART + row * ldc + col0 + bj * 128) : (u32x4){0u, 0u, 0u, 0u}; }
#pragma unroll
            for (int m = 0; m < 4; ++m)
#pragma unroll
                for (int bj = 0; bj < 2; ++bj) { const size_t row = (size_t)(row0 + ai * 128 + m * 16);
                    const u32x4 g4 = gw[m][bj], p4 = pw[m][bj];
                    f32x4 a0 = acc[ai][bj][m][0], a1 = acc[ai][bj][m][1];
                    a0[0] = fmaf(a0[0], fast_sigmoid(bflo(g4.x)), bflo(p4.x)); a0[1] = fmaf(a0[1], fast_sigmoid(bfhi(g4.x)), bfhi(p4.x)); a0[2] = fmaf(a0[2], fast_sigmoid(bflo(g4.y)), bflo(p4.y)); a0[3] = fmaf(a0[3], fast_sigmoid(bfhi(g4.y)), bfhi(p4.y));
                    a1[0] = fmaf(a1[0], fast_sigmoid(bflo(g4.z)), bflo(p4.z)); a1[1] = fmaf(a1[1], fast_sigmoid(bfhi(g4.z)), bfhi(p4.z)); a1[2] = fmaf(a1[2], fast_sigmoid(bflo(g4.w)), bflo(p4.w)); a1[3] = fmaf(a1[3], fast_sigmoid(bfhi(g4.w)), bfhi(p4.w));
                    u32x4 w; w.x = cvt_pk_bf16(a0[0], a0[1]); w.y = cvt_pk_bf16(a0[2], a0[3]); w.z = cvt_pk_bf16(a1[0], a1[1]); w.w = cvt_pk_bf16(a1[2], a1[3]);
                    *(u32x4*)(dst + row * ldc + col0 + bj * 128) = w; }
            asm volatile("" ::: "memory"); }
    }
};

struct Args {
    const float* in[21]; float* out; unsigned char* ws;
    int pro_lo, pro_hi;
    int l_lo, l_hi, ph_lo, ph_hi;
    int li, pad;
};
struct Frame {
    LAS unsigned char* lds; volatile LAS unsigned* MISC; gu32* ctl;
    int tid, lane, wave, G, vcu;
};
__device__ __forceinline__ Frame relaunder(const Frame& F0) {
    Frame F = F0; int t = F0.tid, v = F0.vcu, g = F0.G;
    asm volatile("" : "+v"(t)); asm volatile("" : "+s"(v)); asm volatile("" : "+s"(g));
    F.tid = t; F.lane = t & 63; F.wave = __builtin_amdgcn_readfirstlane(t >> 6); F.vcu = v; F.G = g; return F;
}
#ifndef MK_WSTRIDE
#define MK_WSTRIDE 0
#endif
constexpr size_t WSTRIDE = MK_WSTRIDE;
constexpr size_t WBYTES = WSTRIDE ? (size_t)DEPTH * WSTRIDE : LW_BYTES;
constexpr size_t A_PROJ = WS_W + WBYTES, A_HN = A_PROJ + 212 * MiB, A_OA = A_HN + 32 * MiB, A_OB = A_OA + 16 * MiB, A_OC = A_OB + 16 * MiB, A_MERGED = A_OC + 16 * MiB,
                 A_CQN = A_MERGED + 64 * MiB, A_MQ = A_CQN + 16 * MiB, A_MK = A_MQ + 24 * MiB, A_MV = A_MK + 24 * MiB, A_FQ = A_MV + 16 * MiB, A_FK = A_FQ + 16 * MiB, A_FCUM = A_FK + 16 * MiB,
                 A_QT = A_FCUM + 1 * MiB, A_KT = A_QT + 8 * MiB, A_BLAST = A_KT + 8 * MiB, A_KVP = A_BLAST + 1 * MiB, A_SPREV = A_KVP + 64 * MiB, A_CS = A_SPREV + 32 * MiB, A_KRR = A_CS + 2 * MiB,
                 A_KRSS = A_KRR + 2 * MiB, A_HN2 = A_KRSS + 1 * MiB, A_SSPA = A_HN2 + 32 * MiB, A_SSPB = A_SSPA + 1 * MiB, A_END = A_SSPB + 1 * MiB;
typedef const __attribute__((address_space(4))) Args* ArgsP;
__device__ __forceinline__ int lnd_s(int v) { asm volatile("" : "+s"(v)); return v; }
__device__ __forceinline__ int lnd_v(int v) { asm volatile("" : "+v"(v)); return v; }
#define WSP(T, off) ((T*)(a->ws + (off)))
__device__ __forceinline__ ArgsP get_args() { ArgsP p = (ArgsP)__builtin_amdgcn_kernarg_segment_ptr(); asm volatile("" : "+s"(p)); return p; }

constexpr int I_IN = (DM / 64) * ((D_IN + 63) / 64), I_UQ = (512 / 64) * (1536 / 64), I_UKV = (512 / 64) * (2048 / 64), I_BR = (1024 / 64) * (DM / 64), I_OUT = (DM / 64) * (DM / 64),
              I_GU = (DM / 64) * (2 * FFH / 64), I_DN = (FFH / 64) * (DM / 64);
constexpr int NITEMS = I_IN + I_UQ + I_UKV + 3 * I_BR + I_OUT + I_GU + I_DN;
struct CvItem { const float* src; bf16_t* dst; int K, N, k0, n0, kind; };
__device__ __forceinline__ CvItem cv_decode(ArgsP a, int l, int r) {
    unsigned char* wb = a->ws + WS_W + (size_t)l * WSTRIDE;
    CvItem it;
    if (r < I_IN) { it.src = a->in[3] + (size_t)l * DM * D_IN; it.dst = (bf16_t*)(wb + LW_WIN); it.K = DM; it.N = D_IN; it.kind = 1; }
    else if ((r -= I_IN) < I_UQ) { it.src = a->in[5] + (size_t)l * 512 * 1536; it.dst = (bf16_t*)(wb + LW_WUQ); it.K = 512; it.N = 1536; it.kind = 2; }
    else if ((r -= I_UQ) < I_UKV) { it.src = a->in[7] + (size_t)l * 512 * 2048; it.dst = (bf16_t*)(wb + LW_WUKV); it.K = 512; it.N = 2048; it.kind = 0; }
    else if ((r -= I_UKV) < 3 * I_BR) { const int n = r / I_BR; r -= n * I_BR; it.src = a->in[16] + (size_t)(l * 3 + n) * 1024 * DM; it.dst = (bf16_t*)(wb + LW_WBR) + (size_t)n * DM * 1024; it.K = 1024; it.N = DM; it.kind = 0; }
    else if ((r -= 3 * I_BR) < I_OUT) { it.src = a->in[17] + (size_t)l * DM * DM; it.dst = (bf16_t*)(wb + LW_WOUT); it.K = DM; it.N = DM; it.kind = 0; }
    else if ((r -= I_OUT) < I_GU) { it.src = a->in[19] + (size_t)l * DM * 2 * FFH; it.dst = (bf16_t*)(wb + LW_WGU); it.K = DM; it.N = 2 * FFH; it.kind = 3; }
    else { r -= I_GU; it.src = a->in[20] + (size_t)l * FFH * DM; it.dst = (bf16_t*)(wb + LW_WDN); it.K = FFH; it.N = DM; it.kind = 0; }
    const int nblk = (it.N + 63) >> 6, kb = r / nblk, nb = r - kb * nblk; it.k0 = 64 * kb; it.n0 = 64 * nb;
    return it;
}
__device__ __forceinline__ void cv_load(const CvItem& it, int lane, f32x4 (&v)[8][2]) {
    const int n4 = lane & 15, kq = lane >> 4, n = it.n0 + 4 * n4;
    const bool ok = n < it.N;
    const float* src = it.src + (size_t)(it.k0 + 2 * kq) * it.N + n;
#pragma unroll
    for (int ii = 0; ii < 8; ++ii)
#pragma unroll
        for (int t = 0; t < 2; ++t) v[ii][t] = ok ? __builtin_nontemporal_load((const f32x4*)(src + (size_t)(8 * ii + t) * it.N)) : (f32x4){0.f, 0.f, 0.f, 0.f};
}
__device__ __forceinline__ void cv_store(const CvItem& it, const f32x4 (&v)[8][2], LAS unsigned* scr, int lane) {
    const int n4 = lane & 15, kq = lane >> 4;
#pragma unroll
    for (int ii = 0; ii < 8; ++ii)
#pragma unroll
        for (int e = 0; e < 4; ++e) scr[(4 * n4 + e) * 34 + kq + 4 * ii] = cvt_pk_bf16(v[ii][0][e], v[ii][1][e]);
    asm volatile("s_waitcnt lgkmcnt(0)" ::: "memory");
    const int c8 = lane & 7;
#pragma unroll
    for (int j = 0; j < 8; ++j) { const int nn = (lane >> 3) + 8 * j, n = it.n0 + nn;
        typedef unsigned u32x2 __attribute__((ext_vector_type(2)));
        const u32x2 lo = *(const LAS u32x2*)(scr + nn * 34 + 4 * c8), hi2 = *(const LAS u32x2*)(scr + nn * 34 + 4 * c8 + 2);
        const int dr = it.kind == 0 ? n : (it.kind == 1 ? map_in(n) : (it.kind == 2 ? map_uq(n) : map_gu(n)));
        if (n < it.N) *(u32x4*)(it.dst + (size_t)dr * it.K + it.k0 + 8 * c8) = (u32x4){lo.x, lo.y, hi2.x, hi2.y}; }
    asm volatile("s_waitcnt lgkmcnt(0)" ::: "memory");
}
__device__ __forceinline__ void cv_run(ArgsP a, int l0, int first, int stride, int count, LAS unsigned* scr, int lane, int P = NITEMS, int OFF = 0) {
    if (count <= 0) return;
    CvItem cur = cv_decode(a, l0 + first / P, OFF + first % P);
    f32x4 v[8][2]; cv_load(cur, lane, v);
    for (int i = 1; i <= count; ++i) {
        CvItem nxt = cur; f32x4 w[8][2];
        if (i < count) { const int r = first + i * stride; nxt = cv_decode(a, l0 + r / P, OFF + r % P); cv_load(nxt, lane, w); }
        cv_store(cur, v, scr, lane);
        if (i < count) { cur = nxt;
#pragma unroll
            for (int ii = 0; ii < 8; ++ii) { v[ii][0] = w[ii][0]; v[ii][1] = w[ii][1]; } }
    }
}
constexpr int CV_W1 = 96, CV_R1 = 7, CV_B1 = 0, CV_W4 = 128, CV_R4 = 6, CV_B4 = CV_B1 + CV_W1 * CV_R1 * 8, CV_W8 = 128, CV_R8 = 7, CV_B8 = CV_B4 + CV_W4 * CV_R4 * 8;
constexpr int CV_END = (CV_B8 + CV_W8 * CV_R8 * 8) < NITEMS ? (CV_B8 + CV_W8 * CV_R8 * 8) : NITEMS, CV_TAIL = NITEMS - CV_END;
__device__ __forceinline__ void prologue_weights(const Frame& F0, int l_lo, int l_hi) {
    const Frame F = relaunder(F0);
    ArgsP a = get_args();
    LAS unsigned* scr = (LAS unsigned*)(F.lds + RING_OFF + F.wave * 16384);
    const int gw = F.vcu * NWAVES + F.wave, NGW = F.G * NWAVES, total = (l_hi - l_lo) * NITEMS;
    cv_run(a, l_lo, gw, NGW, gw < total ? (total - gw + NGW - 1) / NGW : 0, scr, F.lane);
    if (l_hi - l_lo == 1 && l_lo == 0 && CV_TAIL > 0) {
        const int tot2 = (DEPTH - 1) * CV_TAIL, g2 = (gw + NGW / 2) % NGW;
        cv_run(a, 1, g2, NGW, g2 < tot2 ? (tot2 - g2 + NGW - 1) / NGW : 0, scr, F.lane, CV_TAIL, CV_END);
    }
}
__device__ __forceinline__ void convert_slice(const Frame& F0, int l, int base, int rank, int W, int R) {
    if (l >= DEPTH) return;
    const Frame F = relaunder(F0);
    ArgsP a = get_args();
    LAS unsigned* scr = (LAS unsigned*)(F.lds + RING_OFF + F.wave * 16384);
    const int first = base + rank * 8 + F.wave, stride = W * 8;
    int count = 0; if (first < NITEMS) { count = (NITEMS - first + stride - 1) / stride; if (count > R) count = R; }
    cv_run(a, l, first, stride, count, scr, F.lane);
}
__device__ __forceinline__ void phase_rms0(const Frame& F0, const float* X, const float* g, bf16_t* O, float* SSP) {
    const Frame F = relaunder(F0);
    const int gw = F.vcu * NWAVES + F.wave, NGW = F.G * NWAVES, lane = F.lane;
    for (int m = gw; m < S; m += NGW) {
        const f32x4* xr = (const f32x4*)(X + (size_t)m * DM) + lane; const f32x4* gr = (const f32x4*)g + lane;
        f32x4 v[8]; float s = 0.f;
#pragma unroll
        for (int j = 0; j < 8; ++j) { v[j] = xr[64 * j]; s += (v[j].x * v[j].x + v[j].y * v[j].y) + (v[j].z * v[j].z + v[j].w * v[j].w); }
        s = wave_sum(s);
        unsigned long long* o8 = (unsigned long long*)(O + (size_t)m * DM) + lane;
#pragma unroll
        for (int j = 0; j < 8; ++j) { const f32x4 gg = gr[64 * j];
            o8[64 * j] = (unsigned long long)pk2(v[j].x * gg.x, v[j].y * gg.y) | ((unsigned long long)pk2(v[j].z * gg.z, v[j].w * gg.w) << 32); }
        if (lane < 2) *(f32x4*)(SSP + (size_t)m * 8 + 4 * lane) = (f32x4){lane == 0 ? s : 0.f, 0.f, 0.f, 0.f};
    }
}
constexpr int RT_OFF = 131072;
__device__ __forceinline__ int first_unit_pm(int nN, int G, int cidx) {
    const int nM = S / 256, nwg = nM * nN; if (cidx >= nwg) return -1;
    int wgid = cidx; { const int q = nwg / pg8::NXCD, r = nwg % pg8::NXCD, xcd = wgid % pg8::NXCD, off = wgid / pg8::NXCD; wgid = (xcd < r ? xcd * (q + 1) : r * (q + 1) + (xcd - r) * q) + off; }
    const int nig = pg8::WGM * nN, gid = wgid / nig, fm = gid * pg8::WGM, gsz = (nM - fm) < pg8::WGM ? (nM - fm) : pg8::WGM;
    return fm + ((wgid % nig) % gsz);
}
__device__ __forceinline__ void fill_rstd_table(const Frame& F0, const float* SSP, int pm) {
    const Frame F = relaunder(F0);
    if (F.tid < 256) { const int row = pm * 256 + F.tid;
        const f32x4 s0 = *(const f32x4*)(SSP + (size_t)row * 8), s1 = *(const f32x4*)(SSP + (size_t)row * 8 + 4);
        ((LAS float*)(F.lds + RT_OFF))[F.tid] = rsqrtf((((s0.x + s0.y) + (s0.z + s0.w)) + ((s1.x + s1.y) + (s1.z + s1.w))) * (1.f / DM) + EPS); }
    __syncthreads();
}

__device__ __forceinline__ float log_sigmoid_f(float x) { return fminf(x, 0.f) - __logf(1.f + __expf(-fabsf(x))); }
__device__ __forceinline__ void unpack8(const u32x4 w, float (&f)[8]) {
    f[0] = bflo(w.x); f[1] = bfhi(w.x); f[2] = bflo(w.y); f[3] = bfhi(w.y); f[4] = bflo(w.z); f[5] = bfhi(w.z); f[6] = bflo(w.w); f[7] = bfhi(w.w);
}
__device__ __forceinline__ u32x4 pack8f(const float (&f)[8]) { u32x4 w; w.x = cvt_pk_bf16(f[0], f[1]); w.y = cvt_pk_bf16(f[2], f[3]); w.z = cvt_pk_bf16(f[4], f[5]); w.w = cvt_pk_bf16(f[6], f[7]); return w; }

__device__ __forceinline__ void sincos_d(double a, double& sn, double& cn) {
    const double TWO_PI = 6.283185307179586476925286766559, HALF_PI = 1.5707963267948966192313216916398;
    const double k = rint(a / TWO_PI); double r = a - k * TWO_PI;
    const double q = rint(r / HALF_PI); r = r - q * HALF_PI; const int qi = ((int)q) & 3;
    const double r2 = r * r;
    const double sp = r * (1.0 + r2 * (-1.0 / 6 + r2 * (1.0 / 120 + r2 * (-1.0 / 5040 + r2 * (1.0 / 362880 + r2 * (-1.0 / 39916800 + r2 * (1.0 / 6227020800.0)))))));
    const double cp = 1.0 + r2 * (-0.5 + r2 * (1.0 / 24 + r2 * (-1.0 / 720 + r2 * (1.0 / 40320 + r2 * (-1.0 / 3628800 + r2 * (1.0 / 479001600.0 + r2 * (-1.0 / 87178291200.0)))))));
    if (qi == 0) { sn = sp; cn = cp; } else if (qi == 1) { sn = cp; cn = -sp; } else if (qi == 2) { sn = -sp; cn = -cp; } else { sn = -cp; cn = sp; }
}
__device__ __forceinline__ void rope_tables(const Frame& F0) {
    const Frame F = relaunder(F0);
    ArgsP a = get_args(); const int* pos = (const int*)a->in[1]; float* CS = WSP(float, A_CS);
    for (int i = F.vcu * NTHREADS + F.tid; i < S * 32; i += F.G * NTHREADS) {
        const int s = i >> 5, f = i & 31;
        const float inv = (float)exp2(-(double)f / 32.0 * 13.287712379549449391481277717958);
        const float ang = (float)pos[s] * inv;
        double sn, cn; sincos_d((double)ang, sn, cn);
        CS[s * 64 + f] = (float)cn; CS[s * 64 + 32 + f] = (float)sn;
    }
}

__device__ __forceinline__ void prep_row(int lane, int row, int l, ArgsP a) {
    const bf16_t* pr = WSP(bf16_t, A_PROJ) + (size_t)row * NP;
    const u32x4 cw0 = *(const u32x4*)(pr + P_CQ + 16 * lane), cw1 = *(const u32x4*)(pr + P_CQ + 16 * lane + 8);
    const u32x4 qw0 = *(const u32x4*)(pr + P_FQ + 16 * lane), qw1 = *(const u32x4*)(pr + P_FQ + 16 * lane + 8);
    const u32x4 kw0 = *(const u32x4*)(pr + P_FK + 16 * lane), kw1 = *(const u32x4*)(pr + P_FK + 16 * lane + 8);
    const float krv = bf2f(pr[P_KR + lane]);
    const float* cs = WSP(float, A_CS) + (size_t)row * 64;
    const float cc = cs[lane & 31], sn = cs[32 + (lane & 31)];
    {
        float v0[8], v1[8]; unpack8(cw0, v0); unpack8(cw1, v1);
        float s = 0.f;
#pragma unroll
        for (int i = 0; i < 8; ++i) s += v0[i] * v0[i] + v1[i] * v1[i];
#pragma unroll
        for (int o = 1; o < 32; o <<= 1) s += __shfl_xor(s, o);
        const float r = rsqrtf(s * (1.f / 512.f) + EPS);
        const float* g = (lane < 32) ? (a->in[4] + l * 512 + 16 * lane) : (a->in[6] + l * 512 + 16 * (lane - 32));
#pragma unroll
        for (int i = 0; i < 8; ++i) { v0[i] *= r * g[i]; v1[i] *= r * g[8 + i]; }
        bf16_t* op = WSP(bf16_t, A_CQN) + (size_t)row * 1024 + 16 * lane;
        *(u32x4*)op = pack8f(v0); *(u32x4*)(op + 8) = pack8f(v1);
    }
    {
        const float ss = wave_sum(krv * krv);
        const float y = krv * (a->in[9][l * 192 + 128 + lane]);
        const float yo = __shfl_xor(y, 32);
        WSP(float, A_KRR)[(size_t)row * 64 + rope_pos(lane)] = (lane < 32) ? (y * cc - yo * sn) : (y * cc + yo * sn);
        if (lane == 0) WSP(float, A_KRSS)[row] = ss;
    }
#pragma unroll
    for (int which = 0; which < 2; ++which) {
        float v0[8], v1[8]; unpack8(which ? kw0 : qw0, v0); unpack8(which ? kw1 : qw1, v1);
        float s = 0.f;
#pragma unroll
        for (int i = 0; i < 8; ++i) s += v0[i] * v0[i] + v1[i] * v1[i];
        s += __shfl_xor(s, 1); s += __shfl_xor(s, 2); s += __shfl_xor(s, 4);
        const float r = rsqrtf(s * (1.f / 128.f) + EPS);
        const float* g = a->in[which ? 14 : 13] + l * 128 + 16 * (lane & 7);
#pragma unroll
        for (int i = 0; i < 8; ++i) { v0[i] *= r * g[i]; v1[i] *= r * g[8 + i]; }
        bf16_t* op = WSP(bf16_t, which ? A_FK : A_FQ) + ((size_t)(lane >> 3) * S + row) * 128 + 16 * (lane & 7);
        *(u32x4*)op = pack8f(v0); *(u32x4*)(op + 8) = pack8f(v1);
    }
}
__device__ __forceinline__ void fox_cumsum(const Frame& F, int h, int l, ArgsP a) {
    LAS float* tot = (LAS float*)(F.lds);
    const bf16_t* P = WSP(bf16_t, A_PROJ) + P_FL + h; const float bf = a->in[15][l * 8 + h];
    const int t = F.tid; float v[16]; float run = 0.f;
    unsigned short raw[16];
#pragma unroll
    for (int i = 0; i < 16; ++i) raw[i] = P[(size_t)(t * 16 + i) * NP];
    asm volatile("" ::: "memory");
#pragma unroll
    for (int i = 0; i < 16; ++i) { run += log_sigmoid_f(bf2f(raw[i]) + bf); v[i] = run; }
    float inc = run;
#pragma unroll
    for (int o = 1; o < 64; o <<= 1) { const float n = __shfl_up(inc, o); if (F.lane >= o) inc += n; }
    if (F.lane == 63) tot[F.wave] = inc;
    __syncthreads();
    float woff = 0.f;
    for (int w = 0; w < F.wave; ++w) woff += tot[w];
    const float off = woff + inc - run;
    float* O = WSP(float, A_FCUM) + (size_t)h * S + t * 16;
#pragma unroll
    for (int i = 0; i < 16; ++i) O[i] = (v[i] + off) * 11.313708498984761f;
    __syncthreads();
}
__device__ __forceinline__ void gla_prep_unit(const Frame& F, int chunk, int h, int l, ArgsP a) {
    using namespace att;
    const int tid = lnd_v(F.tid), lane = tid & 63, w = __builtin_amdgcn_readfirstlane(tid >> 6), r32 = lane & 31, hi = lane >> 5, row0 = chunk * 64;
    char* lds = (char*)F.lds;
    char* Vl = lds;
    char* Kl = lds + 2 * SHM_V;
    float* LA = (float*)(lds + 3 * SHM_V);
    float* WA = (float*)(lds + 3 * SHM_V + 32768);
    float* GA = (float*)(lds + 3 * SHM_V + 32768 + 8192);
    float* TOT = (float*)(lds + 3 * SHM_V + 32768 + 8192 + 4096);
    const mk::bf16_t* PR = WSP(mk::bf16_t, A_PROJ) + (size_t)row0 * NP;
    if (tid < 128) { const int r = tid >> 1, hf = tid & 1; const u32x4 wv = *(const u32x4*)(PR + (size_t)r * NP + P_GA + 8 * hf); float t[8]; mk::unpack8(wv, t);
#pragma unroll
        for (int i = 0; i < 8; ++i) GA[r * 16 + 8 * hf + i] = t[i]; }
    { const int k = tid >> 5, d4 = (tid & 31) * 4; *(f32x4*)(WA + k * 128 + d4) = *(const f32x4*)(a->in[10] + (size_t)l * 16 * 512 + k * 512 + h * 128 + d4); }
    const int sr = tid >> 4, sc = (tid & 15) * 8, vst0 = v_st(sr, sc), vst1 = v_st(32 + sr, sc);
    { const bf16x8 v00 = load8(PR + (size_t)sr * NP + P_GV + h * 256 + sc), v01 = load8(PR + (size_t)(32 + sr) * NP + P_GV + h * 256 + sc);
      const bf16x8 v10 = load8(PR + (size_t)sr * NP + P_GV + h * 256 + 128 + sc), v11 = load8(PR + (size_t)(32 + sr) * NP + P_GV + h * 256 + 128 + sc);
      *(bf16x8*)(Vl + vst0) = v00; *(bf16x8*)(Vl + vst1) = v01; *(bf16x8*)(Vl + SHM_V + vst0) = v10; *(bf16x8*)(Vl + SHM_V + vst1) = v11; }
    __syncthreads();
    const int dg = tid & 15, jq = tid >> 4;
    {   float x0[8], x1[8];
        const f32x4 b0 = *(const f32x4*)(a->in[11] + l * 512 + h * 128 + dg * 8), b1 = *(const f32x4*)(a->in[11] + l * 512 + h * 128 + dg * 8 + 4);
#pragma unroll
        for (int i = 0; i < 4; ++i) { x0[i] = b0[i]; x0[4 + i] = b1[i]; x1[i] = b0[i]; x1[4 + i] = b1[i]; }
#pragma unroll
        for (int k = 0; k < 16; ++k) { const f32x4 w0 = *(const f32x4*)(WA + k * 128 + dg * 8), w1 = *(const f32x4*)(WA + k * 128 + dg * 8 + 4);
            const float g0 = GA[(2 * jq) * 16 + k], g1 = GA[(2 * jq + 1) * 16 + k];
#pragma unroll
            for (int i = 0; i < 4; ++i) { x0[i] = fmaf(g0, w0[i], x0[i]); x0[4 + i] = fmaf(g0, w1[i], x0[4 + i]); x1[i] = fmaf(g1, w0[i], x1[i]); x1[4 + i] = fmaf(g1, w1[i], x1[4 + i]); } }
#pragma unroll
        for (int i = 0; i < 8; ++i) { x0[i] = mk::log_sigmoid_f(x0[i]) * (1.f / 16.f); x1[i] = mk::log_sigmoid_f(x1[i]) * (1.f / 16.f); }
        *(f32x4*)(LA + (2 * jq) * 128 + dg * 8) = (f32x4){x0[0], x0[1], x0[2], x0[3]}; *(f32x4*)(LA + (2 * jq) * 128 + dg * 8 + 4) = (f32x4){x0[4], x0[5], x0[6], x0[7]};
        *(f32x4*)(LA + (2 * jq + 1) * 128 + dg * 8) = (f32x4){x1[0], x1[1], x1[2], x1[3]}; *(f32x4*)(LA + (2 * jq + 1) * 128 + dg * 8 + 4) = (f32x4){x1[4], x1[5], x1[6], x1[7]};
    }
    __syncthreads();
    { const int d = tid & 127, q = tid >> 7; float run = 0.f;
#pragma unroll
      for (int j = 0; j < 16; ++j) { run += LA[(16 * q + j) * 128 + d]; LA[(16 * q + j) * 128 + d] = run; }
      TOT[q * 128 + d] = run;
      __syncthreads();
      float off = 0.f;
      for (int qq = 0; qq < q; ++qq) off += TOT[qq * 128 + d];
      if (q > 0) {
#pragma unroll
          for (int j = 0; j < 16; ++j) LA[(16 * q + j) * 128 + d] += off; }
      if (q == 3) WSP(float, A_BLAST)[chunk * 512 + h * 128 + d] = run + off; }
    __syncthreads();
#pragma unroll
    for (int rr = 0; rr < 2; ++rr) { const int j = 2 * jq + rr;
        const u32x4 qw = *(const u32x4*)(PR + (size_t)j * NP + P_GQ + h * 128 + dg * 8), kw = *(const u32x4*)(PR + (size_t)j * NP + P_GK + h * 128 + dg * 8);
        float qv[8], kv[8]; mk::unpack8(qw, qv); mk::unpack8(kw, kv);
        const f32x4 c0 = *(const f32x4*)(LA + j * 128 + dg * 8), c1 = *(const f32x4*)(LA + j * 128 + dg * 8 + 4);
#pragma unroll
        for (int i = 0; i < 8; ++i) { const float bb = i < 4 ? c0[i] : c1[i - 4]; qv[i] *= 0.08838834764831845f * __expf(bb); kv[i] *= __expf(-bb); }
        const u32x4 qo = mk::pack8f(qv), ko = mk::pack8f(kv);
        *(u32x4*)(WSP(mk::bf16_t, A_QT) + (size_t)(row0 + j) * 512 + h * 128 + dg * 8) = qo;
        *(u32x4*)(WSP(mk::bf16_t, A_KT) + (size_t)(row0 + j) * 512 + h * 128 + dg * 8) = ko;
        *(u32x4*)(Kl + v_st(j, dg * 8)) = ko; }
    __syncthreads();
    {   const int vb = (int)(uintptr_t)Vl + v_rd_base(lane) + (w >> 2) * SHM_V + (w & 3) * 512;
        const int kb = (int)(uintptr_t)Kl + v_rd_base(lane);
#define TRRDV(dst, off) asm volatile("ds_read_b64_tr_b16 %0, %1 offset:%2" : "=&v"(dst) : "v"(vb), "i"(off) : "memory")
#define TRRDK(dst, off) asm volatile("ds_read_b64_tr_b16 %0, %1 offset:%2" : "=&v"(dst) : "v"(kb), "i"(off) : "memory")
        s16x4 vl0, vl1, vl2, vl3, vh0, vh1, vh2, vh3;
        TRRDV(vl0, 0); TRRDV(vh0, 2048); TRRDV(vl1, 4096); TRRDV(vh1, 6144); TRRDV(vl2, 8192); TRRDV(vh2, 10240); TRRDV(vl3, 12288); TRRDV(vh3, 14336);
        mk::bf16_t* O = WSP(mk::bf16_t, A_KVP) + ((size_t)(chunk * 4 + h) * 256 + w * 32 + r32) * 128 + 4 * hi;
#define KV_DB(db) do { s16x4 l0, l1, l2, l3, h0, h1, h2, h3; constexpr int b_ = (db) * 512;                                                                                                       \
            TRRDK(l0, b_); TRRDK(h0, b_ + 2048); TRRDK(l1, b_ + 4096); TRRDK(h1, b_ + 6144); TRRDK(l2, b_ + 8192); TRRDK(h2, b_ + 10240); TRRDK(l3, b_ + 12288); TRRDK(h3, b_ + 14336);         \
            asm volatile("s_waitcnt lgkmcnt(0)" ::: "memory"); SBAR();                                                                                                                          \
            f32x16 c = {};                                                                                                                                                                      \
            c = __builtin_amdgcn_mfma_f32_32x32x16_bf16((bf16x8){l0[0], l0[1], l0[2], l0[3], h0[0], h0[1], h0[2], h0[3]}, (bf16x8){vl0[0], vl0[1], vl0[2], vl0[3], vh0[0], vh0[1], vh0[2], vh0[3]}, c, 0, 0, 0);   \
            c = __builtin_amdgcn_mfma_f32_32x32x16_bf16((bf16x8){l1[0], l1[1], l1[2], l1[3], h1[0], h1[1], h1[2], h1[3]}, (bf16x8){vl1[0], vl1[1], vl1[2], vl1[3], vh1[0], vh1[1], vh1[2], vh1[3]}, c, 0, 0, 0);   \
            c = __builtin_amdgcn_mfma_f32_32x32x16_bf16((bf16x8){l2[0], l2[1], l2[2], l2[3], h2[0], h2[1], h2[2], h2[3]}, (bf16x8){vl2[0], vl2[1], vl2[2], vl2[3], vh2[0], vh2[1], vh2[2], vh2[3]}, c, 0, 0, 0);   \
            c = __builtin_amdgcn_mfma_f32_32x32x16_bf16((bf16x8){l3[0], l3[1], l3[2], l3[3], h3[0], h3[1], h3[2], h3[3]}, (bf16x8){vl3[0], vl3[1], vl3[2], vl3[3], vh3[0], vh3[1], vh3[2], vh3[3]}, c, 0, 0, 0);   \
                                                                                       \
            _Pragma("unroll") for (int g_ = 0; g_ < 4; ++g_) { typedef unsigned u32x2_ __attribute__((ext_vector_type(2))); *(u32x2_*)(O + (db) * 32 + 8 * g_) = (u32x2_){cvtpk_c(c[4 * g_], c[4 * g_ + 1]), cvtpk_c(c[4 * g_ + 2], c[4 * g_ + 3])}; } } while (0)
        KV_DB(0); KV_DB(1); KV_DB(2); KV_DB(3);
#undef KV_DB
#undef TRRDV
#undef TRRDK
    }
    __syncthreads();
}
__device__ __forceinline__ void phase_prep(const Frame& F0, int l) {
    const Frame F = relaunder(F0);
    ArgsP a = get_args();
    const int v = lnd_s(F.vcu);
    for (int u = v; u < 512; u += F.G) gla_prep_unit(F, u >> 2, u & 3, l, a);
    for (int u = v; u < 136; u += F.G) if (u >= 128) fox_cumsum(F, u - 128, l, a);
    const int gw = lnd_s(F.vcu * NWAVES + F.wave), NGW = F.G * NWAVES, lane = lnd_v(F.lane);
    for (int m = gw; m < S; m += NGW) prep_row(lane, m, l, a);
}

__device__ __forceinline__ void gla_scan(const Frame& F0) {
    const Frame F = relaunder(F0);
    ArgsP a = get_args();
    typedef float f32x2 __attribute__((ext_vector_type(2)));
    const bf16_t* KVP = WSP(bf16_t, A_KVP); const float* BL = WSP(float, A_BLAST); bf16_t* SP = WSP(bf16_t, A_SPREV);
    if (F.tid < 256)
    for (int e = lnd_s(F.vcu) * 256 + lnd_v(F.tid); e < 4 * 256 * 64; e += F.G * 256) {
        const int dp = e & 63, hc = e >> 6, h = hc >> 8;
        f32x2 st = {0.f, 0.f};
#pragma unroll 32
        for (int c = 0; c < 128; ++c) {
            const size_t o = ((size_t)c * 1024 + hc) * 128 + 2 * dp;
            const unsigned kw = *(const unsigned*)(KVP + o); const f32x2 kv = {bflo(kw), bfhi(kw)}; const f32x2 bl = *(const f32x2*)(BL + c * 512 + h * 128 + 2 * dp);
            *(unsigned*)(SP + o) = cvt_pk_bf16(st.x, st.y);
            st.x = __expf(bl.x) * (st.x + kv.x); st.y = __expf(bl.y) * (st.y + kv.y);
        }
    }
}

struct EpiMlaQ {
    static constexpr bool PERM = true, AFTER_DRAIN = true;
    bf16_t* MQ; const float* g; const float* CS;
    __device__ __forceinline__ void operator()(const f32x4 (&)[2][2][4][2], const Unit&, int, int, int, int) const {}
    __device__ __forceinline__ void fused(const f32x4 (&acc)[2][2][4][2], const Unit& u, int wr, int wc, int fr, int fq, LAS unsigned char* lds, int wid, int lane) const {
        LAS float* P = (LAS float*)lds;
#pragma unroll
        for (int ai = 0; ai < 2; ++ai)
#pragma unroll
            for (int m = 0; m < 4; ++m) { float s = 0.f;
#pragma unroll
                for (int n = 0; n < 2; ++n) { const f32x4 x = acc[ai][0][m][n]; s += (x[0] * x[0] + x[1] * x[1]) + (x[2] * x[2] + x[3] * x[3]);
                    if (wc < 2) { const f32x4 y = acc[ai][1][m][n]; s += (y[0] * y[0] + y[1] * y[1]) + (y[2] * y[2] + y[3] * y[3]); } }
                s += __shfl_xor(s, 16); s += __shfl_xor(s, 32);
                if (fq == 0) P[(ai * 128 + wr * 64 + m * 16 + fr) * 4 + wc] = s; }
        asm volatile("s_waitcnt lgkmcnt(0)" ::: "memory"); __builtin_amdgcn_s_barrier(); asm volatile("" ::: "memory");
        const int h = u.pn;
        const f32x4 g0 = *(const f32x4*)(g + 32 * wc + 8 * fq), g1 = *(const f32x4*)(g + 32 * wc + 8 * fq + 4);
        f32x4 gr1 = {0.f, 0.f, 0.f, 0.f}, gr2 = gr1;
        if (wc < 2) { gr1 = *(const f32x4*)(g + 128 + 16 * wc + 4 * fq); gr2 = *(const f32x4*)(g + 160 + 16 * wc + 4 * fq); }
#pragma unroll
        for (int ai = 0; ai < 2; ++ai)
#pragma unroll
            for (int m = 0; m < 4; ++m) { const int rl = ai * 128 + wr * 64 + m * 16 + fr; const int row = u.pm * 256 + rl;
                const f32x4 pp = *(const LAS f32x4*)(P + rl * 4);
                const float r = rsqrtf(((pp.x + pp.y) + (pp.z + pp.w)) * (1.f / 192.f) + EPS);
                bf16_t* ob = MQ + ((size_t)h * S + row) * 192;
                { const f32x4 a0 = acc[ai][0][m][0] * r * g0, a1 = acc[ai][0][m][1] * r * g1;
                  u32x4 w; w.x = cvt_pk_bf16(a0[0], a0[1]); w.y = cvt_pk_bf16(a0[2], a0[3]); w.z = cvt_pk_bf16(a1[0], a1[1]); w.w = cvt_pk_bf16(a1[2], a1[3]);
                  *(u32x4*)(ob + 32 * wc + 8 * fq) = w; }
                if (wc < 2) { const f32x4 y1 = acc[ai][1][m][0] * r * gr1, y2 = acc[ai][1][m][1] * r * gr2;
                  const f32x4 c = *(const f32x4*)(CS + (size_t)row * 64 + 16 * wc + 4 * fq), sn = *(const f32x4*)(CS + (size_t)row * 64 + 32 + 16 * wc + 4 * fq);
                  const f32x4 o1 = y1 * c - y2 * sn, o2 = y2 * c + y1 * sn;
                  u32x4 w; w.x = cvt_pk_bf16(o1[0], o1[1]); w.y = cvt_pk_bf16(o1[2], o1[3]); w.z = cvt_pk_bf16(o2[0], o2[1]); w.w = cvt_pk_bf16(o2[2], o2[3]);
                  *(u32x4*)(ob + 128 + 32 * wc + 8 * fq) = w; }
                asm volatile("" ::: "memory"); }
        asm volatile("s_waitcnt lgkmcnt(0)" ::: "memory"); __builtin_amdgcn_s_barrier(); asm volatile("" ::: "memory");
    }
};
struct EpiMlaKV {
    static constexpr bool PERM = true, AFTER_DRAIN = true;
    bf16_t* MK; bf16_t* MV; const float* g; const float* KRR; const float* KRSS;
    __device__ __forceinline__ void operator()(const f32x4 (&)[2][2][4][2], const Unit&, int, int, int, int) const {}
    __device__ __forceinline__ void fused(const f32x4 (&acc)[2][2][4][2], const Unit& u, int wr, int wc, int fr, int fq, LAS unsigned char* lds, int wid, int lane) const {
        LAS float* P = (LAS float*)lds;
#pragma unroll
        for (int ai = 0; ai < 2; ++ai)
#pragma unroll
            for (int m = 0; m < 4; ++m) { float s = 0.f;
#pragma unroll
                for (int n = 0; n < 2; ++n) { const f32x4 x = acc[ai][0][m][n]; s += (x[0] * x[0] + x[1] * x[1]) + (x[2] * x[2] + x[3] * x[3]); }
                s += __shfl_xor(s, 16); s += __shfl_xor(s, 32);
                if (fq == 0) P[(ai * 128 + wr * 64 + m * 16 + fr) * 4 + wc] = s; }
        asm volatile("s_waitcnt lgkmcnt(0)" ::: "memory"); __builtin_amdgcn_s_barrier(); asm volatile("" ::: "memory");
        const int h = u.pn;
        const f32x4 g0 = *(const f32x4*)(g + 32 * wc + 8 * fq), g1 = *(const f32x4*)(g + 32 * wc + 8 * fq + 4);
#pragma unroll
        for (int ai = 0; ai < 2; ++ai)
#pragma unroll
            for (int m = 0; m < 4; ++m) { const int rl = ai * 128 + wr * 64 + m * 16 + fr; const int row = u.pm * 256 + rl;
                const f32x4 pp = *(const LAS f32x4*)(P + rl * 4);
                const float r = rsqrtf((((pp.x + pp.y) + (pp.z + pp.w)) + KRSS[row]) * (1.f / 192.f) + EPS);
                bf16_t* kb = MK + ((size_t)h * S + row) * 192; bf16_t* vb = MV + ((size_t)h * S + row) * 128;
                { const f32x4 a0 = acc[ai][0][m][0] * r * g0, a1 = acc[ai][0][m][1] * r * g1;
                  u32x4 w; w.x = cvt_pk_bf16(a0[0], a0[1]); w.y = cvt_pk_bf16(a0[2], a0[3]); w.z = cvt_pk_bf16(a1[0], a1[1]); w.w = cvt_pk_bf16(a1[2], a1[3]);
                  *(u32x4*)(kb + 32 * wc + 8 * fq) = w; }
                { const f32x4 a0 = acc[ai][1][m][0], a1 = acc[ai][1][m][1];
                  u32x4 w; w.x = cvt_pk_bf16(a0[0], a0[1]); w.y = cvt_pk_bf16(a0[2], a0[3]); w.z = cvt_pk_bf16(a1[0], a1[1]); w.w = cvt_pk_bf16(a1[2], a1[3]);
                  *(u32x4*)(vb + 32 * wc + 8 * fq) = w; }
                { const f32x4 k4 = *(const f32x4*)(KRR + (size_t)row * 64 + 16 * wc + 4 * fq) * r;
                  typedef unsigned u32x2 __attribute__((ext_vector_type(2)));
                  u32x2 w; w.x = cvt_pk_bf16(k4[0], k4[1]); w.y = cvt_pk_bf16(k4[2], k4[3]);
                  *(u32x2*)(kb + 128 + 16 * wc + 4 * fq) = w; }
                asm volatile("" ::: "memory"); }
        asm volatile("s_waitcnt lgkmcnt(0)" ::: "memory"); __builtin_amdgcn_s_barrier(); asm volatile("" ::: "memory");
    }
};

__device__ __forceinline__ void gla_out_unit(const Frame& F, char* lds, int chunk, int l, ArgsP a) {
    using namespace att;
    typedef unsigned short bf16;
    const int w = F.wave, rb = w & 1, cp = w >> 1, row0 = chunk * 64;
    char* V_lds = lds + L_V; float* RS = (float*)(lds + L_WS);
    const bf16* PR = WSP(bf16, A_PROJ) + (size_t)row0 * NP;
    const bf16* QT = WSP(bf16, A_QT) + (size_t)row0 * 512; const bf16* KT = WSP(bf16, A_KT) + (size_t)row0 * 512;
    const float* gO = a->in[12] + l * 256;
#define PK4G(P, B_, OUT) do { unsigned a0 = cvtpk_c(P[B_+0], P[B_+1]), a1 = cvtpk_c(P[B_+2], P[B_+3]); unsigned b0 = cvtpk_c(P[B_+4], P[B_+5]), b1 = cvtpk_c(P[B_+6], P[B_+7]);        \
        auto r0 = __builtin_amdgcn_permlane32_swap(a0, b0, false, false); auto r1 = __builtin_amdgcn_permlane32_swap(a1, b1, false, false); \
        u32x4 w_ = {r0[0], r1[0], r0[1], r1[1]}; OUT = *reinterpret_cast<bf16x8*>(&w_); } while (0)
    for (int h = 0; h < 4; ++h) {
        const int tid = lnd_v(F.tid), lane = tid & 63, r32 = lane & 31, hi = lane >> 5;
        const int sr = tid >> 4, sc = (tid & 15) * 8, vst0 = v_st(sr, sc), vst1 = v_st(32 + sr, sc);
        const bf16x8 v00 = load8(PR + (size_t)sr * NP + P_GV + h * 256 + sc), v01 = load8(PR + (size_t)(32 + sr) * NP + P_GV + h * 256 + sc);
        const bf16x8 v10 = load8(PR + (size_t)sr * NP + P_GV + h * 256 + 128 + sc), v11 = load8(PR + (size_t)(32 + sr) * NP + P_GV + h * 256 + 128 + sc);
        bf16x8 qf[8];
#pragma unroll
        for (int d0 = 0; d0 < 8; ++d0) qf[d0] = load8(QT + (size_t)(rb * 32 + r32) * 512 + h * 128 + d0 * 16 + hi * 8);
        f32x16 p0 = {}, p1 = {};
        {   bf16x8 kf[8];
#pragma unroll
            for (int d0 = 0; d0 < 8; ++d0) kf[d0] = load8(KT + (size_t)r32 * 512 + h * 128 + d0 * 16 + hi * 8);
#pragma unroll
            for (int d0 = 0; d0 < 8; ++d0) p0 = __builtin_amdgcn_mfma_f32_32x32x16_bf16(kf[d0], qf[d0], p0, 0, 0, 0); }
        if (rb == 1) {
            bf16x8 kf[8];
#pragma unroll
            for (int d0 = 0; d0 < 8; ++d0) kf[d0] = load8(KT + (size_t)(32 + r32) * 512 + h * 128 + d0 * 16 + hi * 8);
#pragma unroll
            for (int d0 = 0; d0 < 8; ++d0) p1 = __builtin_amdgcn_mfma_f32_32x32x16_bf16(kf[d0], qf[d0], p1, 0, 0, 0);
        }
#pragma unroll
        for (int r = 0; r < 16; ++r) { const bool keep = ((r & 3) + 8 * (r >> 2) + 4 * hi) <= r32; if (rb == 0) { if (!keep) p0[r] = 0.f; } else { if (!keep) p1[r] = 0.f; } }
        bf16x8 pa0, pa1, pa2, pa3;
        PK4G(p0, 0, pa0); PK4G(p0, 8, pa1); PK4G(p1, 0, pa2); PK4G(p1, 8, pa3);
        *(bf16x8*)(V_lds + vst0) = v00; *(bf16x8*)(V_lds + vst1) = v01; *(bf16x8*)(V_lds + SHM_V + vst0) = v10; *(bf16x8*)(V_lds + SHM_V + vst1) = v11;
        __syncthreads();
        f32x16 o[2] = {};
#pragma unroll
        for (int cbi = 0; cbi < 2; ++cbi) {
            const int cb = 2 * cp + cbi;
            const int vb = (int)(uintptr_t)V_lds + v_rd_base(lane) + (cb >> 2) * SHM_V + (cb & 3) * 512;
#define TRRDG(dst, off) asm volatile("ds_read_b64_tr_b16 %0, %1 offset:%2" : "=&v"(dst) : "v"(vb), "i"(off) : "memory")
            s16x4 l0, l1, l2, l3, h0, h1, h2, h3;
            TRRDG(l0, 0); TRRDG(h0, 2048); TRRDG(l1, 4096); TRRDG(h1, 6144); TRRDG(l2, 8192); TRRDG(h2, 10240); TRRDG(l3, 12288); TRRDG(h3, 14336);
            asm volatile("s_waitcnt lgkmcnt(0)" ::: "memory"); SBAR();
            o[cbi] = __builtin_amdgcn_mfma_f32_32x32x16_bf16(pa0, (bf16x8){l0[0], l0[1], l0[2], l0[3], h0[0], h0[1], h0[2], h0[3]}, o[cbi], 0, 0, 0);
            o[cbi] = __builtin_amdgcn_mfma_f32_32x32x16_bf16(pa1, (bf16x8){l1[0], l1[1], l1[2], l1[3], h1[0], h1[1], h1[2], h1[3]}, o[cbi], 0, 0, 0);
            o[cbi] = __builtin_amdgcn_mfma_f32_32x32x16_bf16(pa2, (bf16x8){l2[0], l2[1], l2[2], l2[3], h2[0], h2[1], h2[2], h2[3]}, o[cbi], 0, 0, 0);
            o[cbi] = __builtin_amdgcn_mfma_f32_32x32x16_bf16(pa3, (bf16x8){l3[0], l3[1], l3[2], l3[3], h3[0], h3[1], h3[2], h3[3]}, o[cbi], 0, 0, 0);
#undef TRRDG
            const bf16* SPc = WSP(bf16, A_SPREV) + ((size_t)(chunk * 4 + h) * 256 + cb * 32 + r32) * 128 + hi * 8;
            bf16x8 sf[8];
#pragma unroll
            for (int d0 = 0; d0 < 8; ++d0) sf[d0] = load8(SPc + d0 * 16);
#pragma unroll
            for (int d0 = 0; d0 < 8; ++d0) o[cbi] = __builtin_amdgcn_mfma_f32_32x32x16_bf16(qf[d0], sf[d0], o[cbi], 0, 0, 0);
        }
        float ss[16];
#pragma unroll
        for (int r = 0; r < 16; ++r) { float s = o[0][r] * o[0][r] + o[1][r] * o[1][r];
            s += __shfl_xor(s, 1); s += __shfl_xor(s, 2); s += __shfl_xor(s, 4); s += __shfl_xor(s, 8); s += __shfl_xor(s, 16); ss[r] = s; }
        if (r32 == 0) {
#pragma unroll
            for (int r = 0; r < 16; ++r) RS[(rb * 32 + crow(r, hi)) * 4 + cp] = ss[r]; }
        __syncthreads();
        float grv[16][2];
#pragma unroll
        for (int r = 0; r < 16; ++r)
#pragma unroll
            for (int cbi = 0; cbi < 2; ++cbi) grv[r][cbi] = mk::bf2f(PR[(size_t)(rb * 32 + crow(r, hi)) * NP + P_GR + h * 256 + (2 * cp + cbi) * 32 + r32]);
        const float go0 = gO[(2 * cp) * 32 + r32], go1 = gO[(2 * cp + 1) * 32 + r32];
#pragma unroll
        for (int r = 0; r < 16; ++r) { const int rr = rb * 32 + crow(r, hi); const f32x4 t = *(const f32x4*)(RS + rr * 4);
            const float rs = rsqrtf(((t.x + t.y) + (t.z + t.w)) * (1.f / 256.f) + EPS);
#pragma unroll
            for (int cbi = 0; cbi < 2; ++cbi) { const int col = (2 * cp + cbi) * 32 + r32;
                const float gr = grv[r][cbi];
                const float v = o[cbi][r] * rs * (cbi ? go1 : go0) * (gr * fast_sigmoid(gr));
                const float vn = __shfl_xor(v, 1);
                if ((r32 & 1) == 0) *(unsigned*)(WSP(bf16, A_OB) + (size_t)(row0 + rr) * 1024 + h * 256 + col) = cvtpk(v, vn); } }
    }
    __syncthreads();
#undef PK4G
}

__device__ __forceinline__ void phase_attn(const Frame& F0, unsigned char* lds_generic, int l) {
    const Frame F = relaunder(F0);
    for (int it = lnd_s((int)blockIdx.x); it < 256; it += F.G) {
        ArgsP a = get_args();
        const int h = it & 7, idx = it >> 3, mixer = idx >> 4, x = idx & 15;
        if (mixer == 0) {
            const att::HeadRef H{WSP(bf16_t, A_MQ) + (size_t)h * S * 192, WSP(bf16_t, A_MK) + (size_t)h * S * 192, WSP(bf16_t, A_MV) + (size_t)h * S * 128, WSP(bf16_t, A_OA) + h * 128, nullptr};
            att::Seam<true> Sm;
            att::prime<true>(H, x, (char*)lds_generic, Sm);
            for (int pass = 0; pass < 2; ++pass) att::block<true>(H, pass ? 31 - x : x, 31 - x, (char*)lds_generic, Sm);
        } else {
            const att::HeadRef H{WSP(bf16_t, A_FQ) + (size_t)h * S * 128, WSP(bf16_t, A_FK) + (size_t)h * S * 128, WSP(bf16_t, A_PROJ) + P_FV + h * 128, WSP(bf16_t, A_OC) + h * 128, WSP(float, A_FCUM) + (size_t)h * S};
            att::Seam<false> Sm;
            att::prime<false>(H, x, (char*)lds_generic, Sm);
            for (int pass = 0; pass < 2; ++pass) att::block<false>(H, pass ? 31 - x : x, 31 - x, (char*)lds_generic, Sm);
        }
    }
}
__device__ __forceinline__ void phase_gla_out(const Frame& F0, unsigned char* lds_generic, int l) {
    const Frame F = relaunder(F0);
    for (int it = lnd_s((int)blockIdx.x); it < 256; it += F.G) {
        ArgsP a = get_args();
        const int h = it & 7, idx = it >> 3;
        if ((idx >> 4) == 1) gla_out_unit(F, (char*)lds_generic, h * 16 + (idx & 15), l, a);
    }
}

__global__ void __launch_bounds__(NTHREADS, 2) mk_fwd(Args args_unused) {
    extern __shared__ __attribute__((aligned(16))) unsigned char lds[];
    Frame F;
    F.lds = (LAS unsigned char*)lds; F.MISC = (volatile LAS unsigned*)(F.lds + MISC_OFF);
    F.tid = threadIdx.x; F.lane = F.tid & 63; F.wave = __builtin_amdgcn_readfirstlane(F.tid >> 6);
    F.G = gridDim.x; { const int bx = blockIdx.x; F.vcu = (F.G % 8 == 0) ? (bx % 8) * (F.G / 8) + bx / 8 : bx; }
    for (int u = F.tid; u < (LDS_BYTES - LDSCTL_OFF) / 4; u += NTHREADS) ((LAS unsigned*)(F.lds + LDSCTL_OFF))[u] = 0u;
    __syncthreads();
    XcdBarrier bar;
    { ArgsP a = get_args(); F.ctl = (gu32*)(a->ws + WS_CTL); bar = xcd_barrier_post((unsigned*)(F.ctl + CW_BAR) + a->li * XCD_BAR_WORDS, F.MISC + 8); }
    int l_lo, l_hi, lo, hi, lazy;
    { ArgsP a = get_args(); const int p0 = a->pro_lo, p1 = a->pro_hi; l_lo = a->l_lo; l_hi = a->l_hi; lo = a->ph_lo; hi = a->ph_hi; lazy = a->pad;
      if (p0 == 0 && p1 > 0) rope_tables(F);
      prologue_weights(F, p0, p1);
      if (p0 == 0 && p1 > 0 && l_lo == 0 && l_hi > 0 && lo == 0) phase_rms0(F, a->in[0], a->in[2], WSP(bf16_t, A_HN), WSP(float, A_SSPA));
      if (p1 > p0 && l_hi > l_lo) xcd_barrier(bar); }

#define IN(k) (lo <= (k) && (k) < hi)
#define SEAM(k) do { if (!(l == l_hi - 1 && (k) == hi - 1)) xcd_barrier(bar); } while (0)
#define WB(off) ((const bf16_t*)(a->ws + WS_W + (size_t)l * WSTRIDE + (off)))
    for (int l = l_lo; l < l_hi; ++l) {
        if (IN(1)) { { ArgsP a = get_args();
            pg8::Gemm g{WSP(bf16_t, A_HN), WB(LW_WIN), S, NP, DM, DM, DM}; pg8::StaticOrder So; So.init(S, NP, lnd_s(F.G), lnd_s((int)blockIdx.x));
            { const int pm0 = first_unit_pm(NP / 256, lnd_s(F.G), lnd_s((int)blockIdx.x)); if (pm0 >= 0) fill_rstd_table(F, WSP(float, A_SSPA), pm0); }
            EpiStoreBf16 E{WSP(bf16_t, A_PROJ), NP, (const LAS float*)(F.lds + RT_OFF)};
            pg8::gemm_phase<EpiStoreBf16, pg8::StaticOrder, true, true>(F.lds + RING_OFF, g, So, E); }
            if (lazy && (int)blockIdx.x >= 256 - CV_W1) convert_slice(F, l + 1, CV_B1, (int)blockIdx.x - (256 - CV_W1), CV_W1, CV_R1);
            SEAM(1);
        }
        if (IN(2)) { phase_prep(F, l); SEAM(2); }
        if (IN(3)) { {
            gla_scan(F);
            pg8::StaticOrder So; So.init(S, 2048, lnd_s(F.G), lnd_s((int)blockIdx.x));
            { ArgsP a = get_args(); pg8::Gemm g{WSP(bf16_t, A_CQN), WB(LW_WUQ), S, 2048, 512, 1024, 512};
              EpiMlaQ E{WSP(bf16_t, A_MQ), a->in[8] + l * 192, WSP(float, A_CS)};
              pg8::gemm_phase<EpiMlaQ, pg8::StaticOrder, false, true>(F.lds + RING_OFF, g, So, E); }
            { ArgsP a = get_args(); pg8::Gemm g{WSP(bf16_t, A_CQN) + 512, WB(LW_WUKV), S, 2048, 512, 1024, 512};
              EpiMlaKV E{WSP(bf16_t, A_MK), WSP(bf16_t, A_MV), a->in[9] + l * 192, WSP(float, A_KRR), WSP(float, A_KRSS)};
              pg8::gemm_phase<EpiMlaKV, pg8::StaticOrder, false, true>(F.lds + RING_OFF, g, So, E); } }
            SEAM(3);
        }
        if (IN(4)) { { phase_attn(F, lds + RING_OFF, l); phase_gla_out(F, lds + RING_OFF, l); }
            if (lazy && (int)blockIdx.x >= 256 - CV_W4) convert_slice(F, l + 1, CV_B4, (int)blockIdx.x - (256 - CV_W4), CV_W4, CV_R4);
            SEAM(4); }
        if (IN(5)) { { ArgsP a = get_args();
            BranchOrder So; So.init(lnd_s(F.G), lnd_s((int)blockIdx.x));
            pg8::Gemm g{WSP(bf16_t, A_OA), WB(LW_WBR), 3 * S, 3 * DM, 1024, 1024, 1024};
            EpiGateMergeAll E{WSP(bf16_t, A_PROJ) + P_GATES, NP, WSP(bf16_t, A_MERGED), WSP(bf16_t, A_HN), DM};
            pg8::gemm_phase<EpiGateMergeAll, BranchOrder, true, true>(F.lds + RING_OFF, g, So, E); }
            SEAM(5);
        }
        if (IN(6)) { { ArgsP a = get_args();
            pg8::Gemm g{WSP(bf16_t, A_HN), WB(LW_WOUT), S, DM, DM, DM, DM}; pg8::StaticOrder So; So.init(S, DM, lnd_s(F.G), lnd_s((int)blockIdx.x));
            EpiResidNorm E{(l == 0) ? a->in[0] : a->out, a->out, DM, WSP(bf16_t, A_HN2), WSP(float, A_SSPB), a->in[18] + l * DM, 1};
            pg8::gemm_phase<EpiResidNorm, pg8::StaticOrder, false, true>(F.lds + RING_OFF, g, So, E); }
            SEAM(6);
        }
        if (IN(8)) { { ArgsP a = get_args();
            pg8::Gemm g{WSP(bf16_t, A_HN2), WB(LW_WGU), S, 2 * FFH, DM, DM, DM}; pg8::StaticOrder So; So.init(S, 2 * FFH, lnd_s(F.G), lnd_s((int)blockIdx.x));
            { const int pm0 = first_unit_pm(2 * FFH / 256, lnd_s(F.G), lnd_s((int)blockIdx.x)); if (pm0 >= 0) fill_rstd_table(F, WSP(float, A_SSPB), pm0); }
            EpiSwiglu E{WSP(bf16_t, A_PROJ), FFH, (const LAS float*)(F.lds + RT_OFF)};
            pg8::gemm_phase<EpiSwiglu, pg8::StaticOrder, true, true>(F.lds + RING_OFF, g, So, E); }
            if (lazy && (int)blockIdx.x >= 256 - CV_W8) convert_slice(F, l + 1, CV_B8, (int)blockIdx.x - (256 - CV_W8), CV_W8, CV_R8);
            SEAM(8);
        }
        if (IN(9)) { { ArgsP a = get_args();
            pg8::Gemm g{WSP(bf16_t, A_PROJ), WB(LW_WDN), S, DM, FFH, FFH, FFH}; pg8::StaticOrder So; So.init(S, DM, lnd_s(F.G), lnd_s((int)blockIdx.x));
            EpiResidNorm E{a->out, a->out, DM, WSP(bf16_t, A_HN), WSP(float, A_SSPA), a->in[2] + (l + 1 < DEPTH ? l + 1 : l) * DM, (l + 1 < DEPTH) ? 1 : 0};
            pg8::gemm_phase<EpiResidNorm, pg8::StaticOrder, false, true>(F.lds + RING_OFF, g, So, E); }
            SEAM(9);
        }
    }
#undef IN
#undef SEAM
}

}

extern "C" void kernel_launch(void* const* d_in, const int* in_sizes, int n_in, void* d_out, int out_size, void* d_ws, size_t ws_size, hipStream_t stream) {
    static int grid = 0;
    if (grid == 0) {
        int dev = 0, cus = 0;
        if (n_in != 21 || out_size != S * DM || ws_size < mk::A_END) { fprintf(stderr, "kernel_launch: unexpected shapes / workspace (%d inputs, out %d, ws %zu < %zu)\n", n_in, out_size, ws_size, (size_t)mk::A_END); grid = -1; return; }
        if (hipGetDevice(&dev) != hipSuccess || hipDeviceGetAttribute(&cus, hipDeviceAttributeMultiprocessorCount, dev) != hipSuccess) { grid = -1; return; }
        if (hipFuncSetAttribute((const void*)mk::mk_fwd, hipFuncAttributeMaxDynamicSharedMemorySize, mk::LDS_BYTES) != hipSuccess) { fprintf(stderr, "hipFuncSetAttribute failed\n"); grid = -1; return; }
        int per_cu = 0;
        if (hipOccupancyMaxActiveBlocksPerMultiprocessor(&per_cu, (const void*)mk::mk_fwd, mk::NTHREADS, mk::LDS_BYTES) != hipSuccess || per_cu < 1) { fprintf(stderr, "occupancy query: %d blocks per CU\n", per_cu); (void)hipGetLastError(); }
        grid = cus;
        if (cus != 256) { fprintf(stderr, "kernel_launch: this kernel's unit deal (one 256x256 unit per workgroup in the N = 2048 GEMM phases, one row panel per workgroup in the wide ones) needs exactly 256 CUs, found %d\n", cus); grid = -1; return; }
    }
    if (grid < 0) return;
    (void)hipMemsetAsync((unsigned char*)d_ws + mk::WS_CTL, 0, mk::CTL_ZERO_BYTES, stream);
    mk::Args a{};
    for (int i = 0; i < 21; ++i) a.in[i] = (const float*)d_in[i];
    a.out = (float*)d_out; a.ws = (unsigned char*)d_ws;
    const int lazy = (grid == 256) ? 1 : 0;
    a.pro_lo = 0; a.pro_hi = lazy ? 1 : DEPTH; a.l_lo = 0; a.l_hi = DEPTH; a.ph_lo = 0; a.ph_hi = 10; a.li = 0; a.pad = lazy;
    mk::mk_fwd<<<dim3(grid), mk::NTHREADS, mk::LDS_BYTES, stream>>>(a);
}
```

```cpp
#include <hip/hip_runtime.h>
#include <cstdio>
#include <cstdint>

constexpr int S = 8192, DM = 2048, DEPTH = 4;
constexpr int D_IN = 13400, FFH = 5632;
constexpr int C_CQ = 0, C_CKV = 512, C_KR = 1024, C_GQ = 1088, C_GK = 1600, C_GV = 2112, C_GA = 3136, C_GR = 3152,
              C_FQ = 4176, C_FK = 5200, C_FV = 6224, C_FL = 7248, C_GATES = 7256;
constexpr float EPS = 1e-6f;
#define MK_WSTRIDE 149946368ull
constexpr int NP_G = 13568;


namespace pg8 {
#define PG8_LAS __attribute__((address_space(3)))
typedef unsigned short bf16_t;
typedef short bf16x8 __attribute__((ext_vector_type(8)));
typedef float f32x4 __attribute__((ext_vector_type(4)));
typedef unsigned u32x4 __attribute__((ext_vector_type(4)));
constexpr int BM = 256, BK = 64, HALF = 128, HTB = HALF * BK * 2  , STAGE_BYTES = 8 * HTB, NXCD = 8, WGM = 8;

__host__ __device__ __forceinline__ int lds_byte(int r, int c) { const int st = (r >> 4) * 2 + (c >> 5), rr = r & 15, cc = c & 31, ob = rr * 64 + cc * 2; return st * 1024 + (ob ^ (((ob >> 9) & 1) << 5)); }
__host__ __device__ __forceinline__ void stage_rc(int b, int& R, int& C) { const int st = b / 1024, sb = b % 1024, swz = sb ^ (((sb >> 9) & 1) << 5); R = (st >> 1) * 16 + swz / 64; C = (st & 1) * 32 + (swz % 64) / 2; }
__host__ __device__ __forceinline__ int perm32(int rho) { const int n = rho >> 4, i = rho & 15; return 8 * (i >> 2) + 4 * n + (i & 3); }

struct Unit { int pm, pn; };
struct Gemm { const bf16_t* A; const bf16_t* Bt; int M, N, K, lda, ldb; };

struct StaticOrder {
    int nM, nN, nwg, G, c;
    __host__ __device__ void init(int M, int N, int G_, int c_) { nM = M / BM; nN = N / BM; nwg = nM * nN; G = G_; c = c_; }
    __host__ __device__ bool next(int i, Unit& u) const {
        const long L = (long)i * G + c; if (L >= nwg) return false;
        int wgid = (int)L; { const int q = nwg / NXCD, r = nwg % NXCD, xcd = wgid % NXCD, off = wgid / NXCD; wgid = (xcd < r ? xcd * (q + 1) : r * (q + 1) + (xcd - r) * q) + off; }
        const int nig = WGM * nN, gid = wgid / nig, fm = gid * WGM, gsz = (nM - fm) < WGM ? (nM - fm) : WGM;
        u.pm = fm + ((wgid % nig) % gsz); u.pn = (wgid % nig) / gsz; return true;
    }
    __device__ __forceinline__ void a_ready(const Unit&) const {}
    __device__ __forceinline__ void done(const Unit&) const {}
};

__device__ __forceinline__ unsigned cvt_pk_bf16(float lo, float hi) { unsigned r; asm volatile("v_cvt_pk_bf16_f32 %0, %1, %2" : "=v"(r) : "v"(lo), "v"(hi)); return r; }
template <class Epi, class Sched, bool ALIGN_EPI = false, bool SP2 = false>
__device__ __forceinline__ void gemm_phase(PG8_LAS unsigned char* lds, const Gemm g, const Sched& S, const Epi& E) {
    int tid_ = threadIdx.x; asm volatile("" : "+v"(tid_));
    const int tid = tid_, wid = __builtin_amdgcn_readfirstlane(tid >> 6), lane = tid & 63, wr = wid >> 2, wc = wid & 3, fr = lane & 15, fq = lane >> 4;
    const int K = g.K, nt = K / BK;
    unsigned voffA[2], voffB[2];
#pragma unroll
    for (int i = 0; i < 2; ++i) { int R, C; stage_rc(tid * 16 + i * 8192, R, C); const int Rb = Epi::PERM ? ((R & ~31) + perm32(R & 31)) : R;
        voffA[i] = (unsigned)(R * g.lda + C) * 2u; voffB[i] = (unsigned)(Rb * g.ldb + C) * 2u; }
    const size_t kstep = (size_t)(BK * 2);
    const size_t hstepA = (size_t)HALF * g.lda * 2, hstepB = (size_t)HALF * g.ldb * 2;
    const size_t tstepA = 2 * hstepA, tstepB = 2 * hstepB;
    const unsigned ldsw = (unsigned)wid * 1024u;
    const int aoff = lds_byte(wr * 64 + fr, fq * 8), boff = lds_byte(wc * 32 + fr, fq * 8);
#define PG8_SA(b, h) (((b) * 2 + (h)) * HTB)
#define PG8_SB(b, h) ((4 + (b) * 2 + (h)) * HTB)
#define PG8_STAGE(bufoff, gbase, voff) do { _Pragma("unroll") for (int _i = 0; _i < 2; ++_i) \
        __builtin_amdgcn_global_load_lds((const unsigned*)((const char*)(gbase) + (voff)[_i]), (PG8_LAS unsigned*)(lds + (bufoff) + ldsw + _i * 8192), 16, 0, 0); } while (0)
#define PG8_LDA(dst, b, h) do { _Pragma("unroll") for (int m = 0; m < 4; ++m) _Pragma("unroll") for (int k = 0; k < 2; ++k) dst[m][k] = *(const PG8_LAS bf16x8*)(lds + PG8_SA(b, h) + aoff + m * 2048 + k * 1024); } while (0)
#define PG8_LDB(dst, b, h) do { _Pragma("unroll") for (int n = 0; n < 2; ++n) _Pragma("unroll") for (int k = 0; k < 2; ++k) dst[n][k] = *(const PG8_LAS bf16x8*)(lds + PG8_SB(b, h) + boff + n * 2048 + k * 1024); } while (0)
#define PG8_MMA(ai, bj, At, Bt) do { __builtin_amdgcn_s_setprio(1); _Pragma("unroll") for (int m = 0; m < 4; ++m) _Pragma("unroll") for (int n = 0; n < 2; ++n) _Pragma("unroll") for (int k = 0; k < 2; ++k) \
        acc[ai][bj][m][n] = __builtin_amdgcn_mfma_f32_16x16x32_bf16(Bt[n][k], At[m][k], acc[ai][bj][m][n], 0, 0, 0); __builtin_amdgcn_s_setprio(0); } while (0)
#define PG8_WAIT_V(n) asm volatile("s_waitcnt vmcnt(" #n ")" ::: "memory")
#define PG8_WAIT_L(n) asm volatile("s_waitcnt lgkmcnt(" #n ")" ::: "memory")
#define PG8_BAR __builtin_amdgcn_s_barrier()
#define PG8_SCHED __builtin_amdgcn_sched_barrier(0)
    Unit cur, nxt; int ui = 0;
    if (!S.next(0, cur)) return;
    f32x4 acc[2][2][4][2];
#pragma unroll
    for (int a = 0; a < 2; ++a)
#pragma unroll
        for (int b = 0; b < 2; ++b)
#pragma unroll
            for (int m = 0; m < 4; ++m)
#pragma unroll
                for (int n = 0; n < 2; ++n) acc[a][b][m][n] = (f32x4){0.f, 0.f, 0.f, 0.f};
    bf16x8 At[4][2], B0[2][2], B1[2][2];
    const char* cA = (const char*)g.A + (size_t)cur.pm * tstepA; const char* cB = (const char*)g.Bt + (size_t)cur.pn * tstepB;
    S.a_ready(cur);
    if constexpr (SP2) {
        PG8_STAGE(PG8_SB(0, 0), cB, voffB); PG8_STAGE(PG8_SB(0, 1), cB + hstepB, voffB); PG8_STAGE(PG8_SA(0, 0), cA, voffA); PG8_STAGE(PG8_SA(0, 1), cA + hstepA, voffA);
        if (wr == 1) PG8_BAR;
        PG8_WAIT_V(2); PG8_BAR;
        PG8_STAGE(PG8_SB(1, 0), cB + kstep, voffB); PG8_STAGE(PG8_SA(1, 0), cA + kstep, voffA); PG8_STAGE(PG8_SB(1, 1), cB + hstepB + kstep, voffB);
        PG8_WAIT_V(6); PG8_BAR;
    } else {
        PG8_STAGE(PG8_SB(0, 0), cB, voffB); PG8_STAGE(PG8_SA(0, 0), cA, voffA); PG8_STAGE(PG8_SB(0, 1), cB + hstepB, voffB); PG8_STAGE(PG8_SA(0, 1), cA + hstepA, voffA);
        if (wr == 1) PG8_BAR;
        PG8_WAIT_V(4); PG8_BAR;
        PG8_STAGE(PG8_SB(1, 0), cB + kstep, voffB); PG8_STAGE(PG8_SA(1, 0), cA + kstep, voffA); PG8_STAGE(PG8_SB(1, 1), cB + hstepB + kstep, voffB);
        PG8_WAIT_V(6); PG8_BAR;
    }
    for (;;) {
        const bool has_next = S.next(ui + 1, nxt);
        const char* nA = has_next ? (const char*)g.A + (size_t)nxt.pm * tstepA : cA; const char* nB = has_next ? (const char*)g.Bt + (size_t)nxt.pn * tstepB : cB;
        for (int t = 0; t < nt; t += 2) {
            const bool last = (t == nt - 2);
            const char* a1 = cA + (size_t)(t + 1) * kstep;
            const char* a2 = last ? nA : cA + (size_t)(t + 2) * kstep; const char* b2 = last ? nB : cB + (size_t)(t + 2) * kstep;
            const char* a3 = a2 + kstep; const char* b3 = b2 + kstep;
            if (last && has_next) S.a_ready(nxt);
            if constexpr (SP2) {
            PG8_LDB(B0, 0, 0); PG8_LDB(B1, 0, 1); PG8_SCHED; PG8_LDA(At, 0, 0); PG8_STAGE(PG8_SA(1, 1), a1 + hstepA, voffA);
            PG8_WAIT_V(8); PG8_WAIT_L(0); PG8_BAR; PG8_MMA(0, 0, At, B0); PG8_MMA(0, 1, At, B1); PG8_BAR; PG8_SCHED;
            PG8_LDA(At, 0, 1); PG8_STAGE(PG8_SB(0, 0), b2, voffB); PG8_STAGE(PG8_SB(0, 1), b2 + hstepB, voffB); PG8_STAGE(PG8_SA(0, 0), a2, voffA);
            PG8_WAIT_V(8); PG8_WAIT_L(0); PG8_BAR; PG8_MMA(1, 0, At, B0); PG8_MMA(1, 1, At, B1); PG8_BAR; PG8_SCHED;
            PG8_LDB(B0, 1, 0); PG8_LDB(B1, 1, 1); PG8_SCHED; PG8_LDA(At, 1, 0); PG8_STAGE(PG8_SA(0, 1), a2 + hstepA, voffA);
            PG8_WAIT_V(8); PG8_WAIT_L(0); PG8_BAR; PG8_MMA(0, 0, At, B0); PG8_MMA(0, 1, At, B1); PG8_BAR; PG8_SCHED;
            PG8_LDA(At, 1, 1); PG8_STAGE(PG8_SB(1, 0), b3, voffB); PG8_STAGE(PG8_SB(1, 1), b3 + hstepB, voffB); PG8_STAGE(PG8_SA(1, 0), a3, voffA);
            PG8_WAIT_V(8); PG8_WAIT_L(0); PG8_BAR; PG8_MMA(1, 0, At, B0); PG8_MMA(1, 1, At, B1); PG8_BAR; PG8_SCHED;
            } else {
            PG8_LDB(B0, 0, 0); PG8_SCHED; PG8_LDA(At, 0, 0); PG8_STAGE(PG8_SA(1, 1), a1 + hstepA, voffA);
            PG8_WAIT_L(8); PG8_BAR; PG8_WAIT_L(0); PG8_MMA(0, 0, At, B0); PG8_BAR; PG8_SCHED;
            PG8_LDB(B1, 0, 1); PG8_STAGE(PG8_SB(0, 0), b2, voffB);
            PG8_BAR; PG8_WAIT_L(0); PG8_MMA(0, 1, At, B1); PG8_BAR;
            PG8_LDA(At, 0, 1); PG8_STAGE(PG8_SA(0, 0), a2, voffA);
            PG8_BAR; PG8_WAIT_L(0); PG8_MMA(1, 0, At, B0); PG8_BAR; PG8_SCHED;
            PG8_STAGE(PG8_SB(0, 1), b2 + hstepB, voffB);
            PG8_WAIT_V(6); PG8_BAR; PG8_MMA(1, 1, At, B1); PG8_BAR;
            PG8_LDB(B0, 1, 0); PG8_SCHED; PG8_LDA(At, 1, 0); PG8_STAGE(PG8_SA(0, 1), a2 + hstepA, voffA);
            PG8_WAIT_L(8); PG8_BAR; PG8_WAIT_L(0); PG8_MMA(0, 0, At, B0); PG8_BAR; PG8_SCHED;
            PG8_LDB(B1, 1, 1); PG8_STAGE(PG8_SB(1, 0), b3, voffB);
            PG8_BAR; PG8_WAIT_L(0); PG8_MMA(0, 1, At, B1); PG8_BAR;
            PG8_LDA(At, 1, 1); PG8_STAGE(PG8_SA(1, 0), a3, voffA);
            PG8_BAR; PG8_WAIT_L(0); PG8_MMA(1, 0, At, B0); PG8_BAR; PG8_SCHED;
            PG8_STAGE(PG8_SB(1, 1), b3 + hstepB, voffB);
            PG8_WAIT_V(6); PG8_BAR; PG8_MMA(1, 1, At, B1); PG8_BAR;
            }
        }
        if constexpr (ALIGN_EPI) { if (wr == 0) PG8_BAR; }
        if constexpr (!Epi::AFTER_DRAIN) { E(acc, cur, wr, wc, fr, fq); S.done(cur); }
        if (!has_next) break;
#pragma unroll
        for (int a = 0; a < 2; ++a)
#pragma unroll
            for (int b = 0; b < 2; ++b)
#pragma unroll
                for (int m = 0; m < 4; ++m)
#pragma unroll
                    for (int n = 0; n < 2; ++n) acc[a][b][m][n] = (f32x4){0.f, 0.f, 0.f, 0.f};
        cur = nxt; cA = nA; cB = nB; ++ui;
        if constexpr (ALIGN_EPI) { if (wr == 1) PG8_BAR; }
    }
    PG8_WAIT_V(0);
    if constexpr (!ALIGN_EPI) { if (wr == 0) PG8_BAR; }
    PG8_BAR;
    if constexpr (Epi::AFTER_DRAIN) { E.fused(acc, cur, wr, wc, fr, fq, lds, wid, lane); S.done(cur); }
#undef PG8_SA
#undef PG8_SB
#undef PG8_STAGE
#undef PG8_LDA
#undef PG8_LDB
#undef PG8_MMA
#undef PG8_WAIT_V
#undef PG8_WAIT_L
#undef PG8_BAR
#undef PG8_SCHED
}
}

#define GAS __attribute__((address_space(1)))
#define LAS __attribute__((address_space(3)))
#define XB_TMO      128
#define XB_XCNT(j)  (256  + 64 * (j))
#define XB_XSUB(j)  (1280 + 64 * (j))
#define XB_XGEN(j)  (2304 + 64 * (j))
#define XB_TOP      3328
#define XB_TOPGEN   3392
#define XCD_BAR_WORDS 3456
#define XB_SPIN_CAP (1u << 18)

__device__ __forceinline__ unsigned xb_ld(unsigned* p)              { return __hip_atomic_load(p, __ATOMIC_RELAXED, __HIP_MEMORY_SCOPE_AGENT); }
__device__ __forceinline__ unsigned xb_add(unsigned* p, unsigned v) { return __hip_atomic_fetch_add(p, v, __ATOMIC_RELAXED, __HIP_MEMORY_SCOPE_AGENT); }
__device__ __forceinline__ unsigned xb_xcc_id() { return (unsigned)__builtin_amdgcn_s_getreg((3 << 11) | 20) & 0xFu; }
#define XB_SPIN(cond, bar) do { unsigned _sp = 0; while (cond) { __builtin_amdgcn_s_sleep(1); \
    if ((++_sp & 255u) == 0u) { if (xb_ld(&(bar)[XB_TMO])) break; if (_sp > XB_SPIN_CAP) { atomicAdd(&(bar)[XB_TMO], 1u); break; } } } } while (0)

struct XcdBarrier {
    unsigned* bar; unsigned x;
    volatile LAS unsigned* st;
};

__device__ __forceinline__ XcdBarrier xcd_barrier_post(unsigned* bar, volatile LAS unsigned* st) {
    XcdBarrier b; b.bar = bar; b.x = xb_xcc_id(); b.st = st;
    if (threadIdx.x == 0) (void)xb_add(&bar[XB_XCNT(b.x)], 1u);
    return b;
}
__device__ __forceinline__ void xcd_barrier_complete(unsigned* bar, unsigned x, unsigned& nloc, unsigned& nx) {
    const unsigned G = gridDim.x * gridDim.y * gridDim.z;
    unsigned sum, cnt, mine, sp = 0u;
    for (;;) {
        sum = 0u; cnt = 0u; mine = 0u;
#pragma unroll
        for (unsigned j = 0; j < 16; ++j) { const unsigned c = xb_ld(&bar[XB_XCNT(j)]); sum += c; cnt += (c > 0u) ? 1u : 0u; mine = (j == x) ? c : mine; }
        if (sum == G) break;
        __builtin_amdgcn_s_sleep(1);
        if ((++sp & 255u) == 0u) { if (xb_ld(&bar[XB_TMO])) break; if (sp > XB_SPIN_CAP) { atomicAdd(&bar[XB_TMO], 1u); break; } }
    }
    nloc = mine > 0u ? mine : 1u; nx = cnt > 0u ? cnt : 1u;
}

__device__ __forceinline__ void xcd_barrier(const XcdBarrier& b) {
    asm volatile("s_waitcnt vmcnt(0)" ::: "memory");
    __syncthreads();
    if (threadIdx.x == 0) {
        unsigned* bar = b.bar;
        __builtin_amdgcn_s_waitcnt(0);
        unsigned nloc = b.st[0], nx = b.st[1];
        if (nloc == 0u) { xcd_barrier_complete(bar, b.x, nloc, nx); b.st[0] = nloc; b.st[1] = nx; }
        const unsigned old = xb_add(&bar[XB_XSUB(b.x)], 1u);
        const unsigned gen = old / nloc;
        if (old + 1u == (gen + 1u) * nloc) {
            __builtin_amdgcn_fence(__ATOMIC_RELEASE, "agent");
            asm volatile("s_waitcnt vmcnt(0)" ::: "memory");
            const unsigned og = xb_add(&bar[XB_TOP], 1u);
            const unsigned tg = og / nx;
            if (og + 1u == (tg + 1u) * nx) xb_add(&bar[XB_TOPGEN], 1u);
            else XB_SPIN(xb_ld(&bar[XB_TOPGEN]) == tg, bar);
            __builtin_amdgcn_fence(__ATOMIC_ACQUIRE, "agent");
            xb_add(&bar[XB_XGEN(b.x)], 1u);
            asm volatile("s_waitcnt vmcnt(0)" ::: "memory");
        } else {
            XB_SPIN(xb_ld(&bar[XB_XGEN(b.x)]) == gen, bar);
            __builtin_amdgcn_fence(__ATOMIC_ACQUIRE, "agent");
            asm volatile("s_waitcnt vmcnt(0)" ::: "memory");
        }
    }
    __syncthreads();
}

namespace att {
__device__ __forceinline__ int mk_lnd_v(int v) { asm volatile("" : "+v"(v)); return v; }
typedef short bf16x8 __attribute__((ext_vector_type(8)));
typedef short s16x4 __attribute__((ext_vector_type(4)));
typedef float f32x16 __attribute__((ext_vector_type(16)));
typedef float f32x4 __attribute__((ext_vector_type(4)));
typedef unsigned u32x4 __attribute__((ext_vector_type(4)));
typedef unsigned short bf16;
constexpr int NW = 8, QBLK = 32, KVBLK = 64, QB = NW * QBLK;
constexpr int SHM_V = KVBLK * 128 * 2, SHM_K = 16 * 1152, SHM_KR = 8 * 1152;
constexpr int L_V = 0, L_K = 2 * SHM_V, L_KR = L_K + 2 * SHM_K, L_WS = L_KR + 2 * SHM_KR, L_X = L_WS + NW * 64 * 4;
constexpr int L_FB = L_X + 32768, L_END = L_X + 65536;
static_assert(L_END <= 163840 - 512, "attention LDS");
constexpr float THR = 8.f;
#define KLAY(row, chunk) ((chunk) * 1152 + (((chunk) & 7) + (row)) * 16)
#define SBAR() __builtin_amdgcn_sched_barrier(0)
__device__ __forceinline__ int v_st(int k, int c) { const int kk = (k & ~0xC) | ((k & 4) << 1) | ((k & 8) >> 1); return ((kk >> 3) * 4 + (c >> 5)) * 512 + ((kk & 7) * 32 + (c & 31)) * 2; }
__device__ __forceinline__ int v_rd_base(int lane) { return ((lane & 3) << 3) | (((lane >> 2) & 3) << 6) | (((lane >> 4) & 1) << 5) | (((lane >> 5) & 1) << 8); }
constexpr int v_rd_off(int d0, int ks, int half) { return d0 * 512 + ks * 4096 + half * 2048; }
__device__ __forceinline__ int crow(int r, int hi) { return (r & 3) + 8 * (r >> 2) + 4 * hi; }
__device__ __forceinline__ unsigned cvtpk(float lo, float hi) { unsigned r; asm volatile("v_cvt_pk_bf16_f32 %0, %1, %2" : "=v"(r) : "v"(lo), "v"(hi)); return r; }
__device__ __forceinline__ bf16x8 load8(const bf16* p) { return *reinterpret_cast<const bf16x8*>(p); }
typedef float f32x2c_t __attribute__((ext_vector_type(2))); typedef __bf16 bf16x2c_t __attribute__((ext_vector_type(2)));
__device__ __forceinline__ unsigned cvtpk_c(float lo, float hi) { f32x2c_t v = {lo, hi}; bf16x2c_t b = __builtin_convertvector(v, bf16x2c_t); return __builtin_bit_cast(unsigned, b); }

__device__ __forceinline__ void mask_tile(f32x16& p0, f32x16& p1, int dq) {
    const float NEG = -__builtin_inff();
#pragma unroll
    for (int r = 0; r < 16; ++r) {
        const int c = (r & 3) + 8 * (r >> 2);
        if (dq - c < 0) p0[r] = NEG;
        if (dq - c - 32 < 0) p1[r] = NEG;
    }
}
template <bool MLA>
__device__ __forceinline__ void partialSM(f32x16& p0, f32x16& p1, float& m_reg, float& mn, float& alpha) {
    constexpr float SCALE = MLA ? 0.07216878364870322f : 0.08838834764831845f;
    float pmax = p0[0];
#pragma unroll
    for (int r = 1; r < 16; ++r) pmax = fmaxf(pmax, p0[r]);
#pragma unroll
    for (int r = 0; r < 16; ++r) pmax = fmaxf(pmax, p1[r]);
    { auto rr = __builtin_amdgcn_permlane32_swap(__float_as_uint(pmax), __float_as_uint(pmax), false, false);
      pmax = fmaxf(__uint_as_float(rr[0]), __uint_as_float(rr[1])); }
    constexpr float C2 = 1.4426950408889634f * SCALE;
    if (__builtin_expect(__all((pmax - m_reg) * SCALE <= THR), 1)) { mn = m_reg; alpha = 1.f; }
    else { mn = fmaxf(m_reg, pmax); alpha = __builtin_amdgcn_exp2f((m_reg - mn) * C2); m_reg = mn; }
    const float mnL = -mn * C2;
#pragma unroll
    for (int r = 0; r < 16; ++r) p0[r] = fmaf(p0[r], C2, mnL);
#pragma unroll
    for (int r = 0; r < 16; ++r) p1[r] = fmaf(p1[r], C2, mnL);
#pragma unroll
    for (int r = 0; r < 16; ++r) p0[r] = __builtin_amdgcn_exp2f(p0[r]);
}
#define PK4(P, B_, OUT) do { unsigned a0 = cvtpk(P[B_+0], P[B_+1]), a1 = cvtpk(P[B_+2], P[B_+3]);                          \
        unsigned b0 = cvtpk(P[B_+4], P[B_+5]), b1 = cvtpk(P[B_+6], P[B_+7]);                                             \
        auto r0 = __builtin_amdgcn_permlane32_swap(a0, b0, false, false); auto r1 = __builtin_amdgcn_permlane32_swap(a1, b1, false, false); \
        u32x4 w = {r0[0], r1[0], r0[1], r1[1]}; OUT = *reinterpret_cast<bf16x8*>(&w); } while (0)
__device__ __forceinline__ void finishSM(f32x16& p0, f32x16& p1, float alpha, float& l_reg, bf16x8& pa0, bf16x8& pa1, bf16x8& pa2, bf16x8& pa3) {
#pragma unroll
    for (int r = 0; r < 16; ++r) p1[r] = __builtin_amdgcn_exp2f(p1[r]);
    float ps = 0;
#pragma unroll
    for (int r = 0; r < 16; ++r) ps += p0[r];
#pragma unroll
    for (int r = 0; r < 16; ++r) ps += p1[r];
    { auto rr = __builtin_amdgcn_permlane32_swap(__float_as_uint(ps), __float_as_uint(ps), false, false);
      ps = __uint_as_float(rr[0]) + __uint_as_float(rr[1]); }
    l_reg = l_reg * alpha + ps;
    PK4(p0, 0, pa0); PK4(p0, 8, pa1); PK4(p1, 0, pa2); PK4(p1, 8, pa3);
}
template <int KB, bool MLA, bool BIAS>
__device__ __forceinline__ void qkt(f32x16& p0, f32x16& p1, const char* lds, int r32, int hi, const bf16x8* qr, int krb, int qrb, int fbb) {
    if constexpr (BIAS) {
        const char* fbp = lds + L_FB + fbb;
#pragma unroll
        for (int g_ = 0; g_ < 4; ++g_) { const f32x4 b0_ = *(const f32x4*)(fbp + g_ * 32), b1_ = *(const f32x4*)(fbp + 128 + g_ * 32);
#pragma unroll
            for (int e_ = 0; e_ < 4; ++e_) { p0[4 * g_ + e_] = b0_[e_]; p1[4 * g_ + e_] = b1_[e_]; } }
    } else { p0 = f32x16{}; p1 = f32x16{}; }
    const char* K_lds = lds + L_K;
    const char* kbase = K_lds + KB * SHM_K + r32 * 16 + hi * 1168;
    constexpr int NQR = MLA ? 12 : 8;
    const char* qq = lds + L_X + qrb;
#pragma unroll
    for (int d0 = 0; d0 < 8; ++d0) {
        bf16x8 b0 = *reinterpret_cast<const bf16x8*>(kbase + KLAY(0, 2 * d0));
        bf16x8 b1 = *reinterpret_cast<const bf16x8*>(kbase + KLAY(32, 2 * d0));
        bf16x8 q; if (d0 < NQR) q = qr[d0]; else q = *reinterpret_cast<const bf16x8*>(qq + (d0 - NQR) * 1024);
        p0 = __builtin_amdgcn_mfma_f32_32x32x16_bf16(b0, q, p0, 0, 0, 0);
        p1 = __builtin_amdgcn_mfma_f32_32x32x16_bf16(b1, q, p1, 0, 0, 0); }
    if constexpr (MLA) {
        const char* kr = lds + L_KR + KB * SHM_KR + krb;
#pragma unroll
        for (int dr = 0; dr < 4; ++dr) {
            bf16x8 b0 = *reinterpret_cast<const bf16x8*>(kr + KLAY(0, 2 * dr));
            bf16x8 b1 = *reinterpret_cast<const bf16x8*>(kr + KLAY(32, 2 * dr));
            bf16x8 q; if (8 + dr < NQR) q = qr[8 + dr]; else q = *reinterpret_cast<const bf16x8*>(qq + (8 + dr - NQR) * 1024);
            p0 = __builtin_amdgcn_mfma_f32_32x32x16_bf16(b0, q, p0, 0, 0, 0);
            p1 = __builtin_amdgcn_mfma_f32_32x32x16_bf16(b1, q, p1, 0, 0, 0); }
    }
}
template <int VB>
__device__ __forceinline__ void pv_tile(f32x16* o, int vb0, bf16x8 pa0, bf16x8 pa1, bf16x8 pa2, bf16x8 pa3) {
#define TRRD(dst, off) asm volatile("ds_read_b64_tr_b16 %0, %1 offset:%2" : "=&v"(dst) : "v"(vb0), "i"(off) : "memory")
#define PV_D0(d0) do { s16x4 l0, l1, l2, l3, h0, h1, h2, h3; constexpr int b_ = VB * SHM_V + v_rd_off(d0, 0, 0);   \
        TRRD(l0, b_); TRRD(h0, b_ + 2048); TRRD(l1, b_ + 4096); TRRD(h1, b_ + 6144); TRRD(l2, b_ + 8192); TRRD(h2, b_ + 10240); TRRD(l3, b_ + 12288); TRRD(h3, b_ + 14336); \
        asm volatile("s_waitcnt lgkmcnt(0)" ::: "memory"); SBAR();   \
        o[d0] = __builtin_amdgcn_mfma_f32_32x32x16_bf16(pa0, (bf16x8){l0[0], l0[1], l0[2], l0[3], h0[0], h0[1], h0[2], h0[3]}, o[d0], 0, 0, 0);   \
        o[d0] = __builtin_amdgcn_mfma_f32_32x32x16_bf16(pa1, (bf16x8){l1[0], l1[1], l1[2], l1[3], h1[0], h1[1], h1[2], h1[3]}, o[d0], 0, 0, 0);   \
        o[d0] = __builtin_amdgcn_mfma_f32_32x32x16_bf16(pa2, (bf16x8){l2[0], l2[1], l2[2], l2[3], h2[0], h2[1], h2[2], h2[3]}, o[d0], 0, 0, 0);   \
        o[d0] = __builtin_amdgcn_mfma_f32_32x32x16_bf16(pa3, (bf16x8){l3[0], l3[1], l3[2], l3[3], h3[0], h3[1], h3[2], h3[3]}, o[d0], 0, 0, 0); } while (0)
    PV_D0(0); PV_D0(1); PV_D0(2); PV_D0(3);
#undef PV_D0
#undef TRRD
}

struct HeadRef { const bf16* Q; const bf16* K; const bf16* V; bf16* O; const float* FS; };
template <bool MLA> struct Seam { bf16x8 qr[MLA ? 12 : 8]; bf16x8 st_v0, st_v1, st_k0, st_k1; bf16x8 st_kr; bf16x8 ql[1]; };
template <bool MLA> struct Geo {
    static constexpr int QP = MLA ? 192 : 128, KP = MLA ? 192 : 128, VP = MLA ? 128 : NP_G, OP = 1024;
};
#define VMW() asm volatile("s_waitcnt vmcnt(0)" ::: "memory")
#define VMWN(n) asm volatile("s_waitcnt vmcnt(%0)" :: "i"(n) : "memory")
#define SLOAD_H(Kp, Vp, k0) do { S.st_v0 = load8((Vp) + (size_t)((k0) + sr) * G::VP + sc); S.st_v1 = load8((Vp) + (size_t)((k0) + 32 + sr) * G::VP + sc);              \
                         S.st_k0 = load8((Kp) + (size_t)((k0) + sr) * G::KP + sc); S.st_k1 = load8((Kp) + (size_t)((k0) + 32 + sr) * G::KP + sc);              \
                         if constexpr (MLA) S.st_kr = load8((Kp) + (size_t)((k0) + (tid >> 3)) * G::KP + 128 + (tid & 7) * 8); } while (0)
#define SWRITE_HK(bf) do { *(bf16x8*)(K_lds + (bf) * SHM_K + kws) = S.st_k0; *(bf16x8*)(K_lds + (bf) * SHM_K + kws1) = S.st_k1;  \
                           if constexpr (MLA) *(bf16x8*)(lds + L_KR + (bf) * SHM_KR + krw) = S.st_kr; } while (0)
#define SWRITE_HV(bf) do { *(bf16x8*)(V_lds + (bf) * SHM_V + vst0) = S.st_v0; *(bf16x8*)(V_lds + (bf) * SHM_V + vst1) = S.st_v1; } while (0)
#define SWRITE_H(bf) do { SWRITE_HV(bf); SWRITE_HK(bf); } while (0)
#define QLOAD_R(ref) do { _Pragma("unroll") for (int d0 = 0; d0 < NQR; ++d0) S.qr[d0] = load8((ref) + (size_t)(wid * QBLK + r32) * G::QP + d0 * 16 + hi * 8); } while (0)
#define QLOAD_L(ref) do { _Pragma("unroll") for (int dr = 0; dr < NQLDS; ++dr) S.ql[dr] = load8((ref) + (size_t)(wid * QBLK + r32) * G::QP + NQR * 16 + dr * 16 + hi * 8); } while (0)
#define QROPE_TO_LDS() do { _Pragma("unroll") for (int dr = 0; dr < NQLDS; ++dr) *(bf16x8*)(lds + L_X + qrb + dr * 1024) = S.ql[dr]; } while (0)

template <bool MLA>
__device__ __forceinline__ void prime(const HeadRef& H, int qb_cur, char* lds, Seam<MLA>& S) {
    typedef Geo<MLA> G;
    const int tid = mk_lnd_v(threadIdx.x), wid = __builtin_amdgcn_readfirstlane(tid >> 6), lane = tid & 63, r32 = lane & 31, hi = lane >> 5;
    const int sr = tid >> 4, sc = (tid & 15) * 8, kws = KLAY(sr, tid & 15), kws1 = KLAY(32 + sr, tid & 15); char* K_lds = lds + L_K;
    constexpr int NQLDS = 0, NQR = MLA ? 12 : 8;
    const int krw = KLAY(tid >> 3, tid & 7), qrb = wid * (NQLDS * 1024) + lane * 16;
    const bf16* Qc = H.Q + (size_t)qb_cur * QB * G::QP;
    QLOAD_R(Qc); QLOAD_L(Qc);
    SLOAD_H(H.K, H.V, 0); VMW(); SWRITE_HK(0); QROPE_TO_LDS();
    __syncthreads();
}
template <bool MLA>
__device__ __forceinline__ void block(const HeadRef& H, int qb_cur, int qb_nxt, char* lds, Seam<MLA>& S) {
    typedef Geo<MLA> G;
    constexpr bool BIAS = !MLA; constexpr int NQLDS = 0, NQR = MLA ? 12 : 8;
    const int tid = mk_lnd_v(threadIdx.x), wid = __builtin_amdgcn_readfirstlane(tid >> 6), lane = tid & 63, r32 = lane & 31, hi = lane >> 5;
    const int P0 = qb_cur * QB;
    const int NT = (P0 + QB - 1) / KVBLK + 1;
    const int qlo = P0 + wid * QBLK, qm = qlo + r32 - 4 * hi;
    char* V_lds = lds + L_V; char* K_lds = lds + L_K;
    float* ws = (float*)(lds + L_WS) + wid * 64; float* li_l = ws, * al_l = ws + 32;
    float m_reg = -1e30f, l_reg = 0; f32x16 o[4] = {};
    const int sr = tid >> 4, sc = (tid & 15) * 8, vst0 = v_st(sr, sc), vst1 = v_st(32 + sr, sc), kws = KLAY(sr, tid & 15), kws1 = KLAY(32 + sr, tid & 15);
    const int krw = KLAY(tid >> 3, tid & 7), qrb = wid * (NQLDS * 1024) + lane * 16, krb = r32 * 16 + hi * 1168, fbh = hi * 16;
    const int vb0 = (int)(uintptr_t)V_lds + v_rd_base(lane);
    const bf16* Kh = H.K; const bf16* Vh = H.V;
    if constexpr (BIAS) {
        const int nk4 = (P0 + QB) / 4;
        for (int i = tid; i < nk4; i += NW * 64) *(f32x4*)(lds + L_FB + i * 16) = -*(const f32x4*)(H.FS + i * 4);
        __syncthreads();
    }
#define RESC(a) do { if (__any((a) < 1.f)) { if (hi == 0) al_l[r32] = (a); asm volatile("s_waitcnt lgkmcnt(0)" ::: "memory");              \
                     for (int d_ = 0; d_ < 4; ++d_) for (int r = 0; r < 16; ++r) o[d_][r] *= al_l[crow(r, hi)]; } } while (0)
#define KBASE(t) ((t) * KVBLK)
#define MASKT(P0_, P1_, t) do { const int kb_ = KBASE(t); if (kb_ + KVBLK - 1 > qlo) mask_tile(P0_, P1_, qm - kb_); } while (0)
    f32x16 pA0, pA1, pB0, pB1; float mnA, mnB, alA, alB; bf16x8 pa0, pa1, pa2, pa3;
    SWRITE_HV(0); SBAR();
    if (NT > 1) { SLOAD_H(Kh, Vh, KBASE(1)); }
    SBAR(); qkt<0, MLA, BIAS>(pA0, pA1, lds, r32, hi, S.qr, krb, qrb, fbh + KBASE(0) * 4);
    MASKT(pA0, pA1, 0); partialSM<MLA>(pA0, pA1, m_reg, mnA, alA);
    if (NT > 1) { VMW(); SWRITE_H(1); }
    __syncthreads();
#define HALF_STEP(PX0, PX1, mnX, alX, PY0, PY1, alY, t, KB, VB, SB) do {                                                      \
        SBAR(); qkt<KB, MLA, BIAS>(PX0, PX1, lds, r32, hi, S.qr, krb, qrb, fbh + KBASE(t) * 4);                                                         \
        finishSM(PY0, PY1, alY, l_reg, pa0, pa1, pa2, pa3); SBAR();                                                           \
        if ((t) + 1 < NT) { SLOAD_H(Kh, Vh, KBASE((t) + 1)); SBAR(); }                                                        \
        pv_tile<VB>(o, vb0, pa0, pa1, pa2, pa3); MASKT(PX0, PX1, (t)); partialSM<MLA>(PX0, PX1, m_reg, mnX, alX);             \
        __syncthreads();                                                                                                      \
        if ((t) + 1 < NT) { VMW(); SWRITE_H(SB); }                                                                            \
        RESC(alX); __syncthreads(); } while (0)
    for (int t = 1; t + 1 < NT; t += 2) {
        HALF_STEP(pB0, pB1, mnB, alB, pA0, pA1, alA, t, 1, 0, 0);
        HALF_STEP(pA0, pA1, mnA, alA, pB0, pB1, alB, t + 1, 0, 1, 1);
    }
    const bool even = (NT & 1) == 0;
    if (even) { SBAR(); qkt<1, MLA, BIAS>(pB0, pB1, lds, r32, hi, S.qr, krb, qrb, fbh + KBASE(NT - 1) * 4); SBAR(); }
    finishSM(pA0, pA1, alA, l_reg, pa0, pa1, pa2, pa3); SBAR();
    pv_tile<0>(o, vb0, pa0, pa1, pa2, pa3);
    if (even) { MASKT(pB0, pB1, NT - 1); partialSM<MLA>(pB0, pB1, m_reg, mnB, alB); __syncthreads(); RESC(alB);
        finishSM(pB0, pB1, alB, l_reg, pa0, pa1, pa2, pa3); SBAR(); pv_tile<1>(o, vb0, pa0, pa1, pa2, pa3); }
    SBAR();
    const bf16* Qn = H.Q + (size_t)qb_nxt * QB * G::QP;
    SLOAD_H(Kh, Vh, 0); QLOAD_R(Qn); SBAR();
    if (hi == 0) li_l[r32] = l_reg; asm volatile("s_waitcnt lgkmcnt(0)" ::: "memory");
    float rli[16];
#pragma unroll
    for (int r = 0; r < 16; ++r) rli[r] = __builtin_amdgcn_rcpf(li_l[crow(r, hi)]);
    bf16* Ow = H.O + (size_t)(P0 + wid * QBLK) * G::OP;
#pragma unroll
    for (int r = 0; r < 16; ++r) { const int orow = crow(r, hi);
#pragma unroll
        for (int d0 = 0; d0 < 4; ++d0) { const float v = o[d0][r] * rli[r];
            const float vn = __shfl_xor(v, 1);
            if ((r32 & 1) == 0) *(unsigned*)(Ow + (size_t)orow * G::OP + d0 * 32 + r32) = cvtpk(v, vn); } }
    SBAR(); QLOAD_L(Qn); VMW(); SWRITE_HK(0); QROPE_TO_LDS();
    __syncthreads();
#undef RESC
#undef KBASE
#undef MASKT
#undef HALF_STEP
}
#undef VMW
#undef VMWN
#undef SLOAD_H
#undef SWRITE_HK
#undef SWRITE_HV
#undef SWRITE_H
#undef QLOAD_R
#undef QLOAD_L
#undef QROPE_TO_LDS
#undef PK4
}


namespace mk {
using pg8::bf16_t; using pg8::f32x4; using pg8::u32x4; using pg8::bf16x8; using pg8::Unit; using pg8::cvt_pk_bf16;
typedef GAS unsigned gu32;
#define RLX_AGENT __ATOMIC_RELAXED, __HIP_MEMORY_SCOPE_AGENT
constexpr int NWAVES = 8, NTHREADS = 512;
constexpr int NP = NP_G;
constexpr int P_CQ = 0, P_CKV = 512, P_GQ = 1024, P_GK = 1536, P_GV = 2048, P_GR = 3072, P_FQ = 4096, P_FK = 5120, P_FV = 6144, P_GATES = 7168, P_KR = 13312, P_GA = 13376, P_FL = 13392;
__host__ __device__ __forceinline__ int map_in(int n) {
    if (n < 1024) return n;
    if (n < 1088) return P_KR + (n - 1024);
    if (n < 3136) return n - 1088 + 1024;
    if (n < 3152) return P_GA + (n - 3136);
    if (n < 7248) return n - 3152 + 3072;
    if (n < 7256) return P_FL + (n - 7248);
    return n - 7256 + P_GATES;
}
__host__ __device__ __forceinline__ int rope_pos(int i) { const int half = i >> 5, jj = i & 31; return 32 * (jj >> 4) + 8 * ((jj >> 2) & 3) + 4 * half + (jj & 3); }
__host__ __device__ __forceinline__ int map_uq(int n) { const int h = n / 192, j = n % 192; return h * 256 + (j < 128 ? j : 128 + rope_pos(j - 128)); }
__host__ __device__ __forceinline__ int map_gu(int n) { const int up = n >= FFH, j = up ? n - FFH : n; return (j >> 7) * 256 + up * 128 + (j & 127); }
__host__ __device__ __forceinline__ int map_id(int n) { return n; }

constexpr size_t MiB = 1u << 20;
constexpr size_t WS_CTL = 0, CTL_ZERO_BYTES = 64 * 1024;
constexpr size_t LW_WIN = 0, LW_WUQ = 53 * MiB, LW_WUKV = 55 * MiB, LW_WBR = 57 * MiB, LW_WOUT = 69 * MiB, LW_WGU = 77 * MiB, LW_WDN = 121 * MiB, LW_BYTES = 143 * MiB;
static_assert((size_t)NP * DM * 2 == 53 * MiB && (size_t)2 * FFH * DM * 2 == 44 * MiB && (size_t)DM * FFH * 2 == 22 * MiB, "weight sizes");
constexpr size_t WS_W = 1 * MiB;
constexpr int CW_TMO = 0, CW_CODE = 1, CW_BAR = 4096, CW_QUEUE = 65536;

constexpr int RING_OFF = 0, LDS_BYTES = 163840, LDSCTL_OFF = LDS_BYTES - 512, MISC_OFF = LDSCTL_OFF + 320;

__device__ __forceinline__ float wave_sum(float v) {
#pragma unroll
    for (int o = 1; o < 64; o <<= 1) v += __shfl_xor(v, o);
    return v;
}
__device__ __forceinline__ unsigned f2bf(float f) { unsigned u = __builtin_bit_cast(unsigned, f); return (u + 0x7fffu + ((u >> 16) & 1u)) >> 16; }
__device__ __forceinline__ unsigned pk2(float lo, float hi) { return f2bf(lo) | (f2bf(hi) << 16); }
__device__ __forceinline__ float bf2f(unsigned short b) { return __builtin_bit_cast(float, (unsigned)b << 16); }
__device__ __forceinline__ float bflo(unsigned w) { return __builtin_bit_cast(float, w << 16); }
__device__ __forceinline__ float bfhi(unsigned w) { return __builtin_bit_cast(float, w & 0xffff0000u); }
__device__ __forceinline__ float fast_sigmoid(float x) { return __builtin_amdgcn_rcpf(1.f + __builtin_amdgcn_exp2f(-1.4426950408889634f * x)); }

struct EpiStoreBf16 {
    static constexpr bool PERM = true, AFTER_DRAIN = false;
    bf16_t* O; int ldc; const LAS float* RT;
    __device__ __forceinline__ void operator()(const f32x4 (&acc)[2][2][4][2], const Unit& u, int wr, int wc, int fr, int fq) const {
        const int row0 = u.pm * 256 + wr * 64 + fr, col0 = u.pn * 256 + wc * 32 + 8 * fq;
#pragma unroll
        for (int ai = 0; ai < 2; ++ai)
#pragma unroll
            for (int m = 0; m < 4; ++m) { const int row = row0 + ai * 128 + m * 16; bf16_t* rowp = O + (size_t)row * ldc + col0;
                const float r = RT[wr * 64 + fr + ai * 128 + m * 16];
#pragma unroll
                for (int bj = 0; bj < 2; ++bj) { const f32x4 v0 = acc[ai][bj][m][0] * r, v1 = acc[ai][bj][m][1] * r;
                    u32x4 w; w.x = cvt_pk_bf16(v0[0], v0[1]); w.y = cvt_pk_bf16(v0[2], v0[3]); w.z = cvt_pk_bf16(v1[0], v1[1]); w.w = cvt_pk_bf16(v1[2], v1[3]);
                    *(u32x4*)(rowp + bj * 128) = w; } }
    }
};
struct EpiSwiglu {
    static constexpr bool PERM = true, AFTER_DRAIN = false;
    bf16_t* O; int ldc; const LAS float* RT;
    __device__ __forceinline__ void operator()(const f32x4 (&acc)[2][2][4][2], const Unit& u, int wr, int wc, int fr, int fq) const {
        const int row0 = u.pm * 256 + wr * 64 + fr, col0 = u.pn * 128 + wc * 32 + 8 * fq;
#pragma unroll
        for (int ai = 0; ai < 2; ++ai)
#pragma unroll
            for (int m = 0; m < 4; ++m) { const int row = row0 + ai * 128 + m * 16; bf16_t* rowp = O + (size_t)row * ldc + col0;
                const float rs = RT[wr * 64 + fr + ai * 128 + m * 16];
                float r[8];
#pragma unroll
                for (int n = 0; n < 2; ++n)
#pragma unroll
                    for (int e = 0; e < 4; ++e) { const float g = acc[ai][0][m][n][e] * rs, up = acc[ai][1][m][n][e] * rs; r[n * 4 + e] = g * fast_sigmoid(g) * up; }
                u32x4 w; w.x = cvt_pk_bf16(r[0], r[1]); w.y = cvt_pk_bf16(r[2], r[3]); w.z = cvt_pk_bf16(r[4], r[5]); w.w = cvt_pk_bf16(r[6], r[7]);
                *(u32x4*)rowp = w; }
    }
};
struct EpiResidF32 {
    static constexpr bool PERM = false, AFTER_DRAIN = false;
    const float* R; float* C; int ldc;
    __device__ __forceinline__ void operator()(const f32x4 (&acc)[2][2][4][2], const Unit& u, int wr, int wc, int fr, int fq) const {
        const int row0 = u.pm * 256 + wr * 64 + fr, col0 = u.pn * 256 + wc * 32 + 4 * fq;
#pragma unroll
        for (int ai = 0; ai < 2; ++ai)
#pragma unroll
            for (int m = 0; m < 4; ++m) { const size_t ro = (size_t)(row0 + ai * 128 + m * 16) * ldc + col0;
#pragma unroll
                for (int bj = 0; bj < 2; ++bj)
#pragma unroll
                    for (int n = 0; n < 2; ++n) { const f32x4 r = *(const f32x4*)(R + ro + bj * 128 + n * 16); *(f32x4*)(C + ro + bj * 128 + n * 16) = r + acc[ai][bj][m][n]; } }
    }
};
struct EpiResidNorm {
    static constexpr bool PERM = true, AFTER_DRAIN = true;
    const void* R; void* C; int ldc; bf16_t* XB; float* SSP; const float* g; int emit; int rb, cb;
    __device__ __forceinline__ void operator()(const f32x4 (&)[2][2][4][2], const Unit&, int, int, int, int) const {}
    template <bool RB, bool CB>
    __device__ __forceinline__ void body(const f32x4 (&acc)[2][2][4][2], const Unit& u, int wr, int wc, int fr, int fq, LAS float* P, const f32x4 (&g0)[2], const f32x4 (&g1)[2]) const {
        const int col0 = u.pn * 256 + wc * 32 + 8 * fq;
#pragma unroll
        for (int ai = 0; ai < 2; ++ai) {
            f32x4 rv[4][2][2]; u32x4 rw[4][2];
#pragma unroll
            for (int m = 0; m < 4; ++m)
#pragma unroll
                for (int bj = 0; bj < 2; ++bj) { const size_t ro = (size_t)(u.pm * 256 + ai * 128 + wr * 64 + m * 16 + fr) * ldc + col0;
                    if (RB) rw[m][bj] = *(const u32x4*)((const bf16_t*)R + ro + bj * 128);
                    else { rv[m][bj][0] = *(const f32x4*)((const float*)R + ro + bj * 128); rv[m][bj][1] = *(const f32x4*)((const float*)R + ro + bj * 128 + 4); } }
#pragma unroll
            for (int m = 0; m < 4; ++m) { const int rl = ai * 128 + wr * 64 + m * 16 + fr; const size_t ro = (size_t)(u.pm * 256 + rl) * ldc + col0; float s = 0.f;
#pragma unroll
                for (int bj = 0; bj < 2; ++bj) {
                    f32x4 r0, r1;
                    if (RB) { const u32x4 w = rw[m][bj];
                        r0 = (f32x4){__uint_as_float(w.x << 16), __uint_as_float(w.x & 0xffff0000u), __uint_as_float(w.y << 16), __uint_as_float(w.y & 0xffff0000u)};
                        r1 = (f32x4){__uint_as_float(w.z << 16), __uint_as_float(w.z & 0xffff0000u), __uint_as_float(w.w << 16), __uint_as_float(w.w & 0xffff0000u)}; }
                    else { r0 = rv[m][bj][0]; r1 = rv[m][bj][1]; }
                    const f32x4 x0 = r0 + acc[ai][bj][m][0], x1 = r1 + acc[ai][bj][m][1];
                    if (CB) { u32x4 w; w.x = cvt_pk_bf16(x0[0], x0[1]); w.y = cvt_pk_bf16(x0[2], x0[3]); w.z = cvt_pk_bf16(x1[0], x1[1]); w.w = cvt_pk_bf16(x1[2], x1[3]);
                        *(u32x4*)((bf16_t*)C + ro + bj * 128) = w; }
                    else { *(f32x4*)((float*)C + ro + bj * 128) = x0; *(f32x4*)((float*)C + ro + bj * 128 + 4) = x1; }
                    if (emit) { s += ((x0[0] * x0[0] + x0[1] * x0[1]) + (x0[2] * x0[2] + x0[3] * x0[3])) + ((x1[0] * x1[0] + x1[1] * x1[1]) + (x1[2] * x1[2] + x1[3] * x1[3]));
                        const f32x4 y0 = x0 * g0[bj], y1 = x1 * g1[bj];
                        u32x4 w; w.x = cvt_pk_bf16(y0[0], y0[1]); w.y = cvt_pk_bf16(y0[2], y0[3]); w.z = cvt_pk_bf16(y1[0], y1[1]); w.w = cvt_pk_bf16(y1[2], y1[3]);
                        *(u32x4*)(XB + ro + bj * 128) = w; } }
                if (emit) { s += __shfl_xor(s, 16); s += __shfl_xor(s, 32); if (fq == 0) P[rl * 4 + wc] = s; } }
            asm volatile("" ::: "memory"); }
    }
    __device__ __forceinline__ void fused(const f32x4 (&acc)[2][2][4][2], const Unit& u, int wr, int wc, int fr, int fq, LAS unsigned char* lds, int wid, int lane) const {
        LAS float* P = (LAS float*)lds;
        const int col0 = u.pn * 256 + wc * 32 + 8 * fq;
        f32x4 g0[2], g1[2];
#pragma unroll
        for (int bj = 0; bj < 2; ++bj) { g0[bj] = emit ? *(const f32x4*)(g + col0 + bj * 128) : (f32x4){0.f, 0.f, 0.f, 0.f}; g1[bj] = emit ? *(const f32x4*)(g + col0 + bj * 128 + 4) : (f32x4){0.f, 0.f, 0.f, 0.f}; }
        if (rb && cb) body<true, true>(acc, u, wr, wc, fr, fq, P, g0, g1);
        else if (rb) body<true, false>(acc, u, wr, wc, fr, fq, P, g0, g1);
        else body<false, true>(acc, u, wr, wc, fr, fq, P, g0, g1);
        if (emit) {
            asm volatile("s_waitcnt lgkmcnt(0)" ::: "memory"); __builtin_amdgcn_s_barrier(); asm volatile("" ::: "memory");
            const int t = wid * 64 + lane;
            if (t < 256) { const f32x4 p = *(const LAS f32x4*)(P + t * 4); SSP[(size_t)(u.pm * 256 + t) * 8 + u.pn] = (p.x + p.y) + (p.z + p.w); }
            asm volatile("s_waitcnt lgkmcnt(0)" ::: "memory"); __builtin_amdgcn_s_barrier(); asm volatile("" ::: "memory");
        }
    }
};

struct BranchOrder {
    pg8::StaticOrder T;
    __device__ void init(int G, int c) { T.init(S, DM, G, c); }
    __device__ bool next(int i, Unit& u) const { Unit t; const int n = i % 3; if (!T.next(i / 3, t)) return false; u.pm = 32 * n + t.pm; u.pn = 8 * n + t.pn; return true; }
    __device__ __forceinline__ void a_ready(const Unit&) const {}
    __device__ __forceinline__ void done(const Unit&) const {}
};
struct EpiGateMergeAll {
    static constexpr bool PERM = true, AFTER_DRAIN = false;
    const bf16_t* G; int ldg; bf16_t* PART; bf16_t* Mb; int ldc;
    __device__ __forceinline__ void operator()(const f32x4 (&acc)[2][2][4][2], const Unit& u, int wr, int wc, int fr, int fq) const {
        const int n = u.pn >> 3, pm = u.pm & 31, pn = u.pn & 7;
        const int row0 = pm * 256 + wr * 64 + fr, col0 = pn * 256 + wc * 32 + 8 * fq;
        bf16_t* dst = (n < 2) ? PART : Mb;
#pragma unroll
        for (int ai = 0; ai < 2; ++ai) {
            u32x4 gw[4][2], pw[4][2];
#pragma unroll
            for (int m = 0; m < 4; ++m)
#pragma unroll
                for (int bj = 0; bj < 2; ++bj) { const size_t row = (size_t)(row0 + ai * 128 + m * 16);
                    gw[m][bj] = *(const u32x4*)(G + row * ldg + n * DM + col0 + bj * 128);
                    pw[m][bj] = (n > 0) ? *(const u32x4*)(PART + row * ldc + col0 + bj * 128) : (u32x4){0u, 0u, 0u, 0u}; }
#pragma unroll
            for (int m = 0; m < 4; ++m)
#pragma unroll
                for (int bj = 0; bj < 2; ++bj) { const size_t row = (size_t)(row0 + ai * 128 + m * 16);
                    const u32x4 g4 = gw[m][bj], p4 = pw[m][bj];
                    f32x4 a0 = acc[ai][bj][m][0], a1 = acc[ai][bj][m][1];
                    a0[0] = fmaf(a0[0], fast_sigmoid(bflo(g4.x)), bflo(p4.x)); a0[1] = fmaf(a0[1], fast_sigmoid(bfhi(g4.x)), bfhi(p4.x)); a0[2] = fmaf(a0[2], fast_sigmoid(bflo(g4.y)), bflo(p4.y)); a0[3] = fmaf(a0[3], fast_sigmoid(bfhi(g4.y)), bfhi(p4.y));
                    a1[0] = fmaf(a1[0], fast_sigmoid(bflo(g4.z)), bflo(p4.z)); a1[1] = fmaf(a1[1], fast_sigmoid(bfhi(g4.z)), bfhi(p4.z)); a1[2] = fmaf(a1[2], fast_sigmoid(bflo(g4.w)), bflo(p4.w)); a1[3] = fmaf(a1[3], fast_sigmoid(bfhi(g4.w)), bfhi(p4.w));
                    u32x4 w; w.x = cvt_pk_bf16(a0[0], a0[1]); w.y = cvt_pk_bf16(a0[2], a0[3]); w.z = cvt_pk_bf16(a1[0], a1[1]); w.w = cvt_pk_bf16(a1[2], a1[3]);
                    *(u32x4*)(dst + row * ldc + col0 + bj * 128) = w; }
            asm volatile("" ::: "memory"); }
    }
};

struct Args {
    const float* in[21]; float* out; unsigned char* ws;
    int pro_lo, pro_hi;
    int l_lo, l_hi, ph_lo, ph_hi;
    int li, pad;
};
struct Frame {
    LAS unsigned char* lds; volatile LAS unsigned* MISC; gu32* ctl;
    int tid, lane, wave, G, vcu;
};
__device__ __forceinline__ Frame relaunder(const Frame& F0) {
    Frame F = F0; int t = F0.tid, v = F0.vcu, g = F0.G;
    asm volatile("" : "+v"(t)); asm volatile("" : "+s"(v)); asm volatile("" : "+s"(g));
    F.tid = t; F.lane = t & 63; F.wave = __builtin_amdgcn_readfirstlane(t >> 6); F.vcu = v; F.G = g; return F;
}
#ifndef MK_WSTRIDE
#define MK_WSTRIDE 0
#endif
constexpr size_t WSTRIDE = MK_WSTRIDE;
constexpr size_t WBYTES = WSTRIDE ? (size_t)DEPTH * WSTRIDE : LW_BYTES;
constexpr size_t A_PROJ = WS_W + WBYTES, A_HN = A_PROJ + 212 * MiB, A_OA = A_HN + 32 * MiB, A_OB = A_OA + 16 * MiB, A_OC = A_OB + 16 * MiB, A_MERGED = A_OC + 16 * MiB,
                 A_CQN = A_MERGED + 64 * MiB, A_MQ = A_CQN + 16 * MiB, A_MK = A_MQ + 24 * MiB, A_MV = A_MK + 24 * MiB, A_FQ = A_MV + 16 * MiB, A_FK = A_FQ + 16 * MiB, A_FCUM = A_FK + 16 * MiB,
                 A_QT = A_FCUM + 1 * MiB, A_KT = A_QT + 8 * MiB, A_BLAST = A_KT + 8 * MiB, A_KVP = A_BLAST + 1 * MiB, A_SPREV = A_KVP + 64 * MiB, A_CS = A_SPREV + 32 * MiB, A_KRR = A_CS + 2 * MiB,
                 A_KRSS = A_KRR + 2 * MiB, A_HN2 = A_KRSS + 1 * MiB, A_SSPA = A_HN2 + 32 * MiB, A_SSPB = A_SSPA + 1 * MiB, A_XR = A_SSPB + 1 * MiB, A_END = A_XR + 32 * MiB;
typedef const __attribute__((address_space(4))) Args* ArgsP;
__device__ __forceinline__ int lnd_s(int v) { asm volatile("" : "+s"(v)); return v; }
__device__ __forceinline__ int lnd_v(int v) { asm volatile("" : "+v"(v)); return v; }
#define WSP(T, off) ((T*)(a->ws + (off)))
__device__ __forceinline__ ArgsP get_args() { ArgsP p = (ArgsP)__builtin_amdgcn_kernarg_segment_ptr(); asm volatile("" : "+s"(p)); return p; }

constexpr int I_IN = (DM / 64) * ((D_IN + 63) / 64), I_UQ = (512 / 64) * (1536 / 64), I_UKV = (512 / 64) * (2048 / 64), I_BR = (1024 / 64) * (DM / 64), I_OUT = (DM / 64) * (DM / 64),
              I_GU = (DM / 64) * (2 * FFH / 64), I_DN = (FFH / 64) * (DM / 64);
constexpr int NITEMS = I_IN + I_UQ + I_UKV + 3 * I_BR + I_OUT + I_GU + I_DN;
struct CvItem { const float* src; bf16_t* dst; int K, N, k0, n0, kind; };
__device__ __forceinline__ CvItem cv_decode(ArgsP a, int l, int r) {
    unsigned char* wb = a->ws + WS_W + (size_t)l * WSTRIDE;
    CvItem it;
    if (r < I_IN) { it.src = a->in[3] + (size_t)l * DM * D_IN; it.dst = (bf16_t*)(wb + LW_WIN); it.K = DM; it.N = D_IN; it.kind = 1; }
    else if ((r -= I_IN) < I_UQ) { it.src = a->in[5] + (size_t)l * 512 * 1536; it.dst = (bf16_t*)(wb + LW_WUQ); it.K = 512; it.N = 1536; it.kind = 2; }
    else if ((r -= I_UQ) < I_UKV) { it.src = a->in[7] + (size_t)l * 512 * 2048; it.dst = (bf16_t*)(wb + LW_WUKV); it.K = 512; it.N = 2048; it.kind = 0; }
    else if ((r -= I_UKV) < 3 * I_BR) { const int n = r / I_BR; r -= n * I_BR; it.src = a->in[16] + (size_t)(l * 3 + n) * 1024 * DM; it.dst = (bf16_t*)(wb + LW_WBR) + (size_t)n * DM * 1024; it.K = 1024; it.N = DM; it.kind = 0; }
    else if ((r -= 3 * I_BR) < I_OUT) { it.src = a->in[17] + (size_t)l * DM * DM; it.dst = (bf16_t*)(wb + LW_WOUT); it.K = DM; it.N = DM; it.kind = 0; }
    else if ((r -= I_OUT) < I_GU) { it.src = a->in[19] + (size_t)l * DM * 2 * FFH; it.dst = (bf16_t*)(wb + LW_WGU); it.K = DM; it.N = 2 * FFH; it.kind = 3; }
    else { r -= I_GU; it.src = a->in[20] + (size_t)l * FFH * DM; it.dst = (bf16_t*)(wb + LW_WDN); it.K = FFH; it.N = DM; it.kind = 0; }
    const int nblk = (it.N + 63) >> 6, kb = r / nblk, nb = r - kb * nblk; it.k0 = 64 * kb; it.n0 = 64 * nb;
    return it;
}
__device__ __forceinline__ void cv_load(const CvItem& it, int lane, f32x4 (&v)[8][2]) {
    const int n4 = lane & 15, kq = lane >> 4, n = it.n0 + 4 * n4;
    const bool ok = n < it.N;
    const float* src = it.src + (size_t)(it.k0 + 2 * kq) * it.N + n;
#pragma unroll
    for (int ii = 0; ii < 8; ++ii)
#pragma unroll
        for (int t = 0; t < 2; ++t) v[ii][t] = ok ? __builtin_nontemporal_load((const f32x4*)(src + (size_t)(8 * ii + t) * it.N)) : (f32x4){0.f, 0.f, 0.f, 0.f};
}
__device__ __forceinline__ void cv_store(const CvItem& it, const f32x4 (&v)[8][2], LAS unsigned* scr, int lane) {
    const int n4 = lane & 15, kq = lane >> 4;
#pragma unroll
    for (int ii = 0; ii < 8; ++ii)
#pragma unroll
        for (int e = 0; e < 4; ++e) scr[(4 * n4 + e) * 34 + kq + 4 * ii] = cvt_pk_bf16(v[ii][0][e], v[ii][1][e]);
    asm volatile("s_waitcnt lgkmcnt(0)" ::: "memory");
    const int c8 = lane & 7;
#pragma unroll
    for (int j = 0; j < 8; ++j) { const int nn = (lane >> 3) + 8 * j, n = it.n0 + nn;
        typedef unsigned u32x2 __attribute__((ext_vector_type(2)));
        const u32x2 lo = *(const LAS u32x2*)(scr + nn * 34 + 4 * c8), hi2 = *(const LAS u32x2*)(scr + nn * 34 + 4 * c8 + 2);
        const int dr = it.kind == 0 ? n : (it.kind == 1 ? map_in(n) : (it.kind == 2 ? map_uq(n) : map_gu(n)));
        if (n < it.N) *(u32x4*)(it.dst + (size_t)dr * it.K + it.k0 + 8 * c8) = (u32x4){lo.x, lo.y, hi2.x, hi2.y}; }
    asm volatile("s_waitcnt lgkmcnt(0)" ::: "memory");
}
__device__ __forceinline__ void cv_run(ArgsP a, int l0, int first, int stride, int count, LAS unsigned* scr, int lane, int P = NITEMS, int OFF = 0) {
    if (count <= 0) return;
    CvItem cur = cv_decode(a, l0 + first / P, OFF + first % P);
    f32x4 v[8][2]; cv_load(cur, lane, v);
    for (int i = 1; i <= count; ++i) {
        CvItem nxt = cur; f32x4 w[8][2];
        if (i < count) { const int r = first + i * stride; nxt = cv_decode(a, l0 + r / P, OFF + r % P); cv_load(nxt, lane, w); }
        cv_store(cur, v, scr, lane);
        if (i < count) { cur = nxt;
#pragma unroll
            for (int ii = 0; ii < 8; ++ii) { v[ii][0] = w[ii][0]; v[ii][1] = w[ii][1]; } }
    }
}
constexpr int CV_W1 = 96, CV_R1 = 7, CV_B1 = 0, CV_W4 = 128, CV_R4 = 6, CV_B4 = CV_B1 + CV_W1 * CV_R1 * 8, CV_W8 = 128, CV_R8 = 7, CV_B8 = CV_B4 + CV_W4 * CV_R4 * 8;
constexpr int CV_END = (CV_B8 + CV_W8 * CV_R8 * 8) < NITEMS ? (CV_B8 + CV_W8 * CV_R8 * 8) : NITEMS, CV_TAIL = NITEMS - CV_END;
__device__ __forceinline__ void prologue_weights(const Frame& F0, int l_lo, int l_hi) {
    const Frame F = relaunder(F0);
    ArgsP a = get_args();
    LAS unsigned* scr = (LAS unsigned*)(F.lds + RING_OFF + F.wave * 16384);
    const int gw = F.vcu * NWAVES + F.wave, NGW = F.G * NWAVES, total = (l_hi - l_lo) * NITEMS;
    cv_run(a, l_lo, gw, NGW, gw < total ? (total - gw + NGW - 1) / NGW : 0, scr, F.lane);
    if (l_hi - l_lo == 1 && l_lo == 0 && CV_TAIL > 0) {
        const int tot2 = (DEPTH - 1) * CV_TAIL, g2 = (gw + NGW / 2) % NGW;
        cv_run(a, 1, g2, NGW, g2 < tot2 ? (tot2 - g2 + NGW - 1) / NGW : 0, scr, F.lane, CV_TAIL, CV_END);
    }
}
__device__ __forceinline__ void convert_slice(const Frame& F0, int l, int base, int rank, int W, int R) {
    if (l >= DEPTH) return;
    const Frame F = relaunder(F0);
    ArgsP a = get_args();
    LAS unsigned* scr = (LAS unsigned*)(F.lds + RING_OFF + F.wave * 16384);
    const int first = base + rank * 8 + F.wave, stride = W * 8;
    int count = 0; if (first < NITEMS) { count = (NITEMS - first + stride - 1) / stride; if (count > R) count = R; }
    cv_run(a, l, first, stride, count, scr, F.lane);
}
__device__ __forceinline__ void phase_rms0(const Frame& F0, const float* X, const float* g, bf16_t* O, float* SSP) {
    const Frame F = relaunder(F0);
    const int gw = F.vcu * NWAVES + F.wave, NGW = F.G * NWAVES, lane = F.lane;
    for (int m = gw; m < S; m += NGW) {
        const f32x4* xr = (const f32x4*)(X + (size_t)m * DM) + lane; const f32x4* gr = (const f32x4*)g + lane;
        f32x4 v[8]; float s = 0.f;
#pragma unroll
        for (int j = 0; j < 8; ++j) { v[j] = xr[64 * j]; s += (v[j].x * v[j].x + v[j].y * v[j].y) + (v[j].z * v[j].z + v[j].w * v[j].w); }
        s = wave_sum(s);
        unsigned long long* o8 = (unsigned long long*)(O + (size_t)m * DM) + lane;
#pragma unroll
        for (int j = 0; j < 8; ++j) { const f32x4 gg = gr[64 * j];
            o8[64 * j] = (unsigned long long)pk2(v[j].x * gg.x, v[j].y * gg.y) | ((unsigned long long)pk2(v[j].z * gg.z, v[j].w * gg.w) << 32); }
        if (lane < 2) *(f32x4*)(SSP + (size_t)m * 8 + 4 * lane) = (f32x4){lane == 0 ? s : 0.f, 0.f, 0.f, 0.f};
    }
}
constexpr int RT_OFF = 131072;
__device__ __forceinline__ int first_unit_pm(int nN, int G, int cidx) {
    const int nM = S / 256, nwg = nM * nN; if (cidx >= nwg) return -1;
    int wgid = cidx; { const int q = nwg / pg8::NXCD, r = nwg % pg8::NXCD, xcd = wgid % pg8::NXCD, off = wgid / pg8::NXCD; wgid = (xcd < r ? xcd * (q + 1) : r * (q + 1) + (xcd - r) * q) + off; }
    const int nig = pg8::WGM * nN, gid = wgid / nig, fm = gid * pg8::WGM, gsz = (nM - fm) < pg8::WGM ? (nM - fm) : pg8::WGM;
    return fm + ((wgid % nig) % gsz);
}
__device__ __forceinline__ void fill_rstd_table(const Frame& F0, const float* SSP, int pm) {
    const Frame F = relaunder(F0);
    if (F.tid < 256) { const int row = pm * 256 + F.tid;
        const f32x4 s0 = *(const f32x4*)(SSP + (size_t)row * 8), s1 = *(const f32x4*)(SSP + (size_t)row * 8 + 4);
        ((LAS float*)(F.lds + RT_OFF))[F.tid] = rsqrtf((((s0.x + s0.y) + (s0.z + s0.w)) + ((s1.x + s1.y) + (s1.z + s1.w))) * (1.f / DM) + EPS); }
    __syncthreads();
}

__device__ __forceinline__ float log_sigmoid_f(float x) { return fminf(x, 0.f) - __logf(1.f + __expf(-fabsf(x))); }
__device__ __forceinline__ void unpack8(const u32x4 w, float (&f)[8]) {
    f[0] = bflo(w.x); f[1] = bfhi(w.x); f[2] = bflo(w.y); f[3] = bfhi(w.y); f[4] = bflo(w.z); f[5] = bfhi(w.z); f[6] = bflo(w.w); f[7] = bfhi(w.w);
}
__device__ __forceinline__ u32x4 pack8f(const float (&f)[8]) { u32x4 w; w.x = cvt_pk_bf16(f[0], f[1]); w.y = cvt_pk_bf16(f[2], f[3]); w.z = cvt_pk_bf16(f[4], f[5]); w.w = cvt_pk_bf16(f[6], f[7]); return w; }

__device__ __forceinline__ void sincos_d(double a, double& sn, double& cn) {
    const double TWO_PI = 6.283185307179586476925286766559, HALF_PI = 1.5707963267948966192313216916398;
    const double k = rint(a / TWO_PI); double r = a - k * TWO_PI;
    const double q = rint(r / HALF_PI); r = r - q * HALF_PI; const int qi = ((int)q) & 3;
    const double r2 = r * r;
    const double sp = r * (1.0 + r2 * (-1.0 / 6 + r2 * (1.0 / 120 + r2 * (-1.0 / 5040 + r2 * (1.0 / 362880 + r2 * (-1.0 / 39916800 + r2 * (1.0 / 6227020800.0)))))));
    const double cp = 1.0 + r2 * (-0.5 + r2 * (1.0 / 24 + r2 * (-1.0 / 720 + r2 * (1.0 / 40320 + r2 * (-1.0 / 3628800 + r2 * (1.0 / 479001600.0 + r2 * (-1.0 / 87178291200.0)))))));
    if (qi == 0) { sn = sp; cn = cp; } else if (qi == 1) { sn = cp; cn = -sp; } else if (qi == 2) { sn = -sp; cn = -cp; } else { sn = -cp; cn = sp; }
}
__device__ __forceinline__ void rope_tables(const Frame& F0) {
    const Frame F = relaunder(F0);
    ArgsP a = get_args(); const int* pos = (const int*)a->in[1]; float* CS = WSP(float, A_CS);
    for (int i = F.vcu * NTHREADS + F.tid; i < S * 32; i += F.G * NTHREADS) {
        const int s = i >> 5, f = i & 31;
        const float inv = (float)exp2(-(double)f / 32.0 * 13.287712379549449391481277717958);
        const float ang = (float)pos[s] * inv;
        double sn, cn; sincos_d((double)ang, sn, cn);
        CS[s * 64 + f] = (float)cn; CS[s * 64 + 32 + f] = (float)sn;
    }
}

__device__ __forceinline__ void prep_row(int lane, int row, int l, ArgsP a) {
    const bf16_t* pr = WSP(bf16_t, A_PROJ) + (size_t)row * NP;
    const u32x4 cw0 = *(const u32x4*)(pr + P_CQ + 16 * lane), cw1 = *(const u32x4*)(pr + P_CQ + 16 * lane + 8);
    const u32x4 qw0 = *(const u32x4*)(pr + P_FQ + 16 * lane), qw1 = *(const u32x4*)(pr + P_FQ + 16 * lane + 8);
    const u32x4 kw0 = *(const u32x4*)(pr + P_FK + 16 * lane), kw1 = *(const u32x4*)(pr + P_FK + 16 * lane + 8);
    const float krv = bf2f(pr[P_KR + lane]);
    const float* cs = WSP(float, A_CS) + (size_t)row * 64;
    const float cc = cs[lane & 31], sn = cs[32 + (lane & 31)];
    {
        float v0[8], v1[8]; unpack8(cw0, v0); unpack8(cw1, v1);
        float s = 0.f;
#pragma unroll
        for (int i = 0; i < 8; ++i) s += v0[i] * v0[i] + v1[i] * v1[i];
#pragma unroll
        for (int o = 1; o < 32; o <<= 1) s += __shfl_xor(s, o);
        const float r = rsqrtf(s * (1.f / 512.f) + EPS);
        const float* g = (lane < 32) ? (a->in[4] + l * 512 + 16 * lane) : (a->in[6] + l * 512 + 16 * (lane - 32));
#pragma unroll
        for (int i = 0; i < 8; ++i) { v0[i] *= r * g[i]; v1[i] *= r * g[8 + i]; }
        bf16_t* op = WSP(bf16_t, A_CQN) + (size_t)row * 1024 + 16 * lane;
        *(u32x4*)op = pack8f(v0); *(u32x4*)(op + 8) = pack8f(v1);
    }
    {
        const float ss = wave_sum(krv * krv);
        const float y = krv * (a->in[9][l * 192 + 128 + lane]);
        const float yo = __shfl_xor(y, 32);
        WSP(float, A_KRR)[(size_t)row * 64 + rope_pos(lane)] = (lane < 32) ? (y * cc - yo * sn) : (y * cc + yo * sn);
        if (lane == 0) WSP(float, A_KRSS)[row] = ss;
    }
#pragma unroll
    for (int which = 0; which < 2; ++which) {
        float v0[8], v1[8]; unpack8(which ? kw0 : qw0, v0); unpack8(which ? kw1 : qw1, v1);
        float s = 0.f;
#pragma unroll
        for (int i = 0; i < 8; ++i) s += v0[i] * v0[i] + v1[i] * v1[i];
        s += __shfl_xor(s, 1); s += __shfl_xor(s, 2); s += __shfl_xor(s, 4);
        const float r = rsqrtf(s * (1.f / 128.f) + EPS);
        const float* g = a->in[which ? 14 : 13] + l * 128 + 16 * (lane & 7);
#pragma unroll
        for (int i = 0; i < 8; ++i) { v0[i] *= r * g[i]; v1[i] *= r * g[8 + i]; }
        bf16_t* op = WSP(bf16_t, which ? A_FK : A_FQ) + ((size_t)(lane >> 3) * S + row) * 128 + 16 * (lane & 7);
        *(u32x4*)op = pack8f(v0); *(u32x4*)(op + 8) = pack8f(v1);
    }
}
__device__ __forceinline__ void fox_cumsum(const Frame& F, int h, int l, ArgsP a) {
    LAS float* tot = (LAS float*)(F.lds);
    const bf16_t* P = WSP(bf16_t, A_PROJ) + P_FL + h; const float bf = a->in[15][l * 8 + h];
    const int t = F.tid; float v[16]; float run = 0.f;
    unsigned short raw[16];
#pragma unroll
    for (int i = 0; i < 16; ++i) raw[i] = P[(size_t)(t * 16 + i) * NP];
    asm volatile("" ::: "memory");
#pragma unroll
    for (int i = 0; i < 16; ++i) { run += log_sigmoid_f(bf2f(raw[i]) + bf); v[i] = run; }
    float inc = run;
#pragma unroll
    for (int o = 1; o < 64; o <<= 1) { const float n = __shfl_up(inc, o); if (F.lane >= o) inc += n; }
    if (F.lane == 63) tot[F.wave] = inc;
    __syncthreads();
    float woff = 0.f;
    for (int w = 0; w < F.wave; ++w) woff += tot[w];
    const float off = woff + inc - run;
    float* O = WSP(float, A_FCUM) + (size_t)h * S + t * 16;
#pragma unroll
    for (int i = 0; i < 16; ++i) O[i] = (v[i] + off) * 11.313708498984761f;
    __syncthreads();
}
__device__ __forceinline__ void gla_prep_unit(const Frame& F, int chunk, int h, int l, ArgsP a) {
    using namespace att;
    const int tid = lnd_v(F.tid), lane = tid & 63, w = __builtin_amdgcn_readfirstlane(tid >> 6), r32 = lane & 31, hi = lane >> 5, row0 = chunk * 64;
    char* lds = (char*)F.lds;
    char* Vl = lds;
    char* Kl = lds + 2 * SHM_V;
    float* LA = (float*)(lds + 3 * SHM_V);
    float* WA = (float*)(lds + 3 * SHM_V + 32768);
    float* GA = (float*)(lds + 3 * SHM_V + 32768 + 8192);
    float* TOT = (float*)(lds + 3 * SHM_V + 32768 + 8192 + 4096);
    const mk::bf16_t* PR = WSP(mk::bf16_t, A_PROJ) + (size_t)row0 * NP;
    if (tid < 128) { const int r = tid >> 1, hf = tid & 1; const u32x4 wv = *(const u32x4*)(PR + (size_t)r * NP + P_GA + 8 * hf); float t[8]; mk::unpack8(wv, t);
#pragma unroll
        for (int i = 0; i < 8; ++i) GA[r * 16 + 8 * hf + i] = t[i]; }
    { const int k = tid >> 5, d4 = (tid & 31) * 4; *(f32x4*)(WA + k * 128 + d4) = *(const f32x4*)(a->in[10] + (size_t)l * 16 * 512 + k * 512 + h * 128 + d4); }
    const int sr = tid >> 4, sc = (tid & 15) * 8, vst0 = v_st(sr, sc), vst1 = v_st(32 + sr, sc);
    { const bf16x8 v00 = load8(PR + (size_t)sr * NP + P_GV + h * 256 + sc), v01 = load8(PR + (size_t)(32 + sr) * NP + P_GV + h * 256 + sc);
      const bf16x8 v10 = load8(PR + (size_t)sr * NP + P_GV + h * 256 + 128 + sc), v11 = load8(PR + (size_t)(32 + sr) * NP + P_GV + h * 256 + 128 + sc);
      *(bf16x8*)(Vl + vst0) = v00; *(bf16x8*)(Vl + vst1) = v01; *(bf16x8*)(Vl + SHM_V + vst0) = v10; *(bf16x8*)(Vl + SHM_V + vst1) = v11; }
    __syncthreads();
    const int dg = tid & 15, jq = tid >> 4;
    {   float x0[8], x1[8];
        const f32x4 b0 = *(const f32x4*)(a->in[11] + l * 512 + h * 128 + dg * 8), b1 = *(const f32x4*)(a->in[11] + l * 512 + h * 128 + dg * 8 + 4);
#pragma unroll
        for (int i = 0; i < 4; ++i) { x0[i] = b0[i]; x0[4 + i] = b1[i]; x1[i] = b0[i]; x1[4 + i] = b1[i]; }
#pragma unroll
        for (int k = 0; k < 16; ++k) { const f32x4 w0 = *(const f32x4*)(WA + k * 128 + dg * 8), w1 = *(const f32x4*)(WA + k * 128 + dg * 8 + 4);
            const float g0 = GA[(2 * jq) * 16 + k], g1 = GA[(2 * jq + 1) * 16 + k];
#pragma unroll
            for (int i = 0; i < 4; ++i) { x0[i] = fmaf(g0, w0[i], x0[i]); x0[4 + i] = fmaf(g0, w1[i], x0[4 + i]); x1[i] = fmaf(g1, w0[i], x1[i]); x1[4 + i] = fmaf(g1, w1[i], x1[4 + i]); } }
#pragma unroll
        for (int i = 0; i < 8; ++i) { x0[i] = mk::log_sigmoid_f(x0[i]) * (1.f / 16.f); x1[i] = mk::log_sigmoid_f(x1[i]) * (1.f / 16.f); }
        *(f32x4*)(LA + (2 * jq) * 128 + dg * 8) = (f32x4){x0[0], x0[1], x0[2], x0[3]}; *(f32x4*)(LA + (2 * jq) * 128 + dg * 8 + 4) = (f32x4){x0[4], x0[5], x0[6], x0[7]};
        *(f32x4*)(LA + (2 * jq + 1) * 128 + dg * 8) = (f32x4){x1[0], x1[1], x1[2], x1[3]}; *(f32x4*)(LA + (2 * jq + 1) * 128 + dg * 8 + 4) = (f32x4){x1[4], x1[5], x1[6], x1[7]};
    }
    __syncthreads();
    { const int d = tid & 127, q = tid >> 7; float run = 0.f;
#pragma unroll
      for (int j = 0; j < 16; ++j) { run += LA[(16 * q + j) * 128 + d]; LA[(16 * q + j) * 128 + d] = run; }
      TOT[q * 128 + d] = run;
      __syncthreads();
      float off = 0.f;
      for (int qq = 0; qq < q; ++qq) off += TOT[qq * 128 + d];
      if (q > 0) {
#pragma unroll
          for (int j = 0; j < 16; ++j) LA[(16 * q + j) * 128 + d] += off; }
      if (q == 3) WSP(float, A_BLAST)[chunk * 512 + h * 128 + d] = run + off; }
    __syncthreads();
#pragma unroll
    for (int rr = 0; rr < 2; ++rr) { const int j = 2 * jq + rr;
        const u32x4 qw = *(const u32x4*)(PR + (size_t)j * NP + P_GQ + h * 128 + dg * 8), kw = *(const u32x4*)(PR + (size_t)j * NP + P_GK + h * 128 + dg * 8);
        float qv[8], kv[8]; mk::unpack8(qw, qv); mk::unpack8(kw, kv);
        const f32x4 c0 = *(const f32x4*)(LA + j * 128 + dg * 8), c1 = *(const f32x4*)(LA + j * 128 + dg * 8 + 4);
#pragma unroll
        for (int i = 0; i < 8; ++i) { const float bb = i < 4 ? c0[i] : c1[i - 4]; qv[i] *= 0.08838834764831845f * __expf(bb); kv[i] *= __expf(-bb); }
        const u32x4 qo = mk::pack8f(qv), ko = mk::pack8f(kv);
        *(u32x4*)(WSP(mk::bf16_t, A_QT) + (size_t)(row0 + j) * 512 + h * 128 + dg * 8) = qo;
        *(u32x4*)(WSP(mk::bf16_t, A_KT) + (size_t)(row0 + j) * 512 + h * 128 + dg * 8) = ko;
        *(u32x4*)(Kl + v_st(j, dg * 8)) = ko; }
    __syncthreads();
    {   const int vb = (int)(uintptr_t)Vl + v_rd_base(lane) + (w >> 2) * SHM_V + (w & 3) * 512;
        const int kb = (int)(uintptr_t)Kl + v_rd_base(lane);
#define TRRDV(dst, off) asm volatile("ds_read_b64_tr_b16 %0, %1 offset:%2" : "=&v"(dst) : "v"(vb), "i"(off) : "memory")
#define TRRDK(dst, off) asm volatile("ds_read_b64_tr_b16 %0, %1 offset:%2" : "=&v"(dst) : "v"(kb), "i"(off) : "memory")
        s16x4 vl0, vl1, vl2, vl3, vh0, vh1, vh2, vh3;
        TRRDV(vl0, 0); TRRDV(vh0, 2048); TRRDV(vl1, 4096); TRRDV(vh1, 6144); TRRDV(vl2, 8192); TRRDV(vh2, 10240); TRRDV(vl3, 12288); TRRDV(vh3, 14336);
        mk::bf16_t* O = WSP(mk::bf16_t, A_KVP) + ((size_t)(chunk * 4 + h) * 256 + w * 32 + r32) * 128 + 4 * hi;
#define KV_DB(db) do { s16x4 l0, l1, l2, l3, h0, h1, h2, h3; constexpr int b_ = (db) * 512;                                                                                                       \
            TRRDK(l0, b_); TRRDK(h0, b_ + 2048); TRRDK(l1, b_ + 4096); TRRDK(h1, b_ + 6144); TRRDK(l2, b_ + 8192); TRRDK(h2, b_ + 10240); TRRDK(l3, b_ + 12288); TRRDK(h3, b_ + 14336);         \
            asm volatile("s_waitcnt lgkmcnt(0)" ::: "memory"); SBAR();                                                                                                                          \
            f32x16 c = {};                                                                                                                                                                      \
            c = __builtin_amdgcn_mfma_f32_32x32x16_bf16((bf16x8){l0[0], l0[1], l0[2], l0[3], h0[0], h0[1], h0[2], h0[3]}, (bf16x8){vl0[0], vl0[1], vl0[2], vl0[3], vh0[0], vh0[1], vh0[2], vh0[3]}, c, 0, 0, 0);   \
            c = __builtin_amdgcn_mfma_f32_32x32x16_bf16((bf16x8){l1[0], l1[1], l1[2], l1[3], h1[0], h1[1], h1[2], h1[3]}, (bf16x8){vl1[0], vl1[1], vl1[2], vl1[3], vh1[0], vh1[1], vh1[2], vh1[3]}, c, 0, 0, 0);   \
            c = __builtin_amdgcn_mfma_f32_32x32x16_bf16((bf16x8){l2[0], l2[1], l2[2], l2[3], h2[0], h2[1], h2[2], h2[3]}, (bf16x8){vl2[0], vl2[1], vl2[2], vl2[3], vh2[0], vh2[1], vh2[2], vh2[3]}, c, 0, 0, 0);   \
            c = __builtin_amdgcn_mfma_f32_32x32x16_bf16((bf16x8){l3[0], l3[1], l3[2], l3[3], h3[0], h3[1], h3[2], h3[3]}, (bf16x8){vl3[0], vl3[1], vl3[2], vl3[3], vh3[0], vh3[1], vh3[2], vh3[3]}, c, 0, 0, 0);   \
                                                                                       \
            _Pragma("unroll") for (int g_ = 0; g_ < 4; ++g_) { typedef unsigned u32x2_ __attribute__((ext_vector_type(2))); *(u32x2_*)(O + (db) * 32 + 8 * g_) = (u32x2_){cvtpk_c(c[4 * g_], c[4 * g_ + 1]), cvtpk_c(c[4 * g_ + 2], c[4 * g_ + 3])}; } } while (0)
        KV_DB(0); KV_DB(1); KV_DB(2); KV_DB(3);
#undef KV_DB
#undef TRRDV
#undef TRRDK
    }
    __syncthreads();
}
__device__ __forceinline__ void phase_prep(const Frame& F0, int l) {
    const Frame F = relaunder(F0);
    ArgsP a = get_args();
    const int v = lnd_s(F.vcu);
    for (int u = v; u < 512; u += F.G) gla_prep_unit(F, u >> 2, u & 3, l, a);
    for (int u = v; u < 136; u += F.G) if (u >= 128) fox_cumsum(F, u - 128, l, a);
    const int gw = lnd_s(F.vcu * NWAVES + F.wave), NGW = F.G * NWAVES, lane = lnd_v(F.lane);
    for (int m = gw; m < S; m += NGW) prep_row(lane, m, l, a);
}

__device__ __forceinline__ void gla_scan(const Frame& F0) {
    const Frame F = relaunder(F0);
    ArgsP a = get_args();
    typedef float f32x2 __attribute__((ext_vector_type(2)));
    const bf16_t* KVP = WSP(bf16_t, A_KVP); const float* BL = WSP(float, A_BLAST); bf16_t* SP = WSP(bf16_t, A_SPREV);
    if (F.tid < 256)
    for (int e = lnd_s(F.vcu) * 256 + lnd_v(F.tid); e < 4 * 256 * 64; e += F.G * 256) {
        const int dp = e & 63, hc = e >> 6, h = hc >> 8;
        f32x2 st = {0.f, 0.f};
#pragma unroll 32
        for (int c = 0; c < 128; ++c) {
            const size_t o = ((size_t)c * 1024 + hc) * 128 + 2 * dp;
            const unsigned kw = *(const unsigned*)(KVP + o); const f32x2 kv = {bflo(kw), bfhi(kw)}; const f32x2 bl = *(const f32x2*)(BL + c * 512 + h * 128 + 2 * dp);
            *(unsigned*)(SP + o) = cvt_pk_bf16(st.x, st.y);
            st.x = __expf(bl.x) * (st.x + kv.x); st.y = __expf(bl.y) * (st.y + kv.y);
        }
    }
}

struct EpiMlaQ {
    static constexpr bool PERM = true, AFTER_DRAIN = true;
    bf16_t* MQ; const float* g; const float* CS;
    __device__ __forceinline__ void operator()(const f32x4 (&)[2][2][4][2], const Unit&, int, int, int, int) const {}
    __device__ __forceinline__ void fused(const f32x4 (&acc)[2][2][4][2], const Unit& u, int wr, int wc, int fr, int fq, LAS unsigned char* lds, int wid, int lane) const {
        LAS float* P = (LAS float*)lds;
#pragma unroll
        for (int ai = 0; ai < 2; ++ai)
#pragma unroll
            for (int m = 0; m < 4; ++m) { float s = 0.f;
#pragma unroll
                for (int n = 0; n < 2; ++n) { const f32x4 x = acc[ai][0][m][n]; s += (x[0] * x[0] + x[1] * x[1]) + (x[2] * x[2] + x[3] * x[3]);
                    if (wc < 2) { const f32x4 y = acc[ai][1][m][n]; s += (y[0] * y[0] + y[1] * y[1]) + (y[2] * y[2] + y[3] * y[3]); } }
                s += __shfl_xor(s, 16); s += __shfl_xor(s, 32);
                if (fq == 0) P[(ai * 128 + wr * 64 + m * 16 + fr) * 4 + wc] = s; }
        asm volatile("s_waitcnt lgkmcnt(0)" ::: "memory"); __builtin_amdgcn_s_barrier(); asm volatile("" ::: "memory");
        const int h = u.pn;
        const f32x4 g0 = *(const f32x4*)(g + 32 * wc + 8 * fq), g1 = *(const f32x4*)(g + 32 * wc + 8 * fq + 4);
        f32x4 gr1 = {0.f, 0.f, 0.f, 0.f}, gr2 = gr1;
        if (wc < 2) { gr1 = *(const f32x4*)(g + 128 + 16 * wc + 4 * fq); gr2 = *(const f32x4*)(g + 160 + 16 * wc + 4 * fq); }
#pragma unroll
        for (int ai = 0; ai < 2; ++ai)
#pragma unroll
            for (int m = 0; m < 4; ++m) { const int rl = ai * 128 + wr * 64 + m * 16 + fr; const int row = u.pm * 256 + rl;
                const f32x4 pp = *(const LAS f32x4*)(P + rl * 4);
                const float r = rsqrtf(((pp.x + pp.y) + (pp.z + pp.w)) * (1.f / 192.f) + EPS);
                bf16_t* ob = MQ + ((size_t)h * S + row) * 192;
                { const f32x4 a0 = acc[ai][0][m][0] * r * g0, a1 = acc[ai][0][m][1] * r * g1;
                  u32x4 w; w.x = cvt_pk_bf16(a0[0], a0[1]); w.y = cvt_pk_bf16(a0[2], a0[3]); w.z = cvt_pk_bf16(a1[0], a1[1]); w.w = cvt_pk_bf16(a1[2], a1[3]);
                  *(u32x4*)(ob + 32 * wc + 8 * fq) = w; }
                if (wc < 2) { const f32x4 y1 = acc[ai][1][m][0] * r * gr1, y2 = acc[ai][1][m][1] * r * gr2;
                  const f32x4 c = *(const f32x4*)(CS + (size_t)row * 64 + 16 * wc + 4 * fq), sn = *(const f32x4*)(CS + (size_t)row * 64 + 32 + 16 * wc + 4 * fq);
                  const f32x4 o1 = y1 * c - y2 * sn, o2 = y2 * c + y1 * sn;
                  u32x4 w; w.x = cvt_pk_bf16(o1[0], o1[1]); w.y = cvt_pk_bf16(o1[2], o1[3]); w.z = cvt_pk_bf16(o2[0], o2[1]); w.w = cvt_pk_bf16(o2[2], o2[3]);
                  *(u32x4*)(ob + 128 + 32 * wc + 8 * fq) = w; }
                asm volatile("" ::: "memory"); }
        asm volatile("s_waitcnt lgkmcnt(0)" ::: "memory"); __builtin_amdgcn_s_barrier(); asm volatile("" ::: "memory");
    }
};
struct EpiMlaKV {
    static constexpr bool PERM = true, AFTER_DRAIN = true;
    bf16_t* MK; bf16_t* MV; const float* g; const float* KRR; const float* KRSS;
    __device__ __forceinline__ void operator()(const f32x4 (&)[2][2][4][2], const Unit&, int, int, int, int) const {}
    __device__ __forceinline__ void fused(const f32x4 (&acc)[2][2][4][2], const Unit& u, int wr, int wc, int fr, int fq, LAS unsigned char* lds, int wid, int lane) const {
        LAS float* P = (LAS float*)lds;
#pragma unroll
        for (int ai = 0; ai < 2; ++ai)
#pragma unroll
            for (int m = 0; m < 4; ++m) { float s = 0.f;
#pragma unroll
                for (int n = 0; n < 2; ++n) { const f32x4 x = acc[ai][0][m][n]; s += (x[0] * x[0] + x[1] * x[1]) + (x[2] * x[2] + x[3] * x[3]); }
                s += __shfl_xor(s, 16); s += __shfl_xor(s, 32);
                if (fq == 0) P[(ai * 128 + wr * 64 + m * 16 + fr) * 4 + wc] = s; }
        asm volatile("s_waitcnt lgkmcnt(0)" ::: "memory"); __builtin_amdgcn_s_barrier(); asm volatile("" ::: "memory");
        const int h = u.pn;
        const f32x4 g0 = *(const f32x4*)(g + 32 * wc + 8 * fq), g1 = *(const f32x4*)(g + 32 * wc + 8 * fq + 4);
#pragma unroll
        for (int ai = 0; ai < 2; ++ai)
#pragma unroll
            for (int m = 0; m < 4; ++m) { const int rl = ai * 128 + wr * 64 + m * 16 + fr; const int row = u.pm * 256 + rl;
                const f32x4 pp = *(const LAS f32x4*)(P + rl * 4);
                const float r = rsqrtf((((pp.x + pp.y) + (pp.z + pp.w)) + KRSS[row]) * (1.f / 192.f) + EPS);
                bf16_t* kb = MK + ((size_t)h * S + row) * 192; bf16_t* vb = MV + ((size_t)h * S + row) * 128;
                { const f32x4 a0 = acc[ai][0][m][0] * r * g0, a1 = acc[ai][0][m][1] * r * g1;
                  u32x4 w; w.x = cvt_pk_bf16(a0[0], a0[1]); w.y = cvt_pk_bf16(a0[2], a0[3]); w.z = cvt_pk_bf16(a1[0], a1[1]); w.w = cvt_pk_bf16(a1[2], a1[3]);
                  *(u32x4*)(kb + 32 * wc + 8 * fq) = w; }
                { const f32x4 a0 = acc[ai][1][m][0], a1 = acc[ai][1][m][1];
                  u32x4 w; w.x = cvt_pk_bf16(a0[0], a0[1]); w.y = cvt_pk_bf16(a0[2], a0[3]); w.z = cvt_pk_bf16(a1[0], a1[1]); w.w = cvt_pk_bf16(a1[2], a1[3]);
                  *(u32x4*)(vb + 32 * wc + 8 * fq) = w; }
                { const f32x4 k4 = *(const f32x4*)(KRR + (size_t)row * 64 + 16 * wc + 4 * fq) * r;
                  typedef unsigned u32x2 __attribute__((ext_vector_type(2)));
                  u32x2 w; w.x = cvt_pk_bf16(k4[0], k4[1]); w.y = cvt_pk_bf16(k4[2], k4[3]);
                  *(u32x2*)(kb + 128 + 16 * wc + 4 * fq) = w; }
                asm volatile("" ::: "memory"); }
        asm volatile("s_waitcnt lgkmcnt(0)" ::: "memory"); __builtin_amdgcn_s_barrier(); asm volatile("" ::: "memory");
    }
};

__device__ __forceinline__ void gla_out_unit(const Frame& F, char* lds, int chunk, int l, ArgsP a) {
    using namespace att;
    typedef unsigned short bf16;
    const int w = F.wave, rb = w & 1, cp = w >> 1, row0 = chunk * 64;
    char* V_lds = lds + L_V; float* RS = (float*)(lds + L_WS);
    const bf16* PR = WSP(bf16, A_PROJ) + (size_t)row0 * NP;
    const bf16* QT = WSP(bf16, A_QT) + (size_t)row0 * 512; const bf16* KT = WSP(bf16, A_KT) + (size_t)row0 * 512;
    const float* gO = a->in[12] + l * 256;
#define PK4G(P, B_, OUT) do { unsigned a0 = cvtpk_c(P[B_+0], P[B_+1]), a1 = cvtpk_c(P[B_+2], P[B_+3]); unsigned b0 = cvtpk_c(P[B_+4], P[B_+5]), b1 = cvtpk_c(P[B_+6], P[B_+7]);        \
        auto r0 = __builtin_amdgcn_permlane32_swap(a0, b0, false, false); auto r1 = __builtin_amdgcn_permlane32_swap(a1, b1, false, false); \
        u32x4 w_ = {r0[0], r1[0], r0[1], r1[1]}; OUT = *reinterpret_cast<bf16x8*>(&w_); } while (0)
    for (int h = 0; h < 4; ++h) {
        const int tid = lnd_v(F.tid), lane = tid & 63, r32 = lane & 31, hi = lane >> 5;
        const int sr = tid >> 4, sc = (tid & 15) * 8, vst0 = v_st(sr, sc), vst1 = v_st(32 + sr, sc);
        const bf16x8 v00 = load8(PR + (size_t)sr * NP + P_GV + h * 256 + sc), v01 = load8(PR + (size_t)(32 + sr) * NP + P_GV + h * 256 + sc);
        const bf16x8 v10 = load8(PR + (size_t)sr * NP + P_GV + h * 256 + 128 + sc), v11 = load8(PR + (size_t)(32 + sr) * NP + P_GV + h * 256 + 128 + sc);
        bf16x8 qf[8];
#pragma unroll
        for (int d0 = 0; d0 < 8; ++d0) qf[d0] = load8(QT + (size_t)(rb * 32 + r32) * 512 + h * 128 + d0 * 16 + hi * 8);
        f32x16 p0 = {}, p1 = {};
        {   bf16x8 kf[8];
#pragma unroll
            for (int d0 = 0; d0 < 8; ++d0) kf[d0] = load8(KT + (size_t)r32 * 512 + h * 128 + d0 * 16 + hi * 8);
#pragma unroll
            for (int d0 = 0; d0 < 8; ++d0) p0 = __builtin_amdgcn_mfma_f32_32x32x16_bf16(kf[d0], qf[d0], p0, 0, 0, 0); }
        if (rb == 1) {
            bf16x8 kf[8];
#pragma unroll
            for (int d0 = 0; d0 < 8; ++d0) kf[d0] = load8(KT + (size_t)(32 + r32) * 512 + h * 128 + d0 * 16 + hi * 8);
#pragma unroll
            for (int d0 = 0; d0 < 8; ++d0) p1 = __builtin_amdgcn_mfma_f32_32x32x16_bf16(kf[d0], qf[d0], p1, 0, 0, 0);
        }
#pragma unroll
        for (int r = 0; r < 16; ++r) { const bool keep = ((r & 3) + 8 * (r >> 2) + 4 * hi) <= r32; if (rb == 0) { if (!keep) p0[r] = 0.f; } else { if (!keep) p1[r] = 0.f; } }
        bf16x8 pa0, pa1, pa2, pa3;
        PK4G(p0, 0, pa0); PK4G(p0, 8, pa1); PK4G(p1, 0, pa2); PK4G(p1, 8, pa3);
        *(bf16x8*)(V_lds + vst0) = v00; *(bf16x8*)(V_lds + vst1) = v01; *(bf16x8*)(V_lds + SHM_V + vst0) = v10; *(bf16x8*)(V_lds + SHM_V + vst1) = v11;
        __syncthreads();
        f32x16 o[2] = {};
#pragma unroll
        for (int cbi = 0; cbi < 2; ++cbi) {
            const int cb = 2 * cp + cbi;
            const int vb = (int)(uintptr_t)V_lds + v_rd_base(lane) + (cb >> 2) * SHM_V + (cb & 3) * 512;
#define TRRDG(dst, off) asm volatile("ds_read_b64_tr_b16 %0, %1 offset:%2" : "=&v"(dst) : "v"(vb), "i"(off) : "memory")
            s16x4 l0, l1, l2, l3, h0, h1, h2, h3;
            TRRDG(l0, 0); TRRDG(h0, 2048); TRRDG(l1, 4096); TRRDG(h1, 6144); TRRDG(l2, 8192); TRRDG(h2, 10240); TRRDG(l3, 12288); TRRDG(h3, 14336);
            asm volatile("s_waitcnt lgkmcnt(0)" ::: "memory"); SBAR();
            o[cbi] = __builtin_amdgcn_mfma_f32_32x32x16_bf16(pa0, (bf16x8){l0[0], l0[1], l0[2], l0[3], h0[0], h0[1], h0[2], h0[3]}, o[cbi], 0, 0, 0);
            o[cbi] = __builtin_amdgcn_mfma_f32_32x32x16_bf16(pa1, (bf16x8){l1[0], l1[1], l1[2], l1[3], h1[0], h1[1], h1[2], h1[3]}, o[cbi], 0, 0, 0);
            o[cbi] = __builtin_amdgcn_mfma_f32_32x32x16_bf16(pa2, (bf16x8){l2[0], l2[1], l2[2], l2[3], h2[0], h2[1], h2[2], h2[3]}, o[cbi], 0, 0, 0);
            o[cbi] = __builtin_amdgcn_mfma_f32_32x32x16_bf16(pa3, (bf16x8){l3[0], l3[1], l3[2], l3[3], h3[0], h3[1], h3[2], h3[3]}, o[cbi], 0, 0, 0);
#undef TRRDG
            const bf16* SPc = WSP(bf16, A_SPREV) + ((size_t)(chunk * 4 + h) * 256 + cb * 32 + r32) * 128 + hi * 8;
            bf16x8 sf[8];
#pragma unroll
            for (int d0 = 0; d0 < 8; ++d0) sf[d0] = load8(SPc + d0 * 16);
#pragma unroll
            for (int d0 = 0; d0 < 8; ++d0) o[cbi] = __builtin_amdgcn_mfma_f32_32x32x16_bf16(qf[d0], sf[d0], o[cbi], 0, 0, 0);
        }
        float ss[16];
#pragma unroll
        for (int r = 0; r < 16; ++r) { float s = o[0][r] * o[0][r] + o[1][r] * o[1][r];
            s += __shfl_xor(s, 1); s += __shfl_xor(s, 2); s += __shfl_xor(s, 4); s += __shfl_xor(s, 8); s += __shfl_xor(s, 16); ss[r] = s; }
        if (r32 == 0) {
#pragma unroll
            for (int r = 0; r < 16; ++r) RS[(rb * 32 + crow(r, hi)) * 4 + cp] = ss[r]; }
        __syncthreads();
        float grv[16][2];
#pragma unroll
        for (int r = 0; r < 16; ++r)
#pragma unroll
            for (int cbi = 0; cbi < 2; ++cbi) grv[r][cbi] = mk::bf2f(PR[(size_t)(rb * 32 + crow(r, hi)) * NP + P_GR + h * 256 + (2 * cp + cbi) * 32 + r32]);
        const float go0 = gO[(2 * cp) * 32 + r32], go1 = gO[(2 * cp + 1) * 32 + r32];
#pragma unroll
        for (int r = 0; r < 16; ++r) { const int rr = rb * 32 + crow(r, hi); const f32x4 t = *(const f32x4*)(RS + rr * 4);
            const float rs = rsqrtf(((t.x + t.y) + (t.z + t.w)) * (1.f / 256.f) + EPS);
#pragma unroll
            for (int cbi = 0; cbi < 2; ++cbi) { const int col = (2 * cp + cbi) * 32 + r32;
                const float gr = grv[r][cbi];
                const float v = o[cbi][r] * rs * (cbi ? go1 : go0) * (gr * fast_sigmoid(gr));
                const float vn = __shfl_xor(v, 1);
                if ((r32 & 1) == 0) *(unsigned*)(WSP(bf16, A_OB) + (size_t)(row0 + rr) * 1024 + h * 256 + col) = cvtpk(v, vn); } }
    }
    __syncthreads();
#undef PK4G
}

__device__ __forceinline__ void phase_attn(const Frame& F0, unsigned char* lds_generic, int l) {
    const Frame F = relaunder(F0);
    for (int it = lnd_s((int)blockIdx.x); it < 256; it += F.G) {
        ArgsP a = get_args();
        const int h = it & 7, idx = it >> 3, mixer = idx >> 4, x = idx & 15;
        if (mixer == 0) {
            const att::HeadRef H{WSP(bf16_t, A_MQ) + (size_t)h * S * 192, WSP(bf16_t, A_MK) + (size_t)h * S * 192, WSP(bf16_t, A_MV) + (size_t)h * S * 128, WSP(bf16_t, A_OA) + h * 128, nullptr};
            att::Seam<true> Sm;
            att::prime<true>(H, x, (char*)lds_generic, Sm);
            for (int pass = 0; pass < 2; ++pass) att::block<true>(H, pass ? 31 - x : x, 31 - x, (char*)lds_generic, Sm);
        } else {
            const att::HeadRef H{WSP(bf16_t, A_FQ) + (size_t)h * S * 128, WSP(bf16_t, A_FK) + (size_t)h * S * 128, WSP(bf16_t, A_PROJ) + P_FV + h * 128, WSP(bf16_t, A_OC) + h * 128, WSP(float, A_FCUM) + (size_t)h * S};
            att::Seam<false> Sm;
            att::prime<false>(H, x, (char*)lds_generic, Sm);
            for (int pass = 0; pass < 2; ++pass) att::block<false>(H, pass ? 31 - x : x, 31 - x, (char*)lds_generic, Sm);
        }
    }
}
__device__ __forceinline__ void phase_gla_out(const Frame& F0, unsigned char* lds_generic, int l) {
    const Frame F = relaunder(F0);
    for (int it = lnd_s((int)blockIdx.x); it < 256; it += F.G) {
        ArgsP a = get_args();
        const int h = it & 7, idx = it >> 3;
        if ((idx >> 4) == 1) gla_out_unit(F, (char*)lds_generic, h * 16 + (idx & 15), l, a);
    }
}

__global__ void __launch_bounds__(NTHREADS, 2) mk_fwd(Args args_unused) {
    extern __shared__ __attribute__((aligned(16))) unsigned char lds[];
    Frame F;
    F.lds = (LAS unsigned char*)lds; F.MISC = (volatile LAS unsigned*)(F.lds + MISC_OFF);
    F.tid = threadIdx.x; F.lane = F.tid & 63; F.wave = __builtin_amdgcn_readfirstlane(F.tid >> 6);
    F.G = gridDim.x; { const int bx = blockIdx.x; F.vcu = (F.G % 8 == 0) ? (bx % 8) * (F.G / 8) + bx / 8 : bx; }
    for (int u = F.tid; u < (LDS_BYTES - LDSCTL_OFF) / 4; u += NTHREADS) ((LAS unsigned*)(F.lds + LDSCTL_OFF))[u] = 0u;
    __syncthreads();
    XcdBarrier bar;
    { ArgsP a = get_args(); F.ctl = (gu32*)(a->ws + WS_CTL); bar = xcd_barrier_post((unsigned*)(F.ctl + CW_BAR) + a->li * XCD_BAR_WORDS, F.MISC + 8); }
    int l_lo, l_hi, lo, hi, lazy;
    { ArgsP a = get_args(); const int p0 = a->pro_lo, p1 = a->pro_hi; l_lo = a->l_lo; l_hi = a->l_hi; lo = a->ph_lo; hi = a->ph_hi; lazy = a->pad;
      if (p0 == 0 && p1 > 0) rope_tables(F);
      prologue_weights(F, p0, p1);
      if (p0 == 0 && p1 > 0 && l_lo == 0 && l_hi > 0 && lo == 0) phase_rms0(F, a->in[0], a->in[2], WSP(bf16_t, A_HN), WSP(float, A_SSPA));
      if (p1 > p0 && l_hi > l_lo) xcd_barrier(bar); }

#define IN(k) (lo <= (k) && (k) < hi)
#define SEAM(k) do { if (!(l == l_hi - 1 && (k) == hi - 1)) xcd_barrier(bar); } while (0)
#define WB(off) ((const bf16_t*)(a->ws + WS_W + (size_t)l * WSTRIDE + (off)))
    for (int l = l_lo; l < l_hi; ++l) {
        if (IN(1)) { { ArgsP a = get_args();
            pg8::Gemm g{WSP(bf16_t, A_HN), WB(LW_WIN), S, NP, DM, DM, DM}; pg8::StaticOrder So; So.init(S, NP, lnd_s(F.G), lnd_s((int)blockIdx.x));
            { const int pm0 = first_unit_pm(NP / 256, lnd_s(F.G), lnd_s((int)blockIdx.x)); if (pm0 >= 0) fill_rstd_table(F, WSP(float, A_SSPA), pm0); }
            EpiStoreBf16 E{WSP(bf16_t, A_PROJ), NP, (const LAS float*)(F.lds + RT_OFF)};
            pg8::gemm_phase<EpiStoreBf16, pg8::StaticOrder, true, true>(F.lds + RING_OFF, g, So, E); }
            if (lazy && (int)blockIdx.x >= 256 - CV_W1) convert_slice(F, l + 1, CV_B1, (int)blockIdx.x - (256 - CV_W1), CV_W1, CV_R1);
            SEAM(1);
        }
        if (IN(2)) { phase_prep(F, l); SEAM(2); }
        if (IN(3)) { {
            gla_scan(F);
            pg8::StaticOrder So; So.init(S, 2048, lnd_s(F.G), lnd_s((int)blockIdx.x));
            { ArgsP a = get_args(); pg8::Gemm g{WSP(bf16_t, A_CQN), WB(LW_WUQ), S, 2048, 512, 1024, 512};
              EpiMlaQ E{WSP(bf16_t, A_MQ), a->in[8] + l * 192, WSP(float, A_CS)};
              pg8::gemm_phase<EpiMlaQ, pg8::StaticOrder, false, true>(F.lds + RING_OFF, g, So, E); }
            { ArgsP a = get_args(); pg8::Gemm g{WSP(bf16_t, A_CQN) + 512, WB(LW_WUKV), S, 2048, 512, 1024, 512};
              EpiMlaKV E{WSP(bf16_t, A_MK), WSP(bf16_t, A_MV), a->in[9] + l * 192, WSP(float, A_KRR), WSP(float, A_KRSS)};
              pg8::gemm_phase<EpiMlaKV, pg8::StaticOrder, false, true>(F.lds + RING_OFF, g, So, E); } }
            SEAM(3);
        }
        if (IN(4)) { { phase_attn(F, lds + RING_OFF, l); phase_gla_out(F, lds + RING_OFF, l); }
            if (lazy && (int)blockIdx.x >= 256 - CV_W4) convert_slice(F, l + 1, CV_B4, (int)blockIdx.x - (256 - CV_W4), CV_W4, CV_R4);
            SEAM(4); }
        if (IN(5)) { { ArgsP a = get_args();
            BranchOrder So; So.init(lnd_s(F.G), lnd_s((int)blockIdx.x));
            pg8::Gemm g{WSP(bf16_t, A_OA), WB(LW_WBR), 3 * S, 3 * DM, 1024, 1024, 1024};
            EpiGateMergeAll E{WSP(bf16_t, A_PROJ) + P_GATES, NP, WSP(bf16_t, A_MERGED), WSP(bf16_t, A_HN), DM};
            pg8::gemm_phase<EpiGateMergeAll, BranchOrder, true, true>(F.lds + RING_OFF, g, So, E); }
            SEAM(5);
        }
        if (IN(6)) { { ArgsP a = get_args();
            pg8::Gemm g{WSP(bf16_t, A_HN), WB(LW_WOUT), S, DM, DM, DM, DM}; pg8::StaticOrder So; So.init(S, DM, lnd_s(F.G), lnd_s((int)blockIdx.x));
            EpiResidNorm E{(l == 0) ? (const void*)a->in[0] : (const void*)WSP(bf16_t, A_XR), (void*)WSP(bf16_t, A_XR), DM, WSP(bf16_t, A_HN2), WSP(float, A_SSPB), a->in[18] + l * DM, 1, (l == 0) ? 0 : 1, 1};
            pg8::gemm_phase<EpiResidNorm, pg8::StaticOrder, false, true>(F.lds + RING_OFF, g, So, E); }
            SEAM(6);
        }
        if (IN(8)) { { ArgsP a = get_args();
            pg8::Gemm g{WSP(bf16_t, A_HN2), WB(LW_WGU), S, 2 * FFH, DM, DM, DM}; pg8::StaticOrder So; So.init(S, 2 * FFH, lnd_s(F.G), lnd_s((int)blockIdx.x));
            { const int pm0 = first_unit_pm(2 * FFH / 256, lnd_s(F.G), lnd_s((int)blockIdx.x)); if (pm0 >= 0) fill_rstd_table(F, WSP(float, A_SSPB), pm0); }
            EpiSwiglu E{WSP(bf16_t, A_PROJ), FFH, (const LAS float*)(F.lds + RT_OFF)};
            pg8::gemm_phase<EpiSwiglu, pg8::StaticOrder, true, true>(F.lds + RING_OFF, g, So, E); }
            if (lazy && (int)blockIdx.x >= 256 - CV_W8) convert_slice(F, l + 1, CV_B8, (int)blockIdx.x - (256 - CV_W8), CV_W8, CV_R8);
            SEAM(8);
        }
        if (IN(9)) { { ArgsP a = get_args();
            pg8::Gemm g{WSP(bf16_t, A_PROJ), WB(LW_WDN), S, DM, FFH, FFH, FFH}; pg8::StaticOrder So; So.init(S, DM, lnd_s(F.G), lnd_s((int)blockIdx.x));
            EpiResidNorm E{(const void*)WSP(bf16_t, A_XR), (l + 1 < DEPTH) ? (void*)WSP(bf16_t, A_XR) : (void*)a->out, DM, WSP(bf16_t, A_HN), WSP(float, A_SSPA), a->in[2] + (l + 1 < DEPTH ? l + 1 : l) * DM, (l + 1 < DEPTH) ? 1 : 0, 1, (l + 1 < DEPTH) ? 1 : 0};
            pg8::gemm_phase<EpiResidNorm, pg8::StaticOrder, false, true>(F.lds + RING_OFF, g, So, E); }
            SEAM(9);
        }
    }
#undef IN
#undef SEAM
}

}

extern "C" void kernel_launch(void* const* d_in, const int* in_sizes, int n_in, void* d_out, int out_size, void* d_ws, size_t ws_size, hipStream_t stream) {
    static int grid = 0;
    if (grid == 0) {
        int dev = 0, cus = 0;
        if (n_in != 21 || out_size != S * DM || ws_size < mk::A_END) { fprintf(stderr, "kernel_launch: unexpected shapes / workspace (%d inputs, out %d, ws %zu < %zu)\n", n_in, out_size, ws_size, (size_t)mk::A_END); grid = -1; return; }
        if (hipGetDevice(&dev) != hipSuccess || hipDeviceGetAttribute(&cus, hipDeviceAttributeMultiprocessorCount, dev) != hipSuccess) { grid = -1; return; }
        if (hipFuncSetAttribute((const void*)mk::mk_fwd, hipFuncAttributeMaxDynamicSharedMemorySize, mk::LDS_BYTES) != hipSuccess) { fprintf(stderr, "hipFuncSetAttribute failed\n"); grid = -1; return; }
        int per_cu = 0;
        if (hipOccupancyMaxActiveBlocksPerMultiprocessor(&per_cu, (const void*)mk::mk_fwd, mk::NTHREADS, mk::LDS_BYTES) != hipSuccess || per_cu < 1) { fprintf(stderr, "occupancy query: %d blocks per CU\n", per_cu); (void)hipGetLastError(); }
        grid = cus;
        if (cus != 256) { fprintf(stderr, "kernel_launch: this kernel's unit deal (one 256x256 unit per workgroup in the N = 2048 GEMM phases, one row panel per workgroup in the wide ones) needs exactly 256 CUs, found %d\n", cus); grid = -1; return; }
    }
    if (grid < 0) return;
    (void)hipMemsetAsync((unsigned char*)d_ws + mk::WS_CTL, 0, mk::CTL_ZERO_BYTES, stream);
    mk::Args a{};
    for (int i = 0; i < 21; ++i) a.in[i] = (const float*)d_in[i];
    a.out = (float*)d_out; a.ws = (unsigned char*)d_ws;
    const int lazy = (grid == 256) ? 1 : 0;
    a.pro_lo = 0; a.pro_hi = lazy ? 1 : DEPTH; a.l_lo = 0; a.l_hi = DEPTH; a.ph_lo = 0; a.ph_hi = 10; a.li = 0; a.pad = lazy;
    mk::mk_fwd<<<dim3(grid), mk::NTHREADS, mk::LDS_BYTES, stream>>>(a);
}
```

```cpp
#include <hip/hip_runtime.h>
#include <cstdio>
#include <cstdint>

constexpr int S = 8192, DM = 2048, DEPTH = 4;
constexpr int D_IN = 13400, FFH = 5632;
constexpr int C_CQ = 0, C_CKV = 512, C_KR = 1024, C_GQ = 1088, C_GK = 1600, C_GV = 2112, C_GA = 3136, C_GR = 3152,
              C_FQ = 4176, C_FK = 5200, C_FV = 6224, C_FL = 7248, C_GATES = 7256;
constexpr float EPS = 1e-6f;
#define MK_WSTRIDE 149946368ull
constexpr int NP_G = 13568;


namespace pg8 {
#define PG8_LAS __attribute__((address_space(3)))
typedef unsigned short bf16_t;
typedef short bf16x8 __attribute__((ext_vector_type(8)));
typedef float f32x4 __attribute__((ext_vector_type(4)));
typedef unsigned u32x4 __attribute__((ext_vector_type(4)));
constexpr int BM = 256, BK = 64, HALF = 128, HTB = HALF * BK * 2  , STAGE_BYTES = 8 * HTB, NXCD = 8, WGM = 8;

__host__ __device__ __forceinline__ int lds_byte(int r, int c) { const int st = (r >> 4) * 2 + (c >> 5), rr = r & 15, cc = c & 31, ob = rr * 64 + cc * 2; return st * 1024 + (ob ^ (((ob >> 9) & 1) << 5)); }
__host__ __device__ __forceinline__ void stage_rc(int b, int& R, int& C) { const int st = b / 1024, sb = b % 1024, swz = sb ^ (((sb >> 9) & 1) << 5); R = (st >> 1) * 16 + swz / 64; C = (st & 1) * 32 + (swz % 64) / 2; }
__host__ __device__ __forceinline__ int perm32(int rho) { const int n = rho >> 4, i = rho & 15; return 8 * (i >> 2) + 4 * n + (i & 3); }

struct Unit { int pm, pn; };
struct Gemm { const bf16_t* A; const bf16_t* Bt; int M, N, K, lda, ldb; };

struct StaticOrder {
    int nM, nN, nwg, G, c;
    __host__ __device__ void init(int M, int N, int G_, int c_) { nM = M / BM; nN = N / BM; nwg = nM * nN; G = G_; c = c_; }
    __host__ __device__ bool next(int i, Unit& u) const {
        const long L = (long)i * G + c; if (L >= nwg) return false;
        int wgid = (int)L; { const int q = nwg / NXCD, r = nwg % NXCD, xcd = wgid % NXCD, off = wgid / NXCD; wgid = (xcd < r ? xcd * (q + 1) : r * (q + 1) + (xcd - r) * q) + off; }
        const int nig = WGM * nN, gid = wgid / nig, fm = gid * WGM, gsz = (nM - fm) < WGM ? (nM - fm) : WGM;
        u.pm = fm + ((wgid % nig) % gsz); u.pn = (wgid % nig) / gsz; return true;
    }
    __device__ __forceinline__ void a_ready(const Unit&) const {}
    __device__ __forceinline__ void done(const Unit&) const {}
};

__device__ __forceinline__ unsigned cvt_pk_bf16(float lo, float hi) { unsigned r; asm volatile("v_cvt_pk_bf16_f32 %0, %1, %2" : "=v"(r) : "v"(lo), "v"(hi)); return r; }
template <class Epi, class Sched, bool ALIGN_EPI = false, bool SP2 = false>
__device__ __forceinline__ void gemm_phase(PG8_LAS unsigned char* lds, const Gemm g, const Sched& S, const Epi& E) {
    int tid_ = threadIdx.x; asm volatile("" : "+v"(tid_));
    const int tid = tid_, wid = __builtin_amdgcn_readfirstlane(tid >> 6), lane = tid & 63, wr = wid >> 2, wc = wid & 3, fr = lane & 15, fq = lane >> 4;
    const int K = g.K, nt = K / BK;
    unsigned voffA[2], voffB[2];
#pragma unroll
    for (int i = 0; i < 2; ++i) { int R, C; stage_rc(tid * 16 + i * 8192, R, C); const int Rb = Epi::PERM ? ((R & ~31) + perm32(R & 31)) : R;
        voffA[i] = (unsigned)(R * g.lda + C) * 2u; voffB[i] = (unsigned)(Rb * g.ldb + C) * 2u; }
    const size_t kstep = (size_t)(BK * 2);
    const size_t hstepA = (size_t)HALF * g.lda * 2, hstepB = (size_t)HALF * g.ldb * 2;
    const size_t tstepA = 2 * hstepA, tstepB = 2 * hstepB;
    const unsigned ldsw = (unsigned)wid * 1024u;
    const int aoff = lds_byte(wr * 64 + fr, fq * 8), boff = lds_byte(wc * 32 + fr, fq * 8);
#define PG8_SA(b, h) (((b) * 2 + (h)) * HTB)
#define PG8_SB(b, h) ((4 + (b) * 2 + (h)) * HTB)
#define PG8_STAGE(bufoff, gbase, voff) do { _Pragma("unroll") for (int _i = 0; _i < 2; ++_i) \
        __builtin_amdgcn_global_load_lds((const unsigned*)((const char*)(gbase) + (voff)[_i]), (PG8_LAS unsigned*)(lds + (bufoff) + ldsw + _i * 8192), 16, 0, 0); } while (0)
#define PG8_LDA(dst, b, h) do { _Pragma("unroll") for (int m = 0; m < 4; ++m) _Pragma("unroll") for (int k = 0; k < 2; ++k) dst[m][k] = *(const PG8_LAS bf16x8*)(lds + PG8_SA(b, h) + aoff + m * 2048 + k * 1024); } while (0)
#define PG8_LDB(dst, b, h) do { _Pragma("unroll") for (int n = 0; n < 2; ++n) _Pragma("unroll") for (int k = 0; k < 2; ++k) dst[n][k] = *(const PG8_LAS bf16x8*)(lds + PG8_SB(b, h) + boff + n * 2048 + k * 1024); } while (0)
#define PG8_MMA(ai, bj, At, Bt) do { __builtin_amdgcn_s_setprio(1); _Pragma("unroll") for (int m = 0; m < 4; ++m) _Pragma("unroll") for (int n = 0; n < 2; ++n) _Pragma("unroll") for (int k = 0; k < 2; ++k) \
        acc[ai][bj][m][n] = __builtin_amdgcn_mfma_f32_16x16x32_bf16(Bt[n][k], At[m][k], acc[ai][bj][m][n], 0, 0, 0); __builtin_amdgcn_s_setprio(0); } while (0)
#define PG8_WAIT_V(n) asm volatile("s_waitcnt vmcnt(" #n ")" ::: "memory")
#define PG8_WAIT_L(n) asm volatile("s_waitcnt lgkmcnt(" #n ")" ::: "memory")
#define PG8_BAR __builtin_amdgcn_s_barrier()
#define PG8_SCHED __builtin_amdgcn_sched_barrier(0)
    Unit cur, nxt; int ui = 0;
    if (!S.next(0, cur)) return;
    f32x4 acc[2][2][4][2];
#pragma unroll
    for (int a = 0; a < 2; ++a)
#pragma unroll
        for (int b = 0; b < 2; ++b)
#pragma unroll
            for (int m = 0; m < 4; ++m)
#pragma unroll
                for (int n = 0; n < 2; ++n) acc[a][b][m][n] = (f32x4){0.f, 0.f, 0.f, 0.f};
    bf16x8 At[4][2], B0[2][2], B1[2][2];
    const char* cA = (const char*)g.A + (size_t)cur.pm * tstepA; const char* cB = (const char*)g.Bt + (size_t)cur.pn * tstepB;
    S.a_ready(cur);
    if constexpr (SP2) {
        PG8_STAGE(PG8_SB(0, 0), cB, voffB); PG8_STAGE(PG8_SB(0, 1), cB + hstepB, voffB); PG8_STAGE(PG8_SA(0, 0), cA, voffA); PG8_STAGE(PG8_SA(0, 1), cA + hstepA, voffA);
        if (wr == 1) PG8_BAR;
        PG8_WAIT_V(2); PG8_BAR;
        PG8_STAGE(PG8_SB(1, 0), cB + kstep, voffB); PG8_STAGE(PG8_SA(1, 0), cA + kstep, voffA); PG8_STAGE(PG8_SB(1, 1), cB + hstepB + kstep, voffB);
        PG8_WAIT_V(6); PG8_BAR;
    } else {
        PG8_STAGE(PG8_SB(0, 0), cB, voffB); PG8_STAGE(PG8_SA(0, 0), cA, voffA); PG8_STAGE(PG8_SB(0, 1), cB + hstepB, voffB); PG8_STAGE(PG8_SA(0, 1), cA + hstepA, voffA);
        if (wr == 1) PG8_BAR;
        PG8_WAIT_V(4); PG8_BAR;
        PG8_STAGE(PG8_SB(1, 0), cB + kstep, voffB); PG8_STAGE(PG8_SA(1, 0), cA + kstep, voffA); PG8_STAGE(PG8_SB(1, 1), cB + hstepB + kstep, voffB);
        PG8_WAIT_V(6); PG8_BAR;
    }
    for (;;) {
        const bool has_next = S.next(ui + 1, nxt);
        const char* nA = has_next ? (const char*)g.A + (size_t)nxt.pm * tstepA : cA; const char* nB = has_next ? (const char*)g.Bt + (size_t)nxt.pn * tstepB : cB;
        for (int t = 0; t < nt; t += 2) {
            const bool last = (t == nt - 2);
            const char* a1 = cA + (size_t)(t + 1) * kstep;
            const char* a2 = last ? nA : cA + (size_t)(t + 2) * kstep; const char* b2 = last ? nB : cB + (size_t)(t + 2) * kstep;
            const char* a3 = a2 + kstep; const char* b3 = b2 + kstep;
            if (last && has_next) S.a_ready(nxt);
            if constexpr (SP2) {
            PG8_LDB(B0, 0, 0); PG8_LDB(B1, 0, 1); PG8_SCHED; PG8_LDA(At, 0, 0); PG8_STAGE(PG8_SA(1, 1), a1 + hstepA, voffA);
            PG8_WAIT_V(8); PG8_WAIT_L(0); PG8_BAR; PG8_MMA(0, 0, At, B0); PG8_MMA(0, 1, At, B1); PG8_BAR; PG8_SCHED;
            PG8_LDA(At, 0, 1); PG8_STAGE(PG8_SB(0, 0), b2, voffB); PG8_STAGE(PG8_SB(0, 1), b2 + hstepB, voffB); PG8_STAGE(PG8_SA(0, 0), a2, voffA);
            PG8_WAIT_V(8); PG8_WAIT_L(0); PG8_BAR; PG8_MMA(1, 0, At, B0); PG8_MMA(1, 1, At, B1); PG8_BAR; PG8_SCHED;
            PG8_LDB(B0, 1, 0); PG8_LDB(B1, 1, 1); PG8_SCHED; PG8_LDA(At, 1, 0); PG8_STAGE(PG8_SA(0, 1), a2 + hstepA, voffA);
            PG8_WAIT_V(8); PG8_WAIT_L(0); PG8_BAR; PG8_MMA(0, 0, At, B0); PG8_MMA(0, 1, At, B1); PG8_BAR; PG8_SCHED;
            PG8_LDA(At, 1, 1); PG8_STAGE(PG8_SB(1, 0), b3, voffB); PG8_STAGE(PG8_SB(1, 1), b3 + hstepB, voffB); PG8_STAGE(PG8_SA(1, 0), a3, voffA);
            PG8_WAIT_V(8); PG8_WAIT_L(0); PG8_BAR; PG8_MMA(1, 0, At, B0); PG8_MMA(1, 1, At, B1); PG8_BAR; PG8_SCHED;
            } else {
            PG8_LDB(B0, 0, 0); PG8_SCHED; PG8_LDA(At, 0, 0); PG8_STAGE(PG8_SA(1, 1), a1 + hstepA, voffA);
            PG8_WAIT_L(8); PG8_BAR; PG8_WAIT_L(0); PG8_MMA(0, 0, At, B0); PG8_BAR; PG8_SCHED;
            PG8_LDB(B1, 0, 1); PG8_STAGE(PG8_SB(0, 0), b2, voffB);
            PG8_BAR; PG8_WAIT_L(0); PG8_MMA(0, 1, At, B1); PG8_BAR;
            PG8_LDA(At, 0, 1); PG8_STAGE(PG8_SA(0, 0), a2, voffA);
            PG8_BAR; PG8_WAIT_L(0); PG8_MMA(1, 0, At, B0); PG8_BAR; PG8_SCHED;
            PG8_STAGE(PG8_SB(0, 1), b2 + hstepB, voffB);
            PG8_WAIT_V(6); PG8_BAR; PG8_MMA(1, 1, At, B1); PG8_BAR;
            PG8_LDB(B0, 1, 0); PG8_SCHED; PG8_LDA(At, 1, 0); PG8_STAGE(PG8_SA(0, 1), a2 + hstepA, voffA);
            PG8_WAIT_L(8); PG8_BAR; PG8_WAIT_L(0); PG8_MMA(0, 0, At, B0); PG8_BAR; PG8_SCHED;
            PG8_LDB(B1, 1, 1); PG8_STAGE(PG8_SB(1, 0), b3, voffB);
            PG8_BAR; PG8_WAIT_L(0); PG8_MMA(0, 1, At, B1); PG8_BAR;
            PG8_LDA(At, 1, 1); PG8_STAGE(PG8_SA(1, 0), a3, voffA);
            PG8_BAR; PG8_WAIT_L(0); PG8_MMA(1, 0, At, B0); PG8_BAR; PG8_SCHED;
            PG8_STAGE(PG8_SB(1, 1), b3 + hstepB, voffB);
            PG8_WAIT_V(6); PG8_BAR; PG8_MMA(1, 1, At, B1); PG8_BAR;
            }
        }
        if constexpr (ALIGN_EPI) { if (wr == 0) PG8_BAR; }
        if constexpr (!Epi::AFTER_DRAIN) { E(acc, cur, wr, wc, fr, fq); S.done(cur); }
        if (!has_next) break;
#pragma unroll
        for (int a = 0; a < 2; ++a)
#pragma unroll
            for (int b = 0; b < 2; ++b)
#pragma unroll
                for (int m = 0; m < 4; ++m)
#pragma unroll
                    for (int n = 0; n < 2; ++n) acc[a][b][m][n] = (f32x4){0.f, 0.f, 0.f, 0.f};
        cur = nxt; cA = nA; cB = nB; ++ui;
        if constexpr (ALIGN_EPI) { if (wr == 1) PG8_BAR; }
    }
    PG8_WAIT_V(0);
    if constexpr (!ALIGN_EPI) { if (wr == 0) PG8_BAR; }
    PG8_BAR;
    if constexpr (Epi::AFTER_DRAIN) { E.fused(acc, cur, wr, wc, fr, fq, lds, wid, lane); S.done(cur); }
#undef PG8_SA
#undef PG8_SB
#undef PG8_STAGE
#undef PG8_LDA
#undef PG8_LDB
#undef PG8_MMA
#undef PG8_WAIT_V
#undef PG8_WAIT_L
#undef PG8_BAR
#undef PG8_SCHED
}
}

#define GAS __attribute__((address_space(1)))
#define LAS __attribute__((address_space(3)))
#define XB_TMO      128
#define XB_XCNT(j)  (256  + 64 * (j))
#define XB_XSUB(j)  (1280 + 64 * (j))
#define XB_XGEN(j)  (2304 + 64 * (j))
#define XB_TOP      3328
#define XB_TOPGEN   3392
#define XCD_BAR_WORDS 3456
#define XB_SPIN_CAP (1u << 18)

__device__ __forceinline__ unsigned xb_ld(unsigned* p)              { return __hip_atomic_load(p, __ATOMIC_RELAXED, __HIP_MEMORY_SCOPE_AGENT); }
__device__ __forceinline__ unsigned xb_add(unsigned* p, unsigned v) { return __hip_atomic_fetch_add(p, v, __ATOMIC_RELAXED, __HIP_MEMORY_SCOPE_AGENT); }
__device__ __forceinline__ unsigned xb_xcc_id() { return (unsigned)__builtin_amdgcn_s_getreg((3 << 11) | 20) & 0xFu; }
#define XB_SPIN(cond, bar) do { unsigned _sp = 0; while (cond) { __builtin_amdgcn_s_sleep(1); \
    if ((++_sp & 255u) == 0u) { if (xb_ld(&(bar)[XB_TMO])) break; if (_sp > XB_SPIN_CAP) { atomicAdd(&(bar)[XB_TMO], 1u); break; } } } } while (0)

struct XcdBarrier {
    unsigned* bar; unsigned x;
    volatile LAS unsigned* st;
};

__device__ __forceinline__ XcdBarrier xcd_barrier_post(unsigned* bar, volatile LAS unsigned* st) {
    XcdBarrier b; b.bar = bar; b.x = xb_xcc_id(); b.st = st;
    if (threadIdx.x == 0) (void)xb_add(&bar[XB_XCNT(b.x)], 1u);
    return b;
}
__device__ __forceinline__ void xcd_barrier_complete(unsigned* bar, unsigned x, unsigned& nloc, unsigned& nx) {
    const unsigned G = gridDim.x * gridDim.y * gridDim.z;
    unsigned sum, cnt, mine, sp = 0u;
    for (;;) {
        sum = 0u; cnt = 0u; mine = 0u;
#pragma unroll
        for (unsigned j = 0; j < 16; ++j) { const unsigned c = xb_ld(&bar[XB_XCNT(j)]); sum += c; cnt += (c > 0u) ? 1u : 0u; mine = (j == x) ? c : mine; }
        if (sum == G) break;
        __builtin_amdgcn_s_sleep(1);
        if ((++sp & 255u) == 0u) { if (xb_ld(&bar[XB_TMO])) break; if (sp > XB_SPIN_CAP) { atomicAdd(&bar[XB_TMO], 1u); break; } }
    }
    nloc = mine > 0u ? mine : 1u; nx = cnt > 0u ? cnt : 1u;
}

__device__ __forceinline__ void xcd_barrier(const XcdBarrier& b) {
    asm volatile("s_waitcnt vmcnt(0)" ::: "memory");
    __syncthreads();
    if (threadIdx.x == 0) {
        unsigned* bar = b.bar;
        __builtin_amdgcn_s_waitcnt(0);
        unsigned nloc = b.st[0], nx = b.st[1];
        if (nloc == 0u) { xcd_barrier_complete(bar, b.x, nloc, nx); b.st[0] = nloc; b.st[1] = nx; }
        const unsigned old = xb_add(&bar[XB_XSUB(b.x)], 1u);
        const unsigned gen = old / nloc;
        if (old + 1u == (gen + 1u) * nloc) {
            __builtin_amdgcn_fence(__ATOMIC_RELEASE, "agent");
            asm volatile("s_waitcnt vmcnt(0)" ::: "memory");
            const unsigned og = xb_add(&bar[XB_TOP], 1u);
            const unsigned tg = og / nx;
            if (og + 1u == (tg + 1u) * nx) xb_add(&bar[XB_TOPGEN], 1u);
            else XB_SPIN(xb_ld(&bar[XB_TOPGEN]) == tg, bar);
            __builtin_amdgcn_fence(__ATOMIC_ACQUIRE, "agent");
            xb_add(&bar[XB_XGEN(b.x)], 1u);
            asm volatile("s_waitcnt vmcnt(0)" ::: "memory");
        } else {
            XB_SPIN(xb_ld(&bar[XB_XGEN(b.x)]) == gen, bar);
            __builtin_amdgcn_fence(__ATOMIC_ACQUIRE, "agent");
            asm volatile("s_waitcnt vmcnt(0)" ::: "memory");
        }
    }
    __syncthreads();
}

namespace att {
__device__ __forceinline__ int mk_lnd_v(int v) { asm volatile("" : "+v"(v)); return v; }
typedef short bf16x8 __attribute__((ext_vector_type(8)));
typedef short s16x4 __attribute__((ext_vector_type(4)));
typedef float f32x16 __attribute__((ext_vector_type(16)));
typedef float f32x4 __attribute__((ext_vector_type(4)));
typedef unsigned u32x4 __attribute__((ext_vector_type(4)));
typedef unsigned short bf16;
constexpr int NW = 8, QBLK = 32, KVBLK = 64, QB = NW * QBLK;
constexpr int SHM_V = KVBLK * 128 * 2, SHM_K = 16 * 1152, SHM_KR = 8 * 1152;
constexpr int L_V = 0, L_K = 2 * SHM_V, L_KR = L_K + 2 * SHM_K, L_WS = L_KR + 2 * SHM_KR, L_X = L_WS + NW * 64 * 4;
constexpr int L_FB = L_X + 32768, L_END = L_X + 65536;
static_assert(L_END <= 163840 - 512, "attention LDS");
constexpr float THR = 8.f;
#define KLAY(row, chunk) ((chunk) * 1152 + (((chunk) & 7) + (row)) * 16)
#define SBAR() __builtin_amdgcn_sched_barrier(0)
__device__ __forceinline__ int v_st(int k, int c) { const int kk = (k & ~0xC) | ((k & 4) << 1) | ((k & 8) >> 1); return ((kk >> 3) * 4 + (c >> 5)) * 512 + ((kk & 7) * 32 + (c & 31)) * 2; }
__device__ __forceinline__ int v_rd_base(int lane) { return ((lane & 3) << 3) | (((lane >> 2) & 3) << 6) | (((lane >> 4) & 1) << 5) | (((lane >> 5) & 1) << 8); }
constexpr int v_rd_off(int d0, int ks, int half) { return d0 * 512 + ks * 4096 + half * 2048; }
__device__ __forceinline__ int crow(int r, int hi) { return (r & 3) + 8 * (r >> 2) + 4 * hi; }
__device__ __forceinline__ unsigned cvtpk(float lo, float hi) { unsigned r; asm volatile("v_cvt_pk_bf16_f32 %0, %1, %2" : "=v"(r) : "v"(lo), "v"(hi)); return r; }
__device__ __forceinline__ bf16x8 load8(const bf16* p) { return *reinterpret_cast<const bf16x8*>(p); }
typedef float f32x2c_t __attribute__((ext_vector_type(2))); typedef __bf16 bf16x2c_t __attribute__((ext_vector_type(2)));
__device__ __forceinline__ unsigned cvtpk_c(float lo, float hi) { f32x2c_t v = {lo, hi}; bf16x2c_t b = __builtin_convertvector(v, bf16x2c_t); return __builtin_bit_cast(unsigned, b); }

__device__ __forceinline__ void mask_tile(f32x16& p0, f32x16& p1, int dq) {
    const float NEG = -__builtin_inff();
#pragma unroll
    for (int r = 0; r < 16; ++r) {
        const int c = (r & 3) + 8 * (r >> 2);
        if (dq - c < 0) p0[r] = NEG;
        if (dq - c - 32 < 0) p1[r] = NEG;
    }
}
template <bool MLA>
__device__ __forceinline__ void partialSM(f32x16& p0, f32x16& p1, float& m_reg, float& mn, float& alpha) {
    constexpr float SCALE = MLA ? 0.07216878364870322f : 0.08838834764831845f;
    float pmax = p0[0];
#pragma unroll
    for (int r = 1; r < 16; ++r) pmax = fmaxf(pmax, p0[r]);
#pragma unroll
    for (int r = 0; r < 16; ++r) pmax = fmaxf(pmax, p1[r]);
    { auto rr = __builtin_amdgcn_permlane32_swap(__float_as_uint(pmax), __float_as_uint(pmax), false, false);
      pmax = fmaxf(__uint_as_float(rr[0]), __uint_as_float(rr[1])); }
    constexpr float C2 = 1.4426950408889634f * SCALE;
    if (__builtin_expect(__all((pmax - m_reg) * SCALE <= THR), 1)) { mn = m_reg; alpha = 1.f; }
    else { mn = fmaxf(m_reg, pmax); alpha = __builtin_amdgcn_exp2f((m_reg - mn) * C2); m_reg = mn; }
    const float mnL = -mn * C2;
#pragma unroll
    for (int r = 0; r < 16; ++r) p0[r] = fmaf(p0[r], C2, mnL);
#pragma unroll
    for (int r = 0; r < 16; ++r) p1[r] = fmaf(p1[r], C2, mnL);
#pragma unroll
    for (int r = 0; r < 16; ++r) p0[r] = __builtin_amdgcn_exp2f(p0[r]);
}
#define PK4(P, B_, OUT) do { unsigned a0 = cvtpk(P[B_+0], P[B_+1]), a1 = cvtpk(P[B_+2], P[B_+3]);                          \
        unsigned b0 = cvtpk(P[B_+4], P[B_+5]), b1 = cvtpk(P[B_+6], P[B_+7]);                                             \
        auto r0 = __builtin_amdgcn_permlane32_swap(a0, b0, false, false); auto r1 = __builtin_amdgcn_permlane32_swap(a1, b1, false, false); \
        u32x4 w = {r0[0], r1[0], r0[1], r1[1]}; OUT = *reinterpret_cast<bf16x8*>(&w); } while (0)
__device__ __forceinline__ void finishSM(f32x16& p0, f32x16& p1, float alpha, float& l_reg, bf16x8& pa0, bf16x8& pa1, bf16x8& pa2, bf16x8& pa3) {
#pragma unroll
    for (int r = 0; r < 16; ++r) p1[r] = __builtin_amdgcn_exp2f(p1[r]);
    float ps = 0;
#pragma unroll
    for (int r = 0; r < 16; ++r) ps += p0[r];
#pragma unroll
    for (int r = 0; r < 16; ++r) ps += p1[r];
    { auto rr = __builtin_amdgcn_permlane32_swap(__float_as_uint(ps), __float_as_uint(ps), false, false);
      ps = __uint_as_float(rr[0]) + __uint_as_float(rr[1]); }
    l_reg = l_reg * alpha + ps;
    PK4(p0, 0, pa0); PK4(p0, 8, pa1); PK4(p1, 0, pa2); PK4(p1, 8, pa3);
}
template <int KB, bool MLA, bool BIAS>
__device__ __forceinline__ void qkt(f32x16& p0, f32x16& p1, const char* lds, int r32, int hi, const bf16x8* qr, int krb, int qrb, int fbb) {
    if constexpr (BIAS) {
        const char* fbp = lds + L_FB + fbb;
#pragma unroll
        for (int g_ = 0; g_ < 4; ++g_) { const f32x4 b0_ = *(const f32x4*)(fbp + g_ * 32), b1_ = *(const f32x4*)(fbp + 128 + g_ * 32);
#pragma unroll
            for (int e_ = 0; e_ < 4; ++e_) { p0[4 * g_ + e_] = b0_[e_]; p1[4 * g_ + e_] = b1_[e_]; } }
    } else { p0 = f32x16{}; p1 = f32x16{}; }
    const char* K_lds = lds + L_K;
    const char* kbase = K_lds + KB * SHM_K + r32 * 16 + hi * 1168;
    constexpr int NQR = MLA ? 12 : 8;
    const char* qq = lds + L_X + qrb;
#pragma unroll
    for (int d0 = 0; d0 < 8; ++d0) {
        bf16x8 b0 = *reinterpret_cast<const bf16x8*>(kbase + KLAY(0, 2 * d0));
        bf16x8 b1 = *reinterpret_cast<const bf16x8*>(kbase + KLAY(32, 2 * d0));
        bf16x8 q; if (d0 < NQR) q = qr[d0]; else q = *reinterpret_cast<const bf16x8*>(qq + (d0 - NQR) * 1024);
        p0 = __builtin_amdgcn_mfma_f32_32x32x16_bf16(b0, q, p0, 0, 0, 0);
        p1 = __builtin_amdgcn_mfma_f32_32x32x16_bf16(b1, q, p1, 0, 0, 0); }
    if constexpr (MLA) {
        const char* kr = lds + L_KR + KB * SHM_KR + krb;
#pragma unroll
        for (int dr = 0; dr < 4; ++dr) {
            bf16x8 b0 = *reinterpret_cast<const bf16x8*>(kr + KLAY(0, 2 * dr));
            bf16x8 b1 = *reinterpret_cast<const bf16x8*>(kr + KLAY(32, 2 * dr));
            bf16x8 q; if (8 + dr < NQR) q = qr[8 + dr]; else q = *reinterpret_cast<const bf16x8*>(qq + (8 + dr - NQR) * 1024);
            p0 = __builtin_amdgcn_mfma_f32_32x32x16_bf16(b0, q, p0, 0, 0, 0);
            p1 = __builtin_amdgcn_mfma_f32_32x32x16_bf16(b1, q, p1, 0, 0, 0); }
    }
}
template <int VB>
__device__ __forceinline__ void pv_tile(f32x16* o, int vb0, bf16x8 pa0, bf16x8 pa1, bf16x8 pa2, bf16x8 pa3) {
#define TRRD(dst, off) asm volatile("ds_read_b64_tr_b16 %0, %1 offset:%2" : "=&v"(dst) : "v"(vb0), "i"(off) : "memory")
#define PV_D0(d0) do { s16x4 l0, l1, l2, l3, h0, h1, h2, h3; constexpr int b_ = VB * SHM_V + v_rd_off(d0, 0, 0);   \
        TRRD(l0, b_); TRRD(h0, b_ + 2048); TRRD(l1, b_ + 4096); TRRD(h1, b_ + 6144); TRRD(l2, b_ + 8192); TRRD(h2, b_ + 10240); TRRD(l3, b_ + 12288); TRRD(h3, b_ + 14336); \
        asm volatile("s_waitcnt lgkmcnt(0)" ::: "memory"); SBAR();   \
        o[d0] = __builtin_amdgcn_mfma_f32_32x32x16_bf16(pa0, (bf16x8){l0[0], l0[1], l0[2], l0[3], h0[0], h0[1], h0[2], h0[3]}, o[d0], 0, 0, 0);   \
        o[d0] = __builtin_amdgcn_mfma_f32_32x32x16_bf16(pa1, (bf16x8){l1[0], l1[1], l1[2], l1[3], h1[0], h1[1], h1[2], h1[3]}, o[d0], 0, 0, 0);   \
        o[d0] = __builtin_amdgcn_mfma_f32_32x32x16_bf16(pa2, (bf16x8){l2[0], l2[1], l2[2], l2[3], h2[0], h2[1], h2[2], h2[3]}, o[d0], 0, 0, 0);   \
        o[d0] = __builtin_amdgcn_mfma_f32_32x32x16_bf16(pa3, (bf16x8){l3[0], l3[1], l3[2], l3[3], h3[0], h3[1], h3[2], h3[3]}, o[d0], 0, 0, 0); } while (0)
    PV_D0(0); PV_D0(1); PV_D0(2); PV_D0(3);
#undef PV_D0
#undef TRRD
}

struct HeadRef { const bf16* Q; const bf16* K; const bf16* V; bf16* O; const float* FS; };
template <bool MLA> struct Seam { bf16x8 qr[MLA ? 12 : 8]; bf16x8 st_v0, st_v1, st_k0, st_k1; bf16x8 st_kr; bf16x8 ql[1]; };
template <bool MLA> struct Geo {
    static constexpr int QP = MLA ? 192 : 128, KP = MLA ? 192 : 128, VP = MLA ? 128 : NP_G, OP = 1024;
};
#define VMW() asm volatile("s_waitcnt vmcnt(0)" ::: "memory")
#define VMWN(n) asm volatile("s_waitcnt vmcnt(%0)" :: "i"(n) : "memory")
#define SLOAD_H(Kp, Vp, k0) do { S.st_v0 = load8((Vp) + (size_t)((k0) + sr) * G::VP + sc); S.st_v1 = load8((Vp) + (size_t)((k0) + 32 + sr) * G::VP + sc);              \
                         S.st_k0 = load8((Kp) + (size_t)((k0) + sr) * G::KP + sc); S.st_k1 = load8((Kp) + (size_t)((k0) + 32 + sr) * G::KP + sc);              \
                         if constexpr (MLA) S.st_kr = load8((Kp) + (size_t)((k0) + (tid >> 3)) * G::KP + 128 + (tid & 7) * 8); } while (0)
#define SWRITE_HK(bf) do { *(bf16x8*)(K_lds + (bf) * SHM_K + kws) = S.st_k0; *(bf16x8*)(K_lds + (bf) * SHM_K + kws1) = S.st_k1;  \
                           if constexpr (MLA) *(bf16x8*)(lds + L_KR + (bf) * SHM_KR + krw) = S.st_kr; } while (0)
#define SWRITE_HV(bf) do { *(bf16x8*)(V_lds + (bf) * SHM_V + vst0) = S.st_v0; *(bf16x8*)(V_lds + (bf) * SHM_V + vst1) = S.st_v1; } while (0)
#define SWRITE_H(bf) do { SWRITE_HV(bf); SWRITE_HK(bf); } while (0)
#define QLOAD_R(ref) do { _Pragma("unroll") for (int d0 = 0; d0 < NQR; ++d0) S.qr[d0] = load8((ref) + (size_t)(wid * QBLK + r32) * G::QP + d0 * 16 + hi * 8); } while (0)
#define QLOAD_L(ref) do { _Pragma("unroll") for (int dr = 0; dr < NQLDS; ++dr) S.ql[dr] = load8((ref) + (size_t)(wid * QBLK + r32) * G::QP + NQR * 16 + dr * 16 + hi * 8); } while (0)
#define QROPE_TO_LDS() do { _Pragma("unroll") for (int dr = 0; dr < NQLDS; ++dr) *(bf16x8*)(lds + L_X + qrb + dr * 1024) = S.ql[dr]; } while (0)

template <bool MLA>
__device__ __forceinline__ void prime(const HeadRef& H, int qb_cur, char* lds, Seam<MLA>& S) {
    typedef Geo<MLA> G;
    const int tid = mk_lnd_v(threadIdx.x), wid = __builtin_amdgcn_readfirstlane(tid >> 6), lane = tid & 63, r32 = lane & 31, hi = lane >> 5;
    const int sr = tid >> 4, sc = (tid & 15) * 8, kws = KLAY(sr, tid & 15), kws1 = KLAY(32 + sr, tid & 15); char* K_lds = lds + L_K;
    constexpr int NQLDS = 0, NQR = MLA ? 12 : 8;
    const int krw = KLAY(tid >> 3, tid & 7), qrb = wid * (NQLDS * 1024) + lane * 16;
    const bf16* Qc = H.Q + (size_t)qb_cur * QB * G::QP;
    QLOAD_R(Qc); QLOAD_L(Qc);
    SLOAD_H(H.K, H.V, 0); VMW(); SWRITE_HK(0); QROPE_TO_LDS();
    __syncthreads();
}
template <bool MLA>
__device__ __forceinline__ void block(const HeadRef& H, int qb_cur, int qb_nxt, char* lds, Seam<MLA>& S) {
    typedef Geo<MLA> G;
    constexpr bool BIAS = !MLA; constexpr int NQLDS = 0, NQR = MLA ? 12 : 8;
    const int tid = mk_lnd_v(threadIdx.x), wid = __builtin_amdgcn_readfirstlane(tid >> 6), lane = tid & 63, r32 = lane & 31, hi = lane >> 5;
    const int P0 = qb_cur * QB;
    const int NT = (P0 + QB - 1) / KVBLK + 1;
    const int qlo = P0 + wid * QBLK, qm = qlo + r32 - 4 * hi;
    char* V_lds = lds + L_V; char* K_lds = lds + L_K;
    float* ws = (float*)(lds + L_WS) + wid * 64; float* li_l = ws, * al_l = ws + 32;
    float m_reg = -1e30f, l_reg = 0; f32x16 o[4] = {};
    const int sr = tid >> 4, sc = (tid & 15) * 8, vst0 = v_st(sr, sc), vst1 = v_st(32 + sr, sc), kws = KLAY(sr, tid & 15), kws1 = KLAY(32 + sr, tid & 15);
    const int krw = KLAY(tid >> 3, tid & 7), qrb = wid * (NQLDS * 1024) + lane * 16, krb = r32 * 16 + hi * 1168, fbh = hi * 16;
    const int vb0 = (int)(uintptr_t)V_lds + v_rd_base(lane);
    const bf16* Kh = H.K; const bf16* Vh = H.V;
    if constexpr (BIAS) {
        const int nk4 = (P0 + QB) / 4;
        for (int i = tid; i < nk4; i += NW * 64) *(f32x4*)(lds + L_FB + i * 16) = -*(const f32x4*)(H.FS + i * 4);
        __syncthreads();
    }
#define RESC(a) do { if (__any((a) < 1.f)) { if (hi == 0) al_l[r32] = (a); asm volatile("s_waitcnt lgkmcnt(0)" ::: "memory");              \
                     for (int d_ = 0; d_ < 4; ++d_) for (int r = 0; r < 16; ++r) o[d_][r] *= al_l[crow(r, hi)]; } } while (0)
#define KBASE(t) ((t) * KVBLK)
#define MASKT(P0_, P1_, t) do { const int kb_ = KBASE(t); if (kb_ + KVBLK - 1 > qlo) mask_tile(P0_, P1_, qm - kb_); } while (0)
    f32x16 pA0, pA1, pB0, pB1; float mnA, mnB, alA, alB; bf16x8 pa0, pa1, pa2, pa3;
    SWRITE_HV(0); SBAR();
    if (NT > 1) { SLOAD_H(Kh, Vh, KBASE(1)); }
    SBAR(); qkt<0, MLA, BIAS>(pA0, pA1, lds, r32, hi, S.qr, krb, qrb, fbh + KBASE(0) * 4);
    MASKT(pA0, pA1, 0); partialSM<MLA>(pA0, pA1, m_reg, mnA, alA);
    if (NT > 1) { VMW(); SWRITE_H(1); }
    __syncthreads();
#define HALF_STEP(PX0, PX1, mnX, alX, PY0, PY1, alY, t, KB, VB, SB) do {                                                      \
        SBAR(); qkt<KB, MLA, BIAS>(PX0, PX1, lds, r32, hi, S.qr, krb, qrb, fbh + KBASE(t) * 4);                                                         \
        finishSM(PY0, PY1, alY, l_reg, pa0, pa1, pa2, pa3); SBAR();                                                           \
        if ((t) + 1 < NT) { SLOAD_H(Kh, Vh, KBASE((t) + 1)); SBAR(); }                                                        \
        pv_tile<VB>(o, vb0, pa0, pa1, pa2, pa3); MASKT(PX0, PX1, (t)); partialSM<MLA>(PX0, PX1, m_reg, mnX, alX);             \
        __syncthreads();                                                                                                      \
        if ((t) + 1 < NT) { VMW(); SWRITE_H(SB); }                                                                            \
        RESC(alX); __syncthreads(); } while (0)
    for (int t = 1; t + 1 < NT; t += 2) {
        HALF_STEP(pB0, pB1, mnB, alB, pA0, pA1, alA, t, 1, 0, 0);
        HALF_STEP(pA0, pA1, mnA, alA, pB0, pB1, alB, t + 1, 0, 1, 1);
    }
    const bool even = (NT & 1) == 0;
    if (even) { SBAR(); qkt<1, MLA, BIAS>(pB0, pB1, lds, r32, hi, S.qr, krb, qrb, fbh + KBASE(NT - 1) * 4); SBAR(); }
    finishSM(pA0, pA1, alA, l_reg, pa0, pa1, pa2, pa3); SBAR();
    pv_tile<0>(o, vb0, pa0, pa1, pa2, pa3);
    if (even) { MASKT(pB0, pB1, NT - 1); partialSM<MLA>(pB0, pB1, m_reg, mnB, alB); __syncthreads(); RESC(alB);
        finishSM(pB0, pB1, alB, l_reg, pa0, pa1, pa2, pa3); SBAR(); pv_tile<1>(o, vb0, pa0, pa1, pa2, pa3); }
    SBAR();
    const bf16* Qn = H.Q + (size_t)qb_nxt * QB * G::QP;
    SLOAD_H(Kh, Vh, 0); QLOAD_R(Qn); SBAR();
    if (hi == 0) li_l[r32] = l_reg; asm volatile("s_waitcnt lgkmcnt(0)" ::: "memory");
    float rli[16];
#pragma unroll
    for (int r = 0; r < 16; ++r) rli[r] = __builtin_amdgcn_rcpf(li_l[crow(r, hi)]);
    bf16* Ow = H.O + (size_t)(P0 + wid * QBLK) * G::OP;
#pragma unroll
    for (int r = 0; r < 16; ++r) { const int orow = crow(r, hi);
#pragma unroll
        for (int d0 = 0; d0 < 4; ++d0) { const float v = o[d0][r] * rli[r];
            const float vn = __shfl_xor(v, 1);
            if ((r32 & 1) == 0) *(unsigned*)(Ow + (size_t)orow * G::OP + d0 * 32 + r32) = cvtpk(v, vn); } }
    SBAR(); QLOAD_L(Qn); VMW(); SWRITE_HK(0); QROPE_TO_LDS();
    __syncthreads();
#undef RESC
#undef KBASE
#undef MASKT
#undef HALF_STEP
}
#undef VMW
#undef VMWN
#undef SLOAD_H
#undef SWRITE_HK
#undef SWRITE_HV
#undef SWRITE_H
#undef QLOAD_R
#undef QLOAD_L
#undef QROPE_TO_LDS
#undef PK4
}


namespace mk {
using pg8::bf16_t; using pg8::f32x4; using pg8::u32x4; using pg8::bf16x8; using pg8::Unit; using pg8::cvt_pk_bf16;
typedef GAS unsigned gu32;
#define RLX_AGENT __ATOMIC_RELAXED, __HIP_MEMORY_SCOPE_AGENT
constexpr int NWAVES = 8, NTHREADS = 512;
constexpr int NP = NP_G;
constexpr int P_CQ = 0, P_CKV = 512, P_GQ = 1024, P_GK = 1536, P_GV = 2048, P_GR = 3072, P_FQ = 4096, P_FK = 5120, P_FV = 6144, P_GATES = 7168, P_KR = 13312, P_GA = 13376, P_FL = 13392;
__host__ __device__ __forceinline__ int map_in(int n) {
    if (n < 1024) return n;
    if (n < 1088) return P_KR + (n - 1024);
    if (n < 3136) return n - 1088 + 1024;
    if (n < 3152) return P_GA + (n - 3136);
    if (n < 7248) return n - 3152 + 3072;
    if (n < 7256) return P_FL + (n - 7248);
    return n - 7256 + P_GATES;
}
__host__ __device__ __forceinline__ int rope_pos(int i) { const int half = i >> 5, jj = i & 31; return 32 * (jj >> 4) + 8 * ((jj >> 2) & 3) + 4 * half + (jj & 3); }
__host__ __device__ __forceinline__ int map_uq(int n) { const int h = n / 192, j = n % 192; return h * 256 + (j < 128 ? j : 128 + rope_pos(j - 128)); }
__host__ __device__ __forceinline__ int map_gu(int n) { const int up = n >= FFH, j = up ? n - FFH : n; return (j >> 7) * 256 + up * 128 + (j & 127); }
__host__ __device__ __forceinline__ int map_id(int n) { return n; }

constexpr size_t MiB = 1u << 20;
constexpr size_t WS_CTL = 0, CTL_ZERO_BYTES = 64 * 1024;
constexpr size_t LW_WIN = 0, LW_WUQ = 53 * MiB, LW_WUKV = 55 * MiB, LW_WBR = 57 * MiB, LW_WOUT = 69 * MiB, LW_WGU = 77 * MiB, LW_WDN = 121 * MiB, LW_BYTES = 143 * MiB;
static_assert((size_t)NP * DM * 2 == 53 * MiB && (size_t)2 * FFH * DM * 2 == 44 * MiB && (size_t)DM * FFH * 2 == 22 * MiB, "weight sizes");
constexpr size_t WS_W = 1 * MiB;
constexpr int CW_TMO = 0, CW_CODE = 1, CW_BAR = 4096, CW_QUEUE = 65536;

constexpr int RING_OFF = 0, LDS_BYTES = 163840, LDSCTL_OFF = LDS_BYTES - 512, MISC_OFF = LDSCTL_OFF + 320;

__device__ __forceinline__ float wave_sum(float v) {
#pragma unroll
    for (int o = 1; o < 64; o <<= 1) v += __shfl_xor(v, o);
    return v;
}
__device__ __forceinline__ unsigned f2bf(float f) { unsigned u = __builtin_bit_cast(unsigned, f); return (u + 0x7fffu + ((u >> 16) & 1u)) >> 16; }
__device__ __forceinline__ unsigned pk2(float lo, float hi) { return f2bf(lo) | (f2bf(hi) << 16); }
__device__ __forceinline__ float bf2f(unsigned short b) { return __builtin_bit_cast(float, (unsigned)b << 16); }
__device__ __forceinline__ float bflo(unsigned w) { return __builtin_bit_cast(float, w << 16); }
__device__ __forceinline__ float bfhi(unsigned w) { return __builtin_bit_cast(float, w & 0xffff0000u); }
__device__ __forceinline__ float fast_sigmoid(float x) { return __builtin_amdgcn_rcpf(1.f + __builtin_amdgcn_exp2f(-1.4426950408889634f * x)); }

struct EpiStoreBf16 {
    static constexpr bool PERM = true, AFTER_DRAIN = false;
    bf16_t* O; int ldc; const LAS float* RT;
    __device__ __forceinline__ void operator()(const f32x4 (&acc)[2][2][4][2], const Unit& u, int wr, int wc, int fr, int fq) const {
        const int row0 = u.pm * 256 + wr * 64 + fr, col0 = u.pn * 256 + wc * 32 + 8 * fq;
#pragma unroll
        for (int ai = 0; ai < 2; ++ai)
#pragma unroll
            for (int m = 0; m < 4; ++m) { const int row = row0 + ai * 128 + m * 16; bf16_t* rowp = O + (size_t)row * ldc + col0;
                const float r = RT[wr * 64 + fr + ai * 128 + m * 16];
#pragma unroll
                for (int bj = 0; bj < 2; ++bj) { const f32x4 v0 = acc[ai][bj][m][0] * r, v1 = acc[ai][bj][m][1] * r;
                    u32x4 w; w.x = cvt_pk_bf16(v0[0], v0[1]); w.y = cvt_pk_bf16(v0[2], v0[3]); w.z = cvt_pk_bf16(v1[0], v1[1]); w.w = cvt_pk_bf16(v1[2], v1[3]);
                    *(u32x4*)(rowp + bj * 128) = w; } }
    }
};
struct EpiSwiglu {
    static constexpr bool PERM = true, AFTER_DRAIN = false;
    bf16_t* O; int ldc; const LAS float* RT;
    __device__ __forceinline__ void operator()(const f32x4 (&acc)[2][2][4][2], const Unit& u, int wr, int wc, int fr, int fq) const {
        const int row0 = u.pm * 256 + wr * 64 + fr, col0 = u.pn * 128 + wc * 32 + 8 * fq;
#pragma unroll
        for (int ai = 0; ai < 2; ++ai)
#pragma unroll
            for (int m = 0; m < 4; ++m) { const int row = row0 + ai * 128 + m * 16; bf16_t* rowp = O + (size_t)row * ldc + col0;
                const float rs = RT[wr * 64 + fr + ai * 128 + m * 16];
                float r[8];
#pragma unroll
                for (int n = 0; n < 2; ++n)
#pragma unroll
                    for (int e = 0; e < 4; ++e) { const float g = acc[ai][0][m][n][e] * rs, up = acc[ai][1][m][n][e] * rs; r[n * 4 + e] = g * fast_sigmoid(g) * up; }
                u32x4 w; w.x = cvt_pk_bf16(r[0], r[1]); w.y = cvt_pk_bf16(r[2], r[3]); w.z = cvt_pk_bf16(r[4], r[5]); w.w = cvt_pk_bf16(r[6], r[7]);
                *(u32x4*)rowp = w; }
    }
};
struct EpiResidF32 {
    static constexpr bool PERM = false, AFTER_DRAIN = false;
    const float* R; float* C; int ldc;
    __device__ __forceinline__ void operator()(const f32x4 (&acc)[2][2][4][2], const Unit& u, int wr, int wc, int fr, int fq) const {
        const int row0 = u.pm * 256 + wr * 64 + fr, col0 = u.pn * 256 + wc * 32 + 4 * fq;
#pragma unroll
        for (int ai = 0; ai < 2; ++ai)
#pragma unroll
            for (int m = 0; m < 4; ++m) { const size_t ro = (size_t)(row0 + ai * 128 + m * 16) * ldc + col0;
#pragma unroll
                for (int bj = 0; bj < 2; ++bj)
#pragma unroll
                    for (int n = 0; n < 2; ++n) { const f32x4 r = *(const f32x4*)(R + ro + bj * 128 + n * 16); *(f32x4*)(C + ro + bj * 128 + n * 16) = r + acc[ai][bj][m][n]; } }
    }
};
struct EpiResidNorm {
    static constexpr bool PERM = true, AFTER_DRAIN = true;
    const void* R; void* C; int ldc; float* SSP; int emit; int rb, cb;
    __device__ __forceinline__ void operator()(const f32x4 (&)[2][2][4][2], const Unit&, int, int, int, int) const {}
    template <bool RB, bool CB>
    __device__ __forceinline__ void body(const f32x4 (&acc)[2][2][4][2], const Unit& u, int wr, int wc, int fr, int fq, LAS float* P) const {
        const int col0 = u.pn * 256 + wc * 32 + 8 * fq;
#pragma unroll
        for (int ai = 0; ai < 2; ++ai) {
            f32x4 rv[4][2][2]; u32x4 rw[4][2];
#pragma unroll
            for (int m = 0; m < 4; ++m)
#pragma unroll
                for (int bj = 0; bj < 2; ++bj) { const size_t ro = (size_t)(u.pm * 256 + ai * 128 + wr * 64 + m * 16 + fr) * ldc + col0;
                    if (RB) rw[m][bj] = *(const u32x4*)((const bf16_t*)R + ro + bj * 128);
                    else { rv[m][bj][0] = *(const f32x4*)((const float*)R + ro + bj * 128); rv[m][bj][1] = *(const f32x4*)((const float*)R + ro + bj * 128 + 4); } }
#pragma unroll
            for (int m = 0; m < 4; ++m) { const int rl = ai * 128 + wr * 64 + m * 16 + fr; const size_t ro = (size_t)(u.pm * 256 + rl) * ldc + col0; float s = 0.f;
#pragma unroll
                for (int bj = 0; bj < 2; ++bj) {
                    f32x4 r0, r1;
                    if (RB) { const u32x4 w = rw[m][bj];
                        r0 = (f32x4){__uint_as_float(w.x << 16), __uint_as_float(w.x & 0xffff0000u), __uint_as_float(w.y << 16), __uint_as_float(w.y & 0xffff0000u)};
                        r1 = (f32x4){__uint_as_float(w.z << 16), __uint_as_float(w.z & 0xffff0000u), __uint_as_float(w.w << 16), __uint_as_float(w.w & 0xffff0000u)}; }
                    else { r0 = rv[m][bj][0]; r1 = rv[m][bj][1]; }
                    const f32x4 x0 = r0 + acc[ai][bj][m][0], x1 = r1 + acc[ai][bj][m][1];
                    if (CB) { u32x4 w; w.x = cvt_pk_bf16(x0[0], x0[1]); w.y = cvt_pk_bf16(x0[2], x0[3]); w.z = cvt_pk_bf16(x1[0], x1[1]); w.w = cvt_pk_bf16(x1[2], x1[3]);
                        *(u32x4*)((bf16_t*)C + ro + bj * 128) = w; }
                    else { *(f32x4*)((float*)C + ro + bj * 128) = x0; *(f32x4*)((float*)C + ro + bj * 128 + 4) = x1; }
                    if (emit) s += ((x0[0] * x0[0] + x0[1] * x0[1]) + (x0[2] * x0[2] + x0[3] * x0[3])) + ((x1[0] * x1[0] + x1[1] * x1[1]) + (x1[2] * x1[2] + x1[3] * x1[3])); }
                if (emit) { s += __shfl_xor(s, 16); s += __shfl_xor(s, 32); if (fq == 0) P[rl * 4 + wc] = s; } }
            asm volatile("" ::: "memory"); }
    }
    __device__ __forceinline__ void fused(const f32x4 (&acc)[2][2][4][2], const Unit& u, int wr, int wc, int fr, int fq, LAS unsigned char* lds, int wid, int lane) const {
        LAS float* P = (LAS float*)lds;
        if (rb && cb) body<true, true>(acc, u, wr, wc, fr, fq, P);
        else if (rb) body<true, false>(acc, u, wr, wc, fr, fq, P);
        else body<false, true>(acc, u, wr, wc, fr, fq, P);
        if (emit) {
            asm volatile("s_waitcnt lgkmcnt(0)" ::: "memory"); __builtin_amdgcn_s_barrier(); asm volatile("" ::: "memory");
            const int t = wid * 64 + lane;
            if (t < 256) { const f32x4 p = *(const LAS f32x4*)(P + t * 4); SSP[(size_t)(u.pm * 256 + t) * 8 + u.pn] = (p.x + p.y) + (p.z + p.w); }
            asm volatile("s_waitcnt lgkmcnt(0)" ::: "memory"); __builtin_amdgcn_s_barrier(); asm volatile("" ::: "memory");
        }
    }
};

struct BranchOrder {
    pg8::StaticOrder T;
    __device__ void init(int G, int c) { T.init(S, DM, G, c); }
    __device__ bool next(int i, Unit& u) const { Unit t; const int n = i % 3; if (!T.next(i / 3, t)) return false; u.pm = 32 * n + t.pm; u.pn = 8 * n + t.pn; return true; }
    __device__ __forceinline__ void a_ready(const Unit&) const {}
    __device__ __forceinline__ void done(const Unit&) const {}
};
struct EpiGateMergeAll {
    static constexpr bool PERM = true, AFTER_DRAIN = false;
    const bf16_t* G; int ldg; bf16_t* PART; bf16_t* Mb; int ldc;
    __device__ __forceinline__ void operator()(const f32x4 (&acc)[2][2][4][2], const Unit& u, int wr, int wc, int fr, int fq) const {
        const int n = u.pn >> 3, pm = u.pm & 31, pn = u.pn & 7;
        const int row0 = pm * 256 + wr * 64 + fr, col0 = pn * 256 + wc * 32 + 8 * fq;
        bf16_t* dst = (n < 2) ? PART : Mb;
#pragma unroll
        for (int ai = 0; ai < 2; ++ai) {
            u32x4 gw[4][2], pw[4][2];
#pragma unroll
            for (int m = 0; m < 4; ++m)
#pragma unroll
                for (int bj = 0; bj < 2; ++bj) { const size_t row = (size_t)(row0 + ai * 128 + m * 16);
                    gw[m][bj] = *(const u32x4*)(G + row * ldg + n * DM + col0 + bj * 128);
                    pw[m][bj] = (n > 0) ? *(const u32x4*)(PART + row * ldc + col0 + bj * 128) : (u32x4){0u, 0u, 0u, 0u}; }
#pragma unroll
            for (int m = 0; m < 4; ++m)
#pragma unroll
                for (int bj = 0; bj < 2; ++bj) { const size_t row = (size_t)(row0 + ai * 128 + m * 16);
                    const u32x4 g4 = gw[m][bj], p4 = pw[m][bj];
                    f32x4 a0 = acc[ai][bj][m][0], a1 = acc[ai][bj][m][1];
                    a0[0] = fmaf(a0[0], fast_sigmoid(bflo(g4.x)), bflo(p4.x)); a0[1] = fmaf(a0[1], fast_sigmoid(bfhi(g4.x)), bfhi(p4.x)); a0[2] = fmaf(a0[2], fast_sigmoid(bflo(g4.y)), bflo(p4.y)); a0[3] = fmaf(a0[3], fast_sigmoid(bfhi(g4.y)), bfhi(p4.y));
                    a1[0] = fmaf(a1[0], fast_sigmoid(bflo(g4.z)), bflo(p4.z)); a1[1] = fmaf(a1[1], fast_sigmoid(bfhi(g4.z)), bfhi(p4.z)); a1[2] = fmaf(a1[2], fast_sigmoid(bflo(g4.w)), bflo(p4.w)); a1[3] = fmaf(a1[3], fast_sigmoid(bfhi(g4.w)), bfhi(p4.w));
                    u32x4 w; w.x = cvt_pk_bf16(a0[0], a0[1]); w.y = cvt_pk_bf16(a0[2], a0[3]); w.z = cvt_pk_bf16(a1[0], a1[1]); w.w = cvt_pk_bf16(a1[2], a1[3]);
                    *(u32x4*)(dst + row * ldc + col0 + bj * 128) = w; }
            asm volatile("" ::: "memory"); }
    }
};

struct Args {
    const float* in[21]; float* out; unsigned char* ws;
    int pro_lo, pro_hi;
    int l_lo, l_hi, ph_lo, ph_hi;
    int li, pad;
};
struct Frame {
    LAS unsigned char* lds; volatile LAS unsigned* MISC; gu32* ctl;
    int tid, lane, wave, G, vcu;
};
__device__ __forceinline__ Frame relaunder(const Frame& F0) {
    Frame F = F0; int t = F0.tid, v = F0.vcu, g = F0.G;
    asm volatile("" : "+v"(t)); asm volatile("" : "+s"(v)); asm volatile("" : "+s"(g));
    F.tid = t; F.lane = t & 63; F.wave = __builtin_amdgcn_readfirstlane(t >> 6); F.vcu = v; F.G = g; return F;
}
#ifndef MK_WSTRIDE
#define MK_WSTRIDE 0
#endif
constexpr size_t WSTRIDE = MK_WSTRIDE;
constexpr size_t WBYTES = WSTRIDE ? (size_t)DEPTH * WSTRIDE : LW_BYTES;
constexpr size_t A_PROJ = WS_W + WBYTES, A_HN = A_PROJ + 212 * MiB, A_OA = A_HN + 32 * MiB, A_OB = A_OA + 16 * MiB, A_OC = A_OB + 16 * MiB, A_MERGED = A_OC + 16 * MiB,
                 A_CQN = A_MERGED + 64 * MiB, A_MQ = A_CQN + 16 * MiB, A_MK = A_MQ + 24 * MiB, A_MV = A_MK + 24 * MiB, A_FQ = A_MV + 16 * MiB, A_FK = A_FQ + 16 * MiB, A_FCUM = A_FK + 16 * MiB,
                 A_QT = A_FCUM + 1 * MiB, A_KT = A_QT + 8 * MiB, A_BLAST = A_KT + 8 * MiB, A_KVP = A_BLAST + 1 * MiB, A_SPREV = A_KVP + 64 * MiB, A_CS = A_SPREV + 32 * MiB, A_KRR = A_CS + 2 * MiB,
                 A_KRSS = A_KRR + 2 * MiB, A_HN2 = A_KRSS + 1 * MiB, A_SSPA = A_HN2 + 32 * MiB, A_SSPB = A_SSPA + 1 * MiB, A_XR = A_SSPB + 1 * MiB, A_END = A_XR + 32 * MiB;
typedef const __attribute__((address_space(4))) Args* ArgsP;
__device__ __forceinline__ int lnd_s(int v) { asm volatile("" : "+s"(v)); return v; }
__device__ __forceinline__ int lnd_v(int v) { asm volatile("" : "+v"(v)); return v; }
#define WSP(T, off) ((T*)(a->ws + (off)))
__device__ __forceinline__ ArgsP get_args() { ArgsP p = (ArgsP)__builtin_amdgcn_kernarg_segment_ptr(); asm volatile("" : "+s"(p)); return p; }

constexpr int I_IN = (DM / 64) * ((D_IN + 63) / 64), I_UQ = (512 / 64) * (1536 / 64), I_UKV = (512 / 64) * (2048 / 64), I_BR = (1024 / 64) * (DM / 64), I_OUT = (DM / 64) * (DM / 64),
              I_GU = (DM / 64) * (2 * FFH / 64), I_DN = (FFH / 64) * (DM / 64);
constexpr int NITEMS = I_IN + I_UQ + I_UKV + 3 * I_BR + I_OUT + I_GU + I_DN;
struct CvItem { const float* src; bf16_t* dst; const float* gk; int K, N, k0, n0, kind; };
__device__ __forceinline__ CvItem cv_decode(ArgsP a, int l, int r) {
    unsigned char* wb = a->ws + WS_W + (size_t)l * WSTRIDE;
    CvItem it; it.gk = nullptr;
    if (r < I_IN) { it.src = a->in[3] + (size_t)l * DM * D_IN; it.dst = (bf16_t*)(wb + LW_WIN); it.K = DM; it.N = D_IN; it.kind = 1; it.gk = a->in[2] + l * DM; }
    else if ((r -= I_IN) < I_UQ) { it.src = a->in[5] + (size_t)l * 512 * 1536; it.dst = (bf16_t*)(wb + LW_WUQ); it.K = 512; it.N = 1536; it.kind = 2; }
    else if ((r -= I_UQ) < I_UKV) { it.src = a->in[7] + (size_t)l * 512 * 2048; it.dst = (bf16_t*)(wb + LW_WUKV); it.K = 512; it.N = 2048; it.kind = 0; }
    else if ((r -= I_UKV) < 3 * I_BR) { const int n = r / I_BR; r -= n * I_BR; it.src = a->in[16] + (size_t)(l * 3 + n) * 1024 * DM; it.dst = (bf16_t*)(wb + LW_WBR) + (size_t)n * DM * 1024; it.K = 1024; it.N = DM; it.kind = 0; }
    else if ((r -= 3 * I_BR) < I_OUT) { it.src = a->in[17] + (size_t)l * DM * DM; it.dst = (bf16_t*)(wb + LW_WOUT); it.K = DM; it.N = DM; it.kind = 0; }
    else if ((r -= I_OUT) < I_GU) { it.src = a->in[19] + (size_t)l * DM * 2 * FFH; it.dst = (bf16_t*)(wb + LW_WGU); it.K = DM; it.N = 2 * FFH; it.kind = 3; it.gk = a->in[18] + l * DM; }
    else { r -= I_GU; it.src = a->in[20] + (size_t)l * FFH * DM; it.dst = (bf16_t*)(wb + LW_WDN); it.K = FFH; it.N = DM; it.kind = 0; }
    const int nblk = (it.N + 63) >> 6, kb = r / nblk, nb = r - kb * nblk; it.k0 = 64 * kb; it.n0 = 64 * nb;
    return it;
}
typedef float f32x2g __attribute__((ext_vector_type(2)));
__device__ __forceinline__ void cv_load(const CvItem& it, int lane, f32x4 (&v)[8][2], f32x2g (&gv)[8]) {
    const int n4 = lane & 15, kq = lane >> 4, n = it.n0 + 4 * n4;
    const bool ok = n < it.N;
    const float* src = it.src + (size_t)(it.k0 + 2 * kq) * it.N + n;
#pragma unroll
    for (int ii = 0; ii < 8; ++ii)
#pragma unroll
        for (int t = 0; t < 2; ++t) v[ii][t] = ok ? __builtin_nontemporal_load((const f32x4*)(src + (size_t)(8 * ii + t) * it.N)) : (f32x4){0.f, 0.f, 0.f, 0.f};
    if (it.gk) {
#pragma unroll
        for (int ii = 0; ii < 8; ++ii) gv[ii] = *(const f32x2g*)(it.gk + it.k0 + 2 * kq + 8 * ii); }
    else {
#pragma unroll
        for (int ii = 0; ii < 8; ++ii) gv[ii] = (f32x2g){1.f, 1.f}; }
}
__device__ __forceinline__ void cv_store(const CvItem& it, const f32x4 (&v)[8][2], const f32x2g (&gv)[8], LAS unsigned* scr, int lane) {
    const int n4 = lane & 15, kq = lane >> 4;
#pragma unroll
    for (int ii = 0; ii < 8; ++ii)
#pragma unroll
        for (int e = 0; e < 4; ++e) scr[(4 * n4 + e) * 34 + kq + 4 * ii] = cvt_pk_bf16(v[ii][0][e] * gv[ii].x, v[ii][1][e] * gv[ii].y);
    asm volatile("s_waitcnt lgkmcnt(0)" ::: "memory");
    const int c8 = lane & 7;
#pragma unroll
    for (int j = 0; j < 8; ++j) { const int nn = (lane >> 3) + 8 * j, n = it.n0 + nn;
        typedef unsigned u32x2 __attribute__((ext_vector_type(2)));
        const u32x2 lo = *(const LAS u32x2*)(scr + nn * 34 + 4 * c8), hi2 = *(const LAS u32x2*)(scr + nn * 34 + 4 * c8 + 2);
        const int dr = it.kind == 0 ? n : (it.kind == 1 ? map_in(n) : (it.kind == 2 ? map_uq(n) : map_gu(n)));
        if (n < it.N) *(u32x4*)(it.dst + (size_t)dr * it.K + it.k0 + 8 * c8) = (u32x4){lo.x, lo.y, hi2.x, hi2.y}; }
    asm volatile("s_waitcnt lgkmcnt(0)" ::: "memory");
}
__device__ __forceinline__ void cv_run(ArgsP a, int l0, int first, int stride, int count, LAS unsigned* scr, int lane, int P = NITEMS, int OFF = 0) {
    if (count <= 0) return;
    CvItem cur = cv_decode(a, l0 + first / P, OFF + first % P);
    f32x4 v[8][2]; f32x2g gv[8]; cv_load(cur, lane, v, gv);
    for (int i = 1; i <= count; ++i) {
        CvItem nxt = cur; f32x4 w[8][2]; f32x2g gw[8];
        if (i < count) { const int r = first + i * stride; nxt = cv_decode(a, l0 + r / P, OFF + r % P); cv_load(nxt, lane, w, gw); }
        cv_store(cur, v, gv, scr, lane);
        if (i < count) { cur = nxt;
#pragma unroll
            for (int ii = 0; ii < 8; ++ii) { v[ii][0] = w[ii][0]; v[ii][1] = w[ii][1]; gv[ii] = gw[ii]; } }
    }
}
constexpr int CV_W1 = 96, CV_R1 = 7, CV_B1 = 0, CV_W4 = 128, CV_R4 = 6, CV_B4 = CV_B1 + CV_W1 * CV_R1 * 8, CV_W8 = 128, CV_R8 = 7, CV_B8 = CV_B4 + CV_W4 * CV_R4 * 8;
constexpr int CV_END = (CV_B8 + CV_W8 * CV_R8 * 8) < NITEMS ? (CV_B8 + CV_W8 * CV_R8 * 8) : NITEMS, CV_TAIL = NITEMS - CV_END;
__device__ __forceinline__ void prologue_weights(const Frame& F0, int l_lo, int l_hi) {
    const Frame F = relaunder(F0);
    ArgsP a = get_args();
    LAS unsigned* scr = (LAS unsigned*)(F.lds + RING_OFF + F.wave * 16384);
    const int gw = F.vcu * NWAVES + F.wave, NGW = F.G * NWAVES, total = (l_hi - l_lo) * NITEMS;
    cv_run(a, l_lo, gw, NGW, gw < total ? (total - gw + NGW - 1) / NGW : 0, scr, F.lane);
    if (l_hi - l_lo == 1 && l_lo == 0 && CV_TAIL > 0) {
        const int tot2 = (DEPTH - 1) * CV_TAIL, g2 = (gw + NGW / 2) % NGW;
        cv_run(a, 1, g2, NGW, g2 < tot2 ? (tot2 - g2 + NGW - 1) / NGW : 0, scr, F.lane, CV_TAIL, CV_END);
    }
}
__device__ __forceinline__ void convert_slice(const Frame& F0, int l, int base, int rank, int W, int R) {
    if (l >= DEPTH) return;
    const Frame F = relaunder(F0);
    ArgsP a = get_args();
    LAS unsigned* scr = (LAS unsigned*)(F.lds + RING_OFF + F.wave * 16384);
    const int first = base + rank * 8 + F.wave, stride = W * 8;
    int count = 0; if (first < NITEMS) { count = (NITEMS - first + stride - 1) / stride; if (count > R) count = R; }
    cv_run(a, l, first, stride, count, scr, F.lane);
}
__device__ __forceinline__ void phase_rms0(const Frame& F0, const float* X, bf16_t* O, float* SSP) {
    const Frame F = relaunder(F0);
    const int gw = F.vcu * NWAVES + F.wave, NGW = F.G * NWAVES, lane = F.lane;
    for (int m = gw; m < S; m += NGW) {
        const f32x4* xr = (const f32x4*)(X + (size_t)m * DM) + lane;
        f32x4 v[8]; float s = 0.f;
#pragma unroll
        for (int j = 0; j < 8; ++j) { v[j] = xr[64 * j]; s += (v[j].x * v[j].x + v[j].y * v[j].y) + (v[j].z * v[j].z + v[j].w * v[j].w); }
        s = wave_sum(s);
        unsigned long long* o8 = (unsigned long long*)(O + (size_t)m * DM) + lane;
#pragma unroll
        for (int j = 0; j < 8; ++j) o8[64 * j] = (unsigned long long)pk2(v[j].x, v[j].y) | ((unsigned long long)pk2(v[j].z, v[j].w) << 32);
        if (lane < 2) *(f32x4*)(SSP + (size_t)m * 8 + 4 * lane) = (f32x4){lane == 0 ? s : 0.f, 0.f, 0.f, 0.f};
    }
}
constexpr int RT_OFF = 131072;
__device__ __forceinline__ int first_unit_pm(int nN, int G, int cidx) {
    const int nM = S / 256, nwg = nM * nN; if (cidx >= nwg) return -1;
    int wgid = cidx; { const int q = nwg / pg8::NXCD, r = nwg % pg8::NXCD, xcd = wgid % pg8::NXCD, off = wgid / pg8::NXCD; wgid = (xcd < r ? xcd * (q + 1) : r * (q + 1) + (xcd - r) * q) + off; }
    const int nig = pg8::WGM * nN, gid = wgid / nig, fm = gid * pg8::WGM, gsz = (nM - fm) < pg8::WGM ? (nM - fm) : pg8::WGM;
    return fm + ((wgid % nig) % gsz);
}
__device__ __forceinline__ void fill_rstd_table(const Frame& F0, const float* SSP, int pm) {
    const Frame F = relaunder(F0);
    if (F.tid < 256) { const int row = pm * 256 + F.tid;
        const f32x4 s0 = *(const f32x4*)(SSP + (size_t)row * 8), s1 = *(const f32x4*)(SSP + (size_t)row * 8 + 4);
        ((LAS float*)(F.lds + RT_OFF))[F.tid] = rsqrtf((((s0.x + s0.y) + (s0.z + s0.w)) + ((s1.x + s1.y) + (s1.z + s1.w))) * (1.f / DM) + EPS); }
    __syncthreads();
}

__device__ __forceinline__ float log_sigmoid_f(float x) { return fminf(x, 0.f) - __logf(1.f + __expf(-fabsf(x))); }
__device__ __forceinline__ void unpack8(const u32x4 w, float (&f)[8]) {
    f[0] = bflo(w.x); f[1] = bfhi(w.x); f[2] = bflo(w.y); f[3] = bfhi(w.y); f[4] = bflo(w.z); f[5] = bfhi(w.z); f[6] = bflo(w.w); f[7] = bfhi(w.w);
}
__device__ __forceinline__ u32x4 pack8f(const float (&f)[8]) { u32x4 w; w.x = cvt_pk_bf16(f[0], f[1]); w.y = cvt_pk_bf16(f[2], f[3]); w.z = cvt_pk_bf16(f[4], f[5]); w.w = cvt_pk_bf16(f[6], f[7]); return w; }

__device__ __forceinline__ void sincos_d(double a, double& sn, double& cn) {
    const double TWO_PI = 6.283185307179586476925286766559, HALF_PI = 1.5707963267948966192313216916398;
    const double k = rint(a / TWO_PI); double r = a - k * TWO_PI;
    const double q = rint(r / HALF_PI); r = r - q * HALF_PI; const int qi = ((int)q) & 3;
    const double r2 = r * r;
    const double sp = r * (1.0 + r2 * (-1.0 / 6 + r2 * (1.0 / 120 + r2 * (-1.0 / 5040 + r2 * (1.0 / 362880 + r2 * (-1.0 / 39916800 + r2 * (1.0 / 6227020800.0)))))));
    const double cp = 1.0 + r2 * (-0.5 + r2 * (1.0 / 24 + r2 * (-1.0 / 720 + r2 * (1.0 / 40320 + r2 * (-1.0 / 3628800 + r2 * (1.0 / 479001600.0 + r2 * (-1.0 / 87178291200.0)))))));
    if (qi == 0) { sn = sp; cn = cp; } else if (qi == 1) { sn = cp; cn = -sp; } else if (qi == 2) { sn = -sp; cn = -cp; } else { sn = -cp; cn = sp; }
}
__device__ __forceinline__ void rope_tables(const Frame& F0) {
    const Frame F = relaunder(F0);
    ArgsP a = get_args(); const int* pos = (const int*)a->in[1]; float* CS = WSP(float, A_CS);
    for (int i = F.vcu * NTHREADS + F.tid; i < S * 32; i += F.G * NTHREADS) {
        const int s = i >> 5, f = i & 31;
        const float inv = (float)exp2(-(double)f / 32.0 * 13.287712379549449391481277717958);
        const float ang = (float)pos[s] * inv;
        double sn, cn; sincos_d((double)ang, sn, cn);
        CS[s * 64 + f] = (float)cn; CS[s * 64 + 32 + f] = (float)sn;
    }
}

__device__ __forceinline__ void prep_row(int lane, int row, int l, ArgsP a) {
    const bf16_t* pr = WSP(bf16_t, A_PROJ) + (size_t)row * NP;
    const u32x4 cw0 = *(const u32x4*)(pr + P_CQ + 16 * lane), cw1 = *(const u32x4*)(pr + P_CQ + 16 * lane + 8);
    const u32x4 qw0 = *(const u32x4*)(pr + P_FQ + 16 * lane), qw1 = *(const u32x4*)(pr + P_FQ + 16 * lane + 8);
    const u32x4 kw0 = *(const u32x4*)(pr + P_FK + 16 * lane), kw1 = *(const u32x4*)(pr + P_FK + 16 * lane + 8);
    const float krv = bf2f(pr[P_KR + lane]);
    const float* cs = WSP(float, A_CS) + (size_t)row * 64;
    const float cc = cs[lane & 31], sn = cs[32 + (lane & 31)];
    {
        float v0[8], v1[8]; unpack8(cw0, v0); unpack8(cw1, v1);
        float s = 0.f;
#pragma unroll
        for (int i = 0; i < 8; ++i) s += v0[i] * v0[i] + v1[i] * v1[i];
#pragma unroll
        for (int o = 1; o < 32; o <<= 1) s += __shfl_xor(s, o);
        const float r = rsqrtf(s * (1.f / 512.f) + EPS);
        const float* g = (lane < 32) ? (a->in[4] + l * 512 + 16 * lane) : (a->in[6] + l * 512 + 16 * (lane - 32));
#pragma unroll
        for (int i = 0; i < 8; ++i) { v0[i] *= r * g[i]; v1[i] *= r * g[8 + i]; }
        bf16_t* op = WSP(bf16_t, A_CQN) + (size_t)row * 1024 + 16 * lane;
        *(u32x4*)op = pack8f(v0); *(u32x4*)(op + 8) = pack8f(v1);
    }
    {
        const float ss = wave_sum(krv * krv);
        const float y = krv * (a->in[9][l * 192 + 128 + lane]);
        const float yo = __shfl_xor(y, 32);
        WSP(float, A_KRR)[(size_t)row * 64 + rope_pos(lane)] = (lane < 32) ? (y * cc - yo * sn) : (y * cc + yo * sn);
        if (lane == 0) WSP(float, A_KRSS)[row] = ss;
    }
#pragma unroll
    for (int which = 0; which < 2; ++which) {
        float v0[8], v1[8]; unpack8(which ? kw0 : qw0, v0); unpack8(which ? kw1 : qw1, v1);
        float s = 0.f;
#pragma unroll
        for (int i = 0; i < 8; ++i) s += v0[i] * v0[i] + v1[i] * v1[i];
        s += __shfl_xor(s, 1); s += __shfl_xor(s, 2); s += __shfl_xor(s, 4);
        const float r = rsqrtf(s * (1.f / 128.f) + EPS);
        const float* g = a->in[which ? 14 : 13] + l * 128 + 16 * (lane & 7);
#pragma unroll
        for (int i = 0; i < 8; ++i) { v0[i] *= r * g[i]; v1[i] *= r * g[8 + i]; }
        bf16_t* op = WSP(bf16_t, which ? A_FK : A_FQ) + ((size_t)(lane >> 3) * S + row) * 128 + 16 * (lane & 7);
        *(u32x4*)op = pack8f(v0); *(u32x4*)(op + 8) = pack8f(v1);
    }
}
__device__ __forceinline__ void fox_cumsum(const Frame& F, int h, int l, ArgsP a) {
    LAS float* tot = (LAS float*)(F.lds);
    const bf16_t* P = WSP(bf16_t, A_PROJ) + P_FL + h; const float bf = a->in[15][l * 8 + h];
    const int t = F.tid; float v[16]; float run = 0.f;
    unsigned short raw[16];
#pragma unroll
    for (int i = 0; i < 16; ++i) raw[i] = P[(size_t)(t * 16 + i) * NP];
    asm volatile("" ::: "memory");
#pragma unroll
    for (int i = 0; i < 16; ++i) { run += log_sigmoid_f(bf2f(raw[i]) + bf); v[i] = run; }
    float inc = run;
#pragma unroll
    for (int o = 1; o < 64; o <<= 1) { const float n = __shfl_up(inc, o); if (F.lane >= o) inc += n; }
    if (F.lane == 63) tot[F.wave] = inc;
    __syncthreads();
    float woff = 0.f;
    for (int w = 0; w < F.wave; ++w) woff += tot[w];
    const float off = woff + inc - run;
    float* O = WSP(float, A_FCUM) + (size_t)h * S + t * 16;
#pragma unroll
    for (int i = 0; i < 16; ++i) O[i] = (v[i] + off) * 11.313708498984761f;
    __syncthreads();
}
__device__ __forceinline__ void gla_prep_unit(const Frame& F, int chunk, int h, int l, ArgsP a) {
    using namespace att;
    const int tid = lnd_v(F.tid), lane = tid & 63, w = __builtin_amdgcn_readfirstlane(tid >> 6), r32 = lane & 31, hi = lane >> 5, row0 = chunk * 64;
    char* lds = (char*)F.lds;
    char* Vl = lds;
    char* Kl = lds + 2 * SHM_V;
    float* LA = (float*)(lds + 3 * SHM_V);
    float* WA = (float*)(lds + 3 * SHM_V + 32768);
    float* GA = (float*)(lds + 3 * SHM_V + 32768 + 8192);
    float* TOT = (float*)(lds + 3 * SHM_V + 32768 + 8192 + 4096);
    const mk::bf16_t* PR = WSP(mk::bf16_t, A_PROJ) + (size_t)row0 * NP;
    if (tid < 128) { const int r = tid >> 1, hf = tid & 1; const u32x4 wv = *(const u32x4*)(PR + (size_t)r * NP + P_GA + 8 * hf); float t[8]; mk::unpack8(wv, t);
#pragma unroll
        for (int i = 0; i < 8; ++i) GA[r * 16 + 8 * hf + i] = t[i]; }
    { const int k = tid >> 5, d4 = (tid & 31) * 4; *(f32x4*)(WA + k * 128 + d4) = *(const f32x4*)(a->in[10] + (size_t)l * 16 * 512 + k * 512 + h * 128 + d4); }
    const int sr = tid >> 4, sc = (tid & 15) * 8, vst0 = v_st(sr, sc), vst1 = v_st(32 + sr, sc);
    { const bf16x8 v00 = load8(PR + (size_t)sr * NP + P_GV + h * 256 + sc), v01 = load8(PR + (size_t)(32 + sr) * NP + P_GV + h * 256 + sc);
      const bf16x8 v10 = load8(PR + (size_t)sr * NP + P_GV + h * 256 + 128 + sc), v11 = load8(PR + (size_t)(32 + sr) * NP + P_GV + h * 256 + 128 + sc);
      *(bf16x8*)(Vl + vst0) = v00; *(bf16x8*)(Vl + vst1) = v01; *(bf16x8*)(Vl + SHM_V + vst0) = v10; *(bf16x8*)(Vl + SHM_V + vst1) = v11; }
    __syncthreads();
    const int dg = tid & 15, jq = tid >> 4;
    {   float x0[8], x1[8];
        const f32x4 b0 = *(const f32x4*)(a->in[11] + l * 512 + h * 128 + dg * 8), b1 = *(const f32x4*)(a->in[11] + l * 512 + h * 128 + dg * 8 + 4);
#pragma unroll
        for (int i = 0; i < 4; ++i) { x0[i] = b0[i]; x0[4 + i] = b1[i]; x1[i] = b0[i]; x1[4 + i] = b1[i]; }
#pragma unroll
        for (int k = 0; k < 16; ++k) { const f32x4 w0 = *(const f32x4*)(WA + k * 128 + dg * 8), w1 = *(const f32x4*)(WA + k * 128 + dg * 8 + 4);
            const float g0 = GA[(2 * jq) * 16 + k], g1 = GA[(2 * jq + 1) * 16 + k];
#pragma unroll
            for (int i = 0; i < 4; ++i) { x0[i] = fmaf(g0, w0[i], x0[i]); x0[4 + i] = fmaf(g0, w1[i], x0[4 + i]); x1[i] = fmaf(g1, w0[i], x1[i]); x1[4 + i] = fmaf(g1, w1[i], x1[4 + i]); } }
#pragma unroll
        for (int i = 0; i < 8; ++i) { x0[i] = mk::log_sigmoid_f(x0[i]) * (1.f / 16.f); x1[i] = mk::log_sigmoid_f(x1[i]) * (1.f / 16.f); }
        *(f32x4*)(LA + (2 * jq) * 128 + dg * 8) = (f32x4){x0[0], x0[1], x0[2], x0[3]}; *(f32x4*)(LA + (2 * jq) * 128 + dg * 8 + 4) = (f32x4){x0[4], x0[5], x0[6], x0[7]};
        *(f32x4*)(LA + (2 * jq + 1) * 128 + dg * 8) = (f32x4){x1[0], x1[1], x1[2], x1[3]}; *(f32x4*)(LA + (2 * jq + 1) * 128 + dg * 8 + 4) = (f32x4){x1[4], x1[5], x1[6], x1[7]};
    }
    __syncthreads();
    { const int d = tid & 127, q = tid >> 7; float run = 0.f;
#pragma unroll
      for (int j = 0; j < 16; ++j) { run += LA[(16 * q + j) * 128 + d]; LA[(16 * q + j) * 128 + d] = run; }
      TOT[q * 128 + d] = run;
      __syncthreads();
      float off = 0.f;
      for (int qq = 0; qq < q; ++qq) off += TOT[qq * 128 + d];
      if (q > 0) {
#pragma unroll
          for (int j = 0; j < 16; ++j) LA[(16 * q + j) * 128 + d] += off; }
      if (q == 3) WSP(float, A_BLAST)[chunk * 512 + h * 128 + d] = run + off; }
    __syncthreads();
#pragma unroll
    for (int rr = 0; rr < 2; ++rr) { const int j = 2 * jq + rr;
        const u32x4 qw = *(const u32x4*)(PR + (size_t)j * NP + P_GQ + h * 128 + dg * 8), kw = *(const u32x4*)(PR + (size_t)j * NP + P_GK + h * 128 + dg * 8);
        float qv[8], kv[8]; mk::unpack8(qw, qv); mk::unpack8(kw, kv);
        const f32x4 c0 = *(const f32x4*)(LA + j * 128 + dg * 8), c1 = *(const f32x4*)(LA + j * 128 + dg * 8 + 4);
#pragma unroll
        for (int i = 0; i < 8; ++i) { const float bb = i < 4 ? c0[i] : c1[i - 4]; qv[i] *= 0.08838834764831845f * __expf(bb); kv[i] *= __expf(-bb); }
        const u32x4 qo = mk::pack8f(qv), ko = mk::pack8f(kv);
        *(u32x4*)(WSP(mk::bf16_t, A_QT) + (size_t)(row0 + j) * 512 + h * 128 + dg * 8) = qo;
        *(u32x4*)(WSP(mk::bf16_t, A_KT) + (size_t)(row0 + j) * 512 + h * 128 + dg * 8) = ko;
        *(u32x4*)(Kl + v_st(j, dg * 8)) = ko; }
    __syncthreads();
    {   const int vb = (int)(uintptr_t)Vl + v_rd_base(lane) + (w >> 2) * SHM_V + (w & 3) * 512;
        const int kb = (int)(uintptr_t)Kl + v_rd_base(lane);
#define TRRDV(dst, off) asm volatile("ds_read_b64_tr_b16 %0, %1 offset:%2" : "=&v"(dst) : "v"(vb), "i"(off) : "memory")
#define TRRDK(dst, off) asm volatile("ds_read_b64_tr_b16 %0, %1 offset:%2" : "=&v"(dst) : "v"(kb), "i"(off) : "memory")
        s16x4 vl0, vl1, vl2, vl3, vh0, vh1, vh2, vh3;
        TRRDV(vl0, 0); TRRDV(vh0, 2048); TRRDV(vl1, 4096); TRRDV(vh1, 6144); TRRDV(vl2, 8192); TRRDV(vh2, 10240); TRRDV(vl3, 12288); TRRDV(vh3, 14336);
        mk::bf16_t* O = WSP(mk::bf16_t, A_KVP) + ((size_t)(chunk * 4 + h) * 256 + w * 32 + r32) * 128 + 4 * hi;
#define KV_DB(db) do { s16x4 l0, l1, l2, l3, h0, h1, h2, h3; constexpr int b_ = (db) * 512;                                                                                                       \
            TRRDK(l0, b_); TRRDK(h0, b_ + 2048); TRRDK(l1, b_ + 4096); TRRDK(h1, b_ + 6144); TRRDK(l2, b_ + 8192); TRRDK(h2, b_ + 10240); TRRDK(l3, b_ + 12288); TRRDK(h3, b_ + 14336);         \
            asm volatile("s_waitcnt lgkmcnt(0)" ::: "memory"); SBAR();                                                                                                                          \
            f32x16 c = {};                                                                                                                                                                      \
            c = __builtin_amdgcn_mfma_f32_32x32x16_bf16((bf16x8){l0[0], l0[1], l0[2], l0[3], h0[0], h0[1], h0[2], h0[3]}, (bf16x8){vl0[0], vl0[1], vl0[2], vl0[3], vh0[0], vh0[1], vh0[2], vh0[3]}, c, 0, 0, 0);   \
            c = __builtin_amdgcn_mfma_f32_32x32x16_bf16((bf16x8){l1[0], l1[1], l1[2], l1[3], h1[0], h1[1], h1[2], h1[3]}, (bf16x8){vl1[0], vl1[1], vl1[2], vl1[3], vh1[0], vh1[1], vh1[2], vh1[3]}, c, 0, 0, 0);   \
            c = __builtin_amdgcn_mfma_f32_32x32x16_bf16((bf16x8){l2[0], l2[1], l2[2], l2[3], h2[0], h2[1], h2[2], h2[3]}, (bf16x8){vl2[0], vl2[1], vl2[2], vl2[3], vh2[0], vh2[1], vh2[2], vh2[3]}, c, 0, 0, 0);   \
            c = __builtin_amdgcn_mfma_f32_32x32x16_bf16((bf16x8){l3[0], l3[1], l3[2], l3[3], h3[0], h3[1], h3[2], h3[3]}, (bf16x8){vl3[0], vl3[1], vl3[2], vl3[3], vh3[0], vh3[1], vh3[2], vh3[3]}, c, 0, 0, 0);   \
                                                                                       \
            _Pragma("unroll") for (int g_ = 0; g_ < 4; ++g_) { typedef unsigned u32x2_ __attribute__((ext_vector_type(2))); *(u32x2_*)(O + (db) * 32 + 8 * g_) = (u32x2_){cvtpk_c(c[4 * g_], c[4 * g_ + 1]), cvtpk_c(c[4 * g_ + 2], c[4 * g_ + 3])}; } } while (0)
        KV_DB(0); KV_DB(1); KV_DB(2); KV_DB(3);
#undef KV_DB
#undef TRRDV
#undef TRRDK
    }
    __syncthreads();
}
__device__ __forceinline__ void phase_prep(const Frame& F0, int l) {
    const Frame F = relaunder(F0);
    ArgsP a = get_args();
    const int v = lnd_s(F.vcu);
    for (int u = v; u < 512; u += F.G) gla_prep_unit(F, u >> 2, u & 3, l, a);
    for (int u = v; u < 136; u += F.G) if (u >= 128) fox_cumsum(F, u - 128, l, a);
    const int gw = lnd_s(F.vcu * NWAVES + F.wave), NGW = F.G * NWAVES, lane = lnd_v(F.lane);
    for (int m = gw; m < S; m += NGW) prep_row(lane, m, l, a);
}

__device__ __forceinline__ void gla_scan(const Frame& F0) {
    const Frame F = relaunder(F0);
    ArgsP a = get_args();
    typedef float f32x2 __attribute__((ext_vector_type(2)));
    const bf16_t* KVP = WSP(bf16_t, A_KVP); const float* BL = WSP(float, A_BLAST); bf16_t* SP = WSP(bf16_t, A_SPREV);
    if (F.tid < 256)
    for (int e = lnd_s(F.vcu) * 256 + lnd_v(F.tid); e < 4 * 256 * 64; e += F.G * 256) {
        const int dp = e & 63, hc = e >> 6, h = hc >> 8;
        f32x2 st = {0.f, 0.f};
#pragma unroll 32
        for (int c = 0; c < 128; ++c) {
            const size_t o = ((size_t)c * 1024 + hc) * 128 + 2 * dp;
            const unsigned kw = *(const unsigned*)(KVP + o); const f32x2 kv = {bflo(kw), bfhi(kw)}; const f32x2 bl = *(const f32x2*)(BL + c * 512 + h * 128 + 2 * dp);
            *(unsigned*)(SP + o) = cvt_pk_bf16(st.x, st.y);
            st.x = __expf(bl.x) * (st.x + kv.x); st.y = __expf(bl.y) * (st.y + kv.y);
        }
    }
}

struct EpiMlaQ {
    static constexpr bool PERM = true, AFTER_DRAIN = true;
    bf16_t* MQ; const float* g; const float* CS;
    __device__ __forceinline__ void operator()(const f32x4 (&)[2][2][4][2], const Unit&, int, int, int, int) const {}
    __device__ __forceinline__ void fused(const f32x4 (&acc)[2][2][4][2], const Unit& u, int wr, int wc, int fr, int fq, LAS unsigned char* lds, int wid, int lane) const {
        LAS float* P = (LAS float*)lds;
#pragma unroll
        for (int ai = 0; ai < 2; ++ai)
#pragma unroll
            for (int m = 0; m < 4; ++m) { float s = 0.f;
#pragma unroll
                for (int n = 0; n < 2; ++n) { const f32x4 x = acc[ai][0][m][n]; s += (x[0] * x[0] + x[1] * x[1]) + (x[2] * x[2] + x[3] * x[3]);
                    if (wc < 2) { const f32x4 y = acc[ai][1][m][n]; s += (y[0] * y[0] + y[1] * y[1]) + (y[2] * y[2] + y[3] * y[3]); } }
                s += __shfl_xor(s, 16); s += __shfl_xor(s, 32);
                if (fq == 0) P[(ai * 128 + wr * 64 + m * 16 + fr) * 4 + wc] = s; }
        asm volatile("s_waitcnt lgkmcnt(0)" ::: "memory"); __builtin_amdgcn_s_barrier(); asm volatile("" ::: "memory");
        const int h = u.pn;
        const f32x4 g0 = *(const f32x4*)(g + 32 * wc + 8 * fq), g1 = *(const f32x4*)(g + 32 * wc + 8 * fq + 4);
        f32x4 gr1 = {0.f, 0.f, 0.f, 0.f}, gr2 = gr1;
        if (wc < 2) { gr1 = *(const f32x4*)(g + 128 + 16 * wc + 4 * fq); gr2 = *(const f32x4*)(g + 160 + 16 * wc + 4 * fq); }
#pragma unroll
        for (int ai = 0; ai < 2; ++ai)
#pragma unroll
            for (int m = 0; m < 4; ++m) { const int rl = ai * 128 + wr * 64 + m * 16 + fr; const int row = u.pm * 256 + rl;
                const f32x4 pp = *(const LAS f32x4*)(P + rl * 4);
                const float r = rsqrtf(((pp.x + pp.y) + (pp.z + pp.w)) * (1.f / 192.f) + EPS);
                bf16_t* ob = MQ + ((size_t)h * S + row) * 192;
                { const f32x4 a0 = acc[ai][0][m][0] * r * g0, a1 = acc[ai][0][m][1] * r * g1;
                  u32x4 w; w.x = cvt_pk_bf16(a0[0], a0[1]); w.y = cvt_pk_bf16(a0[2], a0[3]); w.z = cvt_pk_bf16(a1[0], a1[1]); w.w = cvt_pk_bf16(a1[2], a1[3]);
                  *(u32x4*)(ob + 32 * wc + 8 * fq) = w; }
                if (wc < 2) { const f32x4 y1 = acc[ai][1][m][0] * r * gr1, y2 = acc[ai][1][m][1] * r * gr2;
                  const f32x4 c = *(const f32x4*)(CS + (size_t)row * 64 + 16 * wc + 4 * fq), sn = *(const f32x4*)(CS + (size_t)row * 64 + 32 + 16 * wc + 4 * fq);
                  const f32x4 o1 = y1 * c - y2 * sn, o2 = y2 * c + y1 * sn;
                  u32x4 w; w.x = cvt_pk_bf16(o1[0], o1[1]); w.y = cvt_pk_bf16(o1[2], o1[3]); w.z = cvt_pk_bf16(o2[0], o2[1]); w.w = cvt_pk_bf16(o2[2], o2[3]);
                  *(u32x4*)(ob + 128 + 32 * wc + 8 * fq) = w; }
                asm volatile("" ::: "memory"); }
        asm volatile("s_waitcnt lgkmcnt(0)" ::: "memory"); __builtin_amdgcn_s_barrier(); asm volatile("" ::: "memory");
    }
};
struct EpiMlaKV {
    static constexpr bool PERM = true, AFTER_DRAIN = true;
    bf16_t* MK; bf16_t* MV; const float* g; const float* KRR; const float* KRSS;
    __device__ __forceinline__ void operator()(const f32x4 (&)[2][2][4][2], const Unit&, int, int, int, int) const {}
    __device__ __forceinline__ void fused(const f32x4 (&acc)[2][2][4][2], const Unit& u, int wr, int wc, int fr, int fq, LAS unsigned char* lds, int wid, int lane) const {
        LAS float* P = (LAS float*)lds;
#pragma unroll
        for (int ai = 0; ai < 2; ++ai)
#pragma unroll
            for (int m = 0; m < 4; ++m) { float s = 0.f;
#pragma unroll
                for (int n = 0; n < 2; ++n) { const f32x4 x = acc[ai][0][m][n]; s += (x[0] * x[0] + x[1] * x[1]) + (x[2] * x[2] + x[3] * x[3]); }
                s += __shfl_xor(s, 16); s += __shfl_xor(s, 32);
                if (fq == 0) P[(ai * 128 + wr * 64 + m * 16 + fr) * 4 + wc] = s; }
        asm volatile("s_waitcnt lgkmcnt(0)" ::: "memory"); __builtin_amdgcn_s_barrier(); asm volatile("" ::: "memory");
        const int h = u.pn;
        const f32x4 g0 = *(const f32x4*)(g + 32 * wc + 8 * fq), g1 = *(const f32x4*)(g + 32 * wc + 8 * fq + 4);
#pragma unroll
        for (int ai = 0; ai < 2; ++ai)
#pragma unroll
            for (int m = 0; m < 4; ++m) { const int rl = ai * 128 + wr * 64 + m * 16 + fr; const int row = u.pm * 256 + rl;
                const f32x4 pp = *(const LAS f32x4*)(P + rl * 4);
                const float r = rsqrtf((((pp.x + pp.y) + (pp.z + pp.w)) + KRSS[row]) * (1.f / 192.f) + EPS);
                bf16_t* kb = MK + ((size_t)h * S + row) * 192; bf16_t* vb = MV + ((size_t)h * S + row) * 128;
                { const f32x4 a0 = acc[ai][0][m][0] * r * g0, a1 = acc[ai][0][m][1] * r * g1;
                  u32x4 w; w.x = cvt_pk_bf16(a0[0], a0[1]); w.y = cvt_pk_bf16(a0[2], a0[3]); w.z = cvt_pk_bf16(a1[0], a1[1]); w.w = cvt_pk_bf16(a1[2], a1[3]);
                  *(u32x4*)(kb + 32 * wc + 8 * fq) = w; }
                { const f32x4 a0 = acc[ai][1][m][0], a1 = acc[ai][1][m][1];
                  u32x4 w; w.x = cvt_pk_bf16(a0[0], a0[1]); w.y = cvt_pk_bf16(a0[2], a0[3]); w.z = cvt_pk_bf16(a1[0], a1[1]); w.w = cvt_pk_bf16(a1[2], a1[3]);
                  *(u32x4*)(vb + 32 * wc + 8 * fq) = w; }
                { const f32x4 k4 = *(const f32x4*)(KRR + (size_t)row * 64 + 16 * wc + 4 * fq) * r;
                  typedef unsigned u32x2 __attribute__((ext_vector_type(2)));
                  u32x2 w; w.x = cvt_pk_bf16(k4[0], k4[1]); w.y = cvt_pk_bf16(k4[2], k4[3]);
                  *(u32x2*)(kb + 128 + 16 * wc + 4 * fq) = w; }
                asm volatile("" ::: "memory"); }
        asm volatile("s_waitcnt lgkmcnt(0)" ::: "memory"); __builtin_amdgcn_s_barrier(); asm volatile("" ::: "memory");
    }
};

__device__ __forceinline__ void gla_out_unit(const Frame& F, char* lds, int chunk, int l, ArgsP a) {
    using namespace att;
    typedef unsigned short bf16;
    const int w = F.wave, rb = w & 1, cp = w >> 1, row0 = chunk * 64;
    char* V_lds = lds + L_V; float* RS = (float*)(lds + L_WS);
    const bf16* PR = WSP(bf16, A_PROJ) + (size_t)row0 * NP;
    const bf16* QT = WSP(bf16, A_QT) + (size_t)row0 * 512; const bf16* KT = WSP(bf16, A_KT) + (size_t)row0 * 512;
    const float* gO = a->in[12] + l * 256;
#define PK4G(P, B_, OUT) do { unsigned a0 = cvtpk_c(P[B_+0], P[B_+1]), a1 = cvtpk_c(P[B_+2], P[B_+3]); unsigned b0 = cvtpk_c(P[B_+4], P[B_+5]), b1 = cvtpk_c(P[B_+6], P[B_+7]);        \
        auto r0 = __builtin_amdgcn_permlane32_swap(a0, b0, false, false); auto r1 = __builtin_amdgcn_permlane32_swap(a1, b1, false, false); \
        u32x4 w_ = {r0[0], r1[0], r0[1], r1[1]}; OUT = *reinterpret_cast<bf16x8*>(&w_); } while (0)
    for (int h = 0; h < 4; ++h) {
        const int tid = lnd_v(F.tid), lane = tid & 63, r32 = lane & 31, hi = lane >> 5;
        const int sr = tid >> 4, sc = (tid & 15) * 8, vst0 = v_st(sr, sc), vst1 = v_st(32 + sr, sc);
        const bf16x8 v00 = load8(PR + (size_t)sr * NP + P_GV + h * 256 + sc), v01 = load8(PR + (size_t)(32 + sr) * NP + P_GV + h * 256 + sc);
        const bf16x8 v10 = load8(PR + (size_t)sr * NP + P_GV + h * 256 + 128 + sc), v11 = load8(PR + (size_t)(32 + sr) * NP + P_GV + h * 256 + 128 + sc);
        bf16x8 qf[8];
#pragma unroll
        for (int d0 = 0; d0 < 8; ++d0) qf[d0] = load8(QT + (size_t)(rb * 32 + r32) * 512 + h * 128 + d0 * 16 + hi * 8);
        f32x16 p0 = {}, p1 = {};
        {   bf16x8 kf[8];
#pragma unroll
            for (int d0 = 0; d0 < 8; ++d0) kf[d0] = load8(KT + (size_t)r32 * 512 + h * 128 + d0 * 16 + hi * 8);
#pragma unroll
            for (int d0 = 0; d0 < 8; ++d0) p0 = __builtin_amdgcn_mfma_f32_32x32x16_bf16(kf[d0], qf[d0], p0, 0, 0, 0); }
        if (rb == 1) {
            bf16x8 kf[8];
#pragma unroll
            for (int d0 = 0; d0 < 8; ++d0) kf[d0] = load8(KT + (size_t)(32 + r32) * 512 + h * 128 + d0 * 16 + hi * 8);
#pragma unroll
            for (int d0 = 0; d0 < 8; ++d0) p1 = __builtin_amdgcn_mfma_f32_32x32x16_bf16(kf[d0], qf[d0], p1, 0, 0, 0);
        }
#pragma unroll
        for (int r = 0; r < 16; ++r) { const bool keep = ((r & 3) + 8 * (r >> 2) + 4 * hi) <= r32; if (rb == 0) { if (!keep) p0[r] = 0.f; } else { if (!keep) p1[r] = 0.f; } }
        bf16x8 pa0, pa1, pa2, pa3;
        PK4G(p0, 0, pa0); PK4G(p0, 8, pa1); PK4G(p1, 0, pa2); PK4G(p1, 8, pa3);
        *(bf16x8*)(V_lds + vst0) = v00; *(bf16x8*)(V_lds + vst1) = v01; *(bf16x8*)(V_lds + SHM_V + vst0) = v10; *(bf16x8*)(V_lds + SHM_V + vst1) = v11;
        __syncthreads();
        f32x16 o[2] = {};
#pragma unroll
        for (int cbi = 0; cbi < 2; ++cbi) {
            const int cb = 2 * cp + cbi;
            const int vb = (int)(uintptr_t)V_lds + v_rd_base(lane) + (cb >> 2) * SHM_V + (cb & 3) * 512;
#define TRRDG(dst, off) asm volatile("ds_read_b64_tr_b16 %0, %1 offset:%2" : "=&v"(dst) : "v"(vb), "i"(off) : "memory")
            s16x4 l0, l1, l2, l3, h0, h1, h2, h3;
            TRRDG(l0, 0); TRRDG(h0, 2048); TRRDG(l1, 4096); TRRDG(h1, 6144); TRRDG(l2, 8192); TRRDG(h2, 10240); TRRDG(l3, 12288); TRRDG(h3, 14336);
            asm volatile("s_waitcnt lgkmcnt(0)" ::: "memory"); SBAR();
            o[cbi] = __builtin_amdgcn_mfma_f32_32x32x16_bf16(pa0, (bf16x8){l0[0], l0[1], l0[2], l0[3], h0[0], h0[1], h0[2], h0[3]}, o[cbi], 0, 0, 0);
            o[cbi] = __builtin_amdgcn_mfma_f32_32x32x16_bf16(pa1, (bf16x8){l1[0], l1[1], l1[2], l1[3], h1[0], h1[1], h1[2], h1[3]}, o[cbi], 0, 0, 0);
            o[cbi] = __builtin_amdgcn_mfma_f32_32x32x16_bf16(pa2, (bf16x8){l2[0], l2[1], l2[2], l2[3], h2[0], h2[1], h2[2], h2[3]}, o[cbi], 0, 0, 0);
            o[cbi] = __builtin_amdgcn_mfma_f32_32x32x16_bf16(pa3, (bf16x8){l3[0], l3[1], l3[2], l3[3], h3[0], h3[1], h3[2], h3[3]}, o[cbi], 0, 0, 0);
#undef TRRDG
            const bf16* SPc = WSP(bf16, A_SPREV) + ((size_t)(chunk * 4 + h) * 256 + cb * 32 + r32) * 128 + hi * 8;
            bf16x8 sf[8];
#pragma unroll
            for (int d0 = 0; d0 < 8; ++d0) sf[d0] = load8(SPc + d0 * 16);
#pragma unroll
            for (int d0 = 0; d0 < 8; ++d0) o[cbi] = __builtin_amdgcn_mfma_f32_32x32x16_bf16(qf[d0], sf[d0], o[cbi], 0, 0, 0);
        }
        float ss[16];
#pragma unroll
        for (int r = 0; r < 16; ++r) { float s = o[0][r] * o[0][r] + o[1][r] * o[1][r];
            s += __shfl_xor(s, 1); s += __shfl_xor(s, 2); s += __shfl_xor(s, 4); s += __shfl_xor(s, 8); s += __shfl_xor(s, 16); ss[r] = s; }
        if (r32 == 0) {
#pragma unroll
            for (int r = 0; r < 16; ++r) RS[(rb * 32 + crow(r, hi)) * 4 + cp] = ss[r]; }
        __syncthreads();
        float grv[16][2];
#pragma unroll
        for (int r = 0; r < 16; ++r)
#pragma unroll
            for (int cbi = 0; cbi < 2; ++cbi) grv[r][cbi] = mk::bf2f(PR[(size_t)(rb * 32 + crow(r, hi)) * NP + P_GR + h * 256 + (2 * cp + cbi) * 32 + r32]);
        const float go0 = gO[(2 * cp) * 32 + r32], go1 = gO[(2 * cp + 1) * 32 + r32];
#pragma unroll
        for (int r = 0; r < 16; ++r) { const int rr = rb * 32 + crow(r, hi); const f32x4 t = *(const f32x4*)(RS + rr * 4);
            const float rs = rsqrtf(((t.x + t.y) + (t.z + t.w)) * (1.f / 256.f) + EPS);
#pragma unroll
            for (int cbi = 0; cbi < 2; ++cbi) { const int col = (2 * cp + cbi) * 32 + r32;
                const float gr = grv[r][cbi];
                const float v = o[cbi][r] * rs * (cbi ? go1 : go0) * (gr * fast_sigmoid(gr));
                const float vn = __shfl_xor(v, 1);
                if ((r32 & 1) == 0) *(unsigned*)(WSP(bf16, A_OB) + (size_t)(row0 + rr) * 1024 + h * 256 + col) = cvtpk(v, vn); } }
    }
    __syncthreads();
#undef PK4G
}

__device__ __forceinline__ void phase_attn(const Frame& F0, unsigned char* lds_generic, int l) {
    const Frame F = relaunder(F0);
    for (int it = lnd_s((int)blockIdx.x); it < 256; it += F.G) {
        ArgsP a = get_args();
        const int h = it & 7, idx = it >> 3, mixer = idx >> 4, x = idx & 15;
        if (mixer == 0) {
            const att::HeadRef H{WSP(bf16_t, A_MQ) + (size_t)h * S * 192, WSP(bf16_t, A_MK) + (size_t)h * S * 192, WSP(bf16_t, A_MV) + (size_t)h * S * 128, WSP(bf16_t, A_OA) + h * 128, nullptr};
            att::Seam<true> Sm;
            att::prime<true>(H, x, (char*)lds_generic, Sm);
            for (int pass = 0; pass < 2; ++pass) att::block<true>(H, pass ? 31 - x : x, 31 - x, (char*)lds_generic, Sm);
        } else {
            const att::HeadRef H{WSP(bf16_t, A_FQ) + (size_t)h * S * 128, WSP(bf16_t, A_FK) + (size_t)h * S * 128, WSP(bf16_t, A_PROJ) + P_FV + h * 128, WSP(bf16_t, A_OC) + h * 128, WSP(float, A_FCUM) + (size_t)h * S};
            att::Seam<false> Sm;
            att::prime<false>(H, x, (char*)lds_generic, Sm);
            for (int pass = 0; pass < 2; ++pass) att::block<false>(H, pass ? 31 - x : x, 31 - x, (char*)lds_generic, Sm);
        }
    }
}
__device__ __forceinline__ void phase_gla_out(const Frame& F0, unsigned char* lds_generic, int l) {
    const Frame F = relaunder(F0);
    for (int it = lnd_s((int)blockIdx.x); it < 256; it += F.G) {
        ArgsP a = get_args();
        const int h = it & 7, idx = it >> 3;
        if ((idx >> 4) == 1) gla_out_unit(F, (char*)lds_generic, h * 16 + (idx & 15), l, a);
    }
}

__global__ void __launch_bounds__(NTHREADS, 2) mk_fwd(Args args_unused) {
    extern __shared__ __attribute__((aligned(16))) unsigned char lds[];
    Frame F;
    F.lds = (LAS unsigned char*)lds; F.MISC = (volatile LAS unsigned*)(F.lds + MISC_OFF);
    F.tid = threadIdx.x; F.lane = F.tid & 63; F.wave = __builtin_amdgcn_readfirstlane(F.tid >> 6);
    F.G = gridDim.x; { const int bx = blockIdx.x; F.vcu = (F.G % 8 == 0) ? (bx % 8) * (F.G / 8) + bx / 8 : bx; }
    for (int u = F.tid; u < (LDS_BYTES - LDSCTL_OFF) / 4; u += NTHREADS) ((LAS unsigned*)(F.lds + LDSCTL_OFF))[u] = 0u;
    __syncthreads();
    XcdBarrier bar;
    { ArgsP a = get_args(); F.ctl = (gu32*)(a->ws + WS_CTL); bar = xcd_barrier_post((unsigned*)(F.ctl + CW_BAR) + a->li * XCD_BAR_WORDS, F.MISC + 8); }
    int l_lo, l_hi, lo, hi, lazy;
    { ArgsP a = get_args(); const int p0 = a->pro_lo, p1 = a->pro_hi; l_lo = a->l_lo; l_hi = a->l_hi; lo = a->ph_lo; hi = a->ph_hi; lazy = a->pad;
      if (p0 == 0 && p1 > 0) rope_tables(F);
      prologue_weights(F, p0, p1);
      if (p0 == 0 && p1 > 0 && l_lo == 0 && l_hi > 0 && lo == 0) phase_rms0(F, a->in[0], WSP(bf16_t, A_XR), WSP(float, A_SSPA));
      if (p1 > p0 && l_hi > l_lo) xcd_barrier(bar); }

#define IN(k) (lo <= (k) && (k) < hi)
#define SEAM(k) do { if (!(l == l_hi - 1 && (k) == hi - 1)) xcd_barrier(bar); } while (0)
#define WB(off) ((const bf16_t*)(a->ws + WS_W + (size_t)l * WSTRIDE + (off)))
    for (int l = l_lo; l < l_hi; ++l) {
        if (IN(1)) { { ArgsP a = get_args();
            pg8::Gemm g{WSP(bf16_t, A_XR), WB(LW_WIN), S, NP, DM, DM, DM}; pg8::StaticOrder So; So.init(S, NP, lnd_s(F.G), lnd_s((int)blockIdx.x));
            { const int pm0 = first_unit_pm(NP / 256, lnd_s(F.G), lnd_s((int)blockIdx.x)); if (pm0 >= 0) fill_rstd_table(F, WSP(float, A_SSPA), pm0); }
            EpiStoreBf16 E{WSP(bf16_t, A_PROJ), NP, (const LAS float*)(F.lds + RT_OFF)};
            pg8::gemm_phase<EpiStoreBf16, pg8::StaticOrder, true, true>(F.lds + RING_OFF, g, So, E); }
            if (lazy && (int)blockIdx.x >= 256 - CV_W1) convert_slice(F, l + 1, CV_B1, (int)blockIdx.x - (256 - CV_W1), CV_W1, CV_R1);
            SEAM(1);
        }
        if (IN(2)) { phase_prep(F, l); SEAM(2); }
        if (IN(3)) { {
            gla_scan(F);
            pg8::StaticOrder So; So.init(S, 2048, lnd_s(F.G), lnd_s((int)blockIdx.x));
            { ArgsP a = get_args(); pg8::Gemm g{WSP(bf16_t, A_CQN), WB(LW_WUQ), S, 2048, 512, 1024, 512};
              EpiMlaQ E{WSP(bf16_t, A_MQ), a->in[8] + l * 192, WSP(float, A_CS)};
              pg8::gemm_phase<EpiMlaQ, pg8::StaticOrder, false, true>(F.lds + RING_OFF, g, So, E); }
            { ArgsP a = get_args(); pg8::Gemm g{WSP(bf16_t, A_CQN) + 512, WB(LW_WUKV), S, 2048, 512, 1024, 512};
              EpiMlaKV E{WSP(bf16_t, A_MK), WSP(bf16_t, A_MV), a->in[9] + l * 192, WSP(float, A_KRR), WSP(float, A_KRSS)};
              pg8::gemm_phase<EpiMlaKV, pg8::StaticOrder, false, true>(F.lds + RING_OFF, g, So, E); } }
            SEAM(3);
        }
        if (IN(4)) { { phase_attn(F, lds + RING_OFF, l); phase_gla_out(F, lds + RING_OFF, l); }
            if (lazy && (int)blockIdx.x >= 256 - CV_W4) convert_slice(F, l + 1, CV_B4, (int)blockIdx.x - (256 - CV_W4), CV_W4, CV_R4);
            SEAM(4); }
        if (IN(5)) { { ArgsP a = get_args();
            BranchOrder So; So.init(lnd_s(F.G), lnd_s((int)blockIdx.x));
            pg8::Gemm g{WSP(bf16_t, A_OA), WB(LW_WBR), 3 * S, 3 * DM, 1024, 1024, 1024};
            EpiGateMergeAll E{WSP(bf16_t, A_PROJ) + P_GATES, NP, WSP(bf16_t, A_MERGED), WSP(bf16_t, A_HN), DM};
            pg8::gemm_phase<EpiGateMergeAll, BranchOrder, true, true>(F.lds + RING_OFF, g, So, E); }
            SEAM(5);
        }
        if (IN(6)) { { ArgsP a = get_args();
            pg8::Gemm g{WSP(bf16_t, A_HN), WB(LW_WOUT), S, DM, DM, DM, DM}; pg8::StaticOrder So; So.init(S, DM, lnd_s(F.G), lnd_s((int)blockIdx.x));
            EpiResidNorm E{(l == 0) ? (const void*)a->in[0] : (const void*)WSP(bf16_t, A_XR), (void*)WSP(bf16_t, A_XR), DM, WSP(float, A_SSPB), 1, (l == 0) ? 0 : 1, 1};
            pg8::gemm_phase<EpiResidNorm, pg8::StaticOrder, false, true>(F.lds + RING_OFF, g, So, E); }
            SEAM(6);
        }
        if (IN(8)) { { ArgsP a = get_args();
            pg8::Gemm g{WSP(bf16_t, A_XR), WB(LW_WGU), S, 2 * FFH, DM, DM, DM}; pg8::StaticOrder So; So.init(S, 2 * FFH, lnd_s(F.G), lnd_s((int)blockIdx.x));
            { const int pm0 = first_unit_pm(2 * FFH / 256, lnd_s(F.G), lnd_s((int)blockIdx.x)); if (pm0 >= 0) fill_rstd_table(F, WSP(float, A_SSPB), pm0); }
            EpiSwiglu E{WSP(bf16_t, A_PROJ), FFH, (const LAS float*)(F.lds + RT_OFF)};
            pg8::gemm_phase<EpiSwiglu, pg8::StaticOrder, true, true>(F.lds + RING_OFF, g, So, E); }
            if (lazy && (int)blockIdx.x >= 256 - CV_W8) convert_slice(F, l + 1, CV_B8, (int)blockIdx.x - (256 - CV_W8), CV_W8, CV_R8);
            SEAM(8);
        }
        if (IN(9)) { { ArgsP a = get_args();
            pg8::Gemm g{WSP(bf16_t, A_PROJ), WB(LW_WDN), S, DM, FFH, FFH, FFH}; pg8::StaticOrder So; So.init(S, DM, lnd_s(F.G), lnd_s((int)blockIdx.x));
            EpiResidNorm E{(const void*)WSP(bf16_t, A_XR), (l + 1 < DEPTH) ? (void*)WSP(bf16_t, A_XR) : (void*)a->out, DM, WSP(float, A_SSPA), (l + 1 < DEPTH) ? 1 : 0, 1, (l + 1 < DEPTH) ? 1 : 0};
            pg8::gemm_phase<EpiResidNorm, pg8::StaticOrder, false, true>(F.lds + RING_OFF, g, So, E); }
            SEAM(9);
        }
    }
#undef IN
#undef SEAM
}

}

extern "C" void kernel_launch(void* const* d_in, const int* in_sizes, int n_in, void* d_out, int out_size, void* d_ws, size_t ws_size, hipStream_t stream) {
    static int grid = 0;
    if (grid == 0) {
        int dev = 0, cus = 0;
        if (n_in != 21 || out_size != S * DM || ws_size < mk::A_END) { fprintf(stderr, "kernel_launch: unexpected shapes / workspace (%d inputs, out %d, ws %zu < %zu)\n", n_in, out_size, ws_size, (size_t)mk::A_END); grid = -1; return; }
        if (hipGetDevice(&dev) != hipSuccess || hipDeviceGetAttribute(&cus, hipDeviceAttributeMultiprocessorCount, dev) != hipSuccess) { grid = -1; return; }
        if (hipFuncSetAttribute((const void*)mk::mk_fwd, hipFuncAttributeMaxDynamicSharedMemorySize, mk::LDS_BYTES) != hipSuccess) { fprintf(stderr, "hipFuncSetAttribute failed\n"); grid = -1; return; }
        int per_cu = 0;
        if (hipOccupancyMaxActiveBlocksPerMultiprocessor(&per_cu, (const void*)mk::mk_fwd, mk::NTHREADS, mk::LDS_BYTES) != hipSuccess || per_cu < 1) { fprintf(stderr, "occupancy query: %d blocks per CU\n", per_cu); (void)hipGetLastError(); }
        grid = cus;
        if (cus != 256) { fprintf(stderr, "kernel_launch: this kernel's unit deal (one 256x256 unit per workgroup in the N = 2048 GEMM phases, one row panel per workgroup in the wide ones) needs exactly 256 CUs, found %d\n", cus); grid = -1; return; }
    }
    if (grid < 0) return;
    (void)hipMemsetAsync((unsigned char*)d_ws + mk::WS_CTL, 0, mk::CTL_ZERO_BYTES, stream);
    mk::Args a{};
    for (int i = 0; i < 21; ++i) a.in[i] = (const float*)d_in[i];
    a.out = (float*)d_out; a.ws = (unsigned char*)d_ws;
    const int lazy = (grid == 256) ? 1 : 0;
    a.pro_lo = 0; a.pro_hi = lazy ? 1 : DEPTH; a.l_lo = 0; a.l_hi = DEPTH; a.ph_lo = 0; a.ph_hi = 10; a.li = 0; a.pad = lazy;
    mk::mk_fwd<<<dim3(grid), mk::NTHREADS, mk::LDS_BYTES, stream>>>(a);
}
```

```cpp
#include <hip/hip_runtime.h>
#include <cstdio>
#include <cstdint>

constexpr int S = 8192, DM = 2048, DEPTH = 4;
constexpr int D_IN = 13400, FFH = 5632;
constexpr int C_CQ = 0, C_CKV = 512, C_KR = 1024, C_GQ = 1088, C_GK = 1600, C_GV = 2112, C_GA = 3136, C_GR = 3152,
              C_FQ = 4176, C_FK = 5200, C_FV = 6224, C_FL = 7248, C_GATES = 7256;
constexpr float EPS = 1e-6f;
#define MK_WSTRIDE 149946368ull
constexpr int NP_G = 13568;


namespace pg8 {
#define PG8_LAS __attribute__((address_space(3)))
typedef unsigned short bf16_t;
typedef short bf16x8 __attribute__((ext_vector_type(8)));
typedef float f32x4 __attribute__((ext_vector_type(4)));
typedef unsigned u32x4 __attribute__((ext_vector_type(4)));
constexpr int BM = 256, BK = 64, HALF = 128, HTB = HALF * BK * 2  , STAGE_BYTES = 8 * HTB, NXCD = 8, WGM = 8;

__host__ __device__ __forceinline__ int lds_byte(int r, int c) { const int st = (r >> 4) * 2 + (c >> 5), rr = r & 15, cc = c & 31, ob = rr * 64 + cc * 2; return st * 1024 + (ob ^ (((ob >> 9) & 1) << 5)); }
__host__ __device__ __forceinline__ void stage_rc(int b, int& R, int& C) { const int st = b / 1024, sb = b % 1024, swz = sb ^ (((sb >> 9) & 1) << 5); R = (st >> 1) * 16 + swz / 64; C = (st & 1) * 32 + (swz % 64) / 2; }
__host__ __device__ __forceinline__ int perm32(int rho) { const int n = rho >> 4, i = rho & 15; return 8 * (i >> 2) + 4 * n + (i & 3); }

struct Unit { int pm, pn; };
struct Gemm { const bf16_t* A; const bf16_t* Bt; int M, N, K, lda, ldb; };

struct StaticOrder {
    int nM, nN, nwg, G, c;
    __host__ __device__ void init(int M, int N, int G_, int c_) { nM = M / BM; nN = N / BM; nwg = nM * nN; G = G_; c = c_; }
    __host__ __device__ bool next(int i, Unit& u) const {
        const long L = (long)i * G + c; if (L >= nwg) return false;
        int wgid = (int)L; { const int q = nwg / NXCD, r = nwg % NXCD, xcd = wgid % NXCD, off = wgid / NXCD; wgid = (xcd < r ? xcd * (q + 1) : r * (q + 1) + (xcd - r) * q) + off; }
        const int nig = WGM * nN, gid = wgid / nig, fm = gid * WGM, gsz = (nM - fm) < WGM ? (nM - fm) : WGM;
        u.pm = fm + ((wgid % nig) % gsz); u.pn = (wgid % nig) / gsz; return true;
    }
    __device__ __forceinline__ void a_ready(const Unit&) const {}
    __device__ __forceinline__ void done(const Unit&) const {}
};

__device__ __forceinline__ unsigned cvt_pk_bf16(float lo, float hi) { unsigned r; asm volatile("v_cvt_pk_bf16_f32 %0, %1, %2" : "=v"(r) : "v"(lo), "v"(hi)); return r; }
template <class Epi, class Sched, bool ALIGN_EPI = false, bool SP2 = false>
__device__ __forceinline__ void gemm_phase(PG8_LAS unsigned char* lds, const Gemm g, const Sched& S, const Epi& E) {
    int tid_ = threadIdx.x; asm volatile("" : "+v"(tid_));
    const int tid = tid_, wid = __builtin_amdgcn_readfirstlane(tid >> 6), lane = tid & 63, wr = wid >> 2, wc = wid & 3, fr = lane & 15, fq = lane >> 4;
    const int K = g.K, nt = K / BK;
    unsigned voffA[2], voffB[2];
#pragma unroll
    for (int i = 0; i < 2; ++i) { int R, C; stage_rc(tid * 16 + i * 8192, R, C); const int Rb = Epi::PERM ? ((R & ~31) + perm32(R & 31)) : R;
        voffA[i] = (unsigned)(R * g.lda + C) * 2u; voffB[i] = (unsigned)(Rb * g.ldb + C) * 2u; }
    const size_t kstep = (size_t)(BK * 2);
    const size_t hstepA = (size_t)HALF * g.lda * 2, hstepB = (size_t)HALF * g.ldb * 2;
    const size_t tstepA = 2 * hstepA, tstepB = 2 * hstepB;
    const unsigned ldsw = (unsigned)wid * 1024u;
    const int aoff = lds_byte(wr * 64 + fr, fq * 8), boff = lds_byte(wc * 32 + fr, fq * 8);
#define PG8_SA(b, h) (((b) * 2 + (h)) * HTB)
#define PG8_SB(b, h) ((4 + (b) * 2 + (h)) * HTB)
#define PG8_STAGE(bufoff, gbase, voff) do { _Pragma("unroll") for (int _i = 0; _i < 2; ++_i) \
        __builtin_amdgcn_global_load_lds((const unsigned*)((const char*)(gbase) + (voff)[_i]), (PG8_LAS unsigned*)(lds + (bufoff) + ldsw + _i * 8192), 16, 0, 0); } while (0)
#define PG8_LDA(dst, b, h) do { _Pragma("unroll") for (int m = 0; m < 4; ++m) _Pragma("unroll") for (int k = 0; k < 2; ++k) dst[m][k] = *(const PG8_LAS bf16x8*)(lds + PG8_SA(b, h) + aoff + m * 2048 + k * 1024); } while (0)
#define PG8_LDB(dst, b, h) do { _Pragma("unroll") for (int n = 0; n < 2; ++n) _Pragma("unroll") for (int k = 0; k < 2; ++k) dst[n][k] = *(const PG8_LAS bf16x8*)(lds + PG8_SB(b, h) + boff + n * 2048 + k * 1024); } while (0)
#define PG8_MMA(ai, bj, At, Bt) do { __builtin_amdgcn_s_setprio(1); _Pragma("unroll") for (int m = 0; m < 4; ++m) _Pragma("unroll") for (int n = 0; n < 2; ++n) _Pragma("unroll") for (int k = 0; k < 2; ++k) \
        acc[ai][bj][m][n] = __builtin_amdgcn_mfma_f32_16x16x32_bf16(Bt[n][k], At[m][k], acc[ai][bj][m][n], 0, 0, 0); __builtin_amdgcn_s_setprio(0); } while (0)
#define PG8_WAIT_V(n) asm volatile("s_waitcnt vmcnt(" #n ")" ::: "memory")
#define PG8_WAIT_L(n) asm volatile("s_waitcnt lgkmcnt(" #n ")" ::: "memory")
#define PG8_BAR __builtin_amdgcn_s_barrier()
#define PG8_SCHED __builtin_amdgcn_sched_barrier(0)
    Unit cur, nxt; int ui = 0;
    if (!S.next(0, cur)) return;
    f32x4 acc[2][2][4][2];
#pragma unroll
    for (int a = 0; a < 2; ++a)
#pragma unroll
        for (int b = 0; b < 2; ++b)
#pragma unroll
            for (int m = 0; m < 4; ++m)
#pragma unroll
                for (int n = 0; n < 2; ++n) acc[a][b][m][n] = (f32x4){0.f, 0.f, 0.f, 0.f};
    bf16x8 At[4][2], B0[2][2], B1[2][2];
    const char* cA = (const char*)g.A + (size_t)cur.pm * tstepA; const char* cB = (const char*)g.Bt + (size_t)cur.pn * tstepB;
    S.a_ready(cur);
    if constexpr (SP2) {
        PG8_STAGE(PG8_SB(0, 0), cB, voffB); PG8_STAGE(PG8_SB(0, 1), cB + hstepB, voffB); PG8_STAGE(PG8_SA(0, 0), cA, voffA); PG8_STAGE(PG8_SA(0, 1), cA + hstepA, voffA);
        if (wr == 1) PG8_BAR;
        PG8_WAIT_V(2); PG8_BAR;
        PG8_STAGE(PG8_SB(1, 0), cB + kstep, voffB); PG8_STAGE(PG8_SA(1, 0), cA + kstep, voffA); PG8_STAGE(PG8_SB(1, 1), cB + hstepB + kstep, voffB);
        PG8_WAIT_V(6); PG8_BAR;
    } else {
        PG8_STAGE(PG8_SB(0, 0), cB, voffB); PG8_STAGE(PG8_SA(0, 0), cA, voffA); PG8_STAGE(PG8_SB(0, 1), cB + hstepB, voffB); PG8_STAGE(PG8_SA(0, 1), cA + hstepA, voffA);
        if (wr == 1) PG8_BAR;
        PG8_WAIT_V(4); PG8_BAR;
        PG8_STAGE(PG8_SB(1, 0), cB + kstep, voffB); PG8_STAGE(PG8_SA(1, 0), cA + kstep, voffA); PG8_STAGE(PG8_SB(1, 1), cB + hstepB + kstep, voffB);
        PG8_WAIT_V(6); PG8_BAR;
    }
    for (;;) {
        const bool has_next = S.next(ui + 1, nxt);
        const char* nA = has_next ? (const char*)g.A + (size_t)nxt.pm * tstepA : cA; const char* nB = has_next ? (const char*)g.Bt + (size_t)nxt.pn * tstepB : cB;
        for (int t = 0; t < nt; t += 2) {
            const bool last = (t == nt - 2);
            const char* a1 = cA + (size_t)(t + 1) * kstep;
            const char* a2 = last ? nA : cA + (size_t)(t + 2) * kstep; const char* b2 = last ? nB : cB + (size_t)(t + 2) * kstep;
            const char* a3 = a2 + kstep; const char* b3 = b2 + kstep;
            if (last && has_next) S.a_ready(nxt);
            if constexpr (SP2) {
            PG8_LDB(B0, 0, 0); PG8_LDB(B1, 0, 1); PG8_SCHED; PG8_LDA(At, 0, 0); PG8_STAGE(PG8_SA(1, 1), a1 + hstepA, voffA);
            PG8_WAIT_V(8); PG8_WAIT_L(0); PG8_BAR; PG8_MMA(0, 0, At, B0); PG8_MMA(0, 1, At, B1); PG8_BAR; PG8_SCHED;
            PG8_LDA(At, 0, 1); PG8_STAGE(PG8_SB(0, 0), b2, voffB); PG8_STAGE(PG8_SB(0, 1), b2 + hstepB, voffB); PG8_STAGE(PG8_SA(0, 0), a2, voffA);
            PG8_WAIT_V(8); PG8_WAIT_L(0); PG8_BAR; PG8_MMA(1, 0, At, B0); PG8_MMA(1, 1, At, B1); PG8_BAR; PG8_SCHED;
            PG8_LDB(B0, 1, 0); PG8_LDB(B1, 1, 1); PG8_SCHED; PG8_LDA(At, 1, 0); PG8_STAGE(PG8_SA(0, 1), a2 + hstepA, voffA);
            PG8_WAIT_V(8); PG8_WAIT_L(0); PG8_BAR; PG8_MMA(0, 0, At, B0); PG8_MMA(0, 1, At, B1); PG8_BAR; PG8_SCHED;
            PG8_LDA(At, 1, 1); PG8_STAGE(PG8_SB(1, 0), b3, voffB); PG8_STAGE(PG8_SB(1, 1), b3 + hstepB, voffB); PG8_STAGE(PG8_SA(1, 0), a3, voffA);
            PG8_WAIT_V(8); PG8_WAIT_L(0); PG8_BAR; PG8_MMA(1, 0, At, B0); PG8_MMA(1, 1, At, B1); PG8_BAR; PG8_SCHED;
            } else {
            PG8_LDB(B0, 0, 0); PG8_SCHED; PG8_LDA(At, 0, 0); PG8_STAGE(PG8_SA(1, 1), a1 + hstepA, voffA);
            PG8_WAIT_L(8); PG8_BAR; PG8_WAIT_L(0); PG8_MMA(0, 0, At, B0); PG8_BAR; PG8_SCHED;
            PG8_LDB(B1, 0, 1); PG8_STAGE(PG8_SB(0, 0), b2, voffB);
            PG8_BAR; PG8_WAIT_L(0); PG8_MMA(0, 1, At, B1); PG8_BAR;
            PG8_LDA(At, 0, 1); PG8_STAGE(PG8_SA(0, 0), a2, voffA);
            PG8_BAR; PG8_WAIT_L(0); PG8_MMA(1, 0, At, B0); PG8_BAR; PG8_SCHED;
            PG8_STAGE(PG8_SB(0, 1), b2 + hstepB, voffB);
            PG8_WAIT_V(6); PG8_BAR; PG8_MMA(1, 1, At, B1); PG8_BAR;
            PG8_LDB(B0, 1, 0); PG8_SCHED; PG8_LDA(At, 1, 0); PG8_STAGE(PG8_SA(0, 1), a2 + hstepA, voffA);
            PG8_WAIT_L(8); PG8_BAR; PG8_WAIT_L(0); PG8_MMA(0, 0, At, B0); PG8_BAR; PG8_SCHED;
            PG8_LDB(B1, 1, 1); PG8_STAGE(PG8_SB(1, 0), b3, voffB);
            PG8_BAR; PG8_WAIT_L(0); PG8_MMA(0, 1, At, B1); PG8_BAR;
            PG8_LDA(At, 1, 1); PG8_STAGE(PG8_SA(1, 0), a3, voffA);
            PG8_BAR; PG8_WAIT_L(0); PG8_MMA(1, 0, At, B0); PG8_BAR; PG8_SCHED;
            PG8_STAGE(PG8_SB(1, 1), b3 + hstepB, voffB);
            PG8_WAIT_V(6); PG8_BAR; PG8_MMA(1, 1, At, B1); PG8_BAR;
            }
        }
        if constexpr (ALIGN_EPI) { if (wr == 0) PG8_BAR; }
        if constexpr (!Epi::AFTER_DRAIN) { E(acc, cur, wr, wc, fr, fq); S.done(cur); }
        if (!has_next) break;
#pragma unroll
        for (int a = 0; a < 2; ++a)
#pragma unroll
            for (int b = 0; b < 2; ++b)
#pragma unroll
                for (int m = 0; m < 4; ++m)
#pragma unroll
                    for (int n = 0; n < 2; ++n) acc[a][b][m][n] = (f32x4){0.f, 0.f, 0.f, 0.f};
        cur = nxt; cA = nA; cB = nB; ++ui;
        if constexpr (ALIGN_EPI) { if (wr == 1) PG8_BAR; }
    }
    PG8_WAIT_V(0);
    if constexpr (!ALIGN_EPI) { if (wr == 0) PG8_BAR; }
    PG8_BAR;
    if constexpr (Epi::AFTER_DRAIN) { E.fused(acc, cur, wr, wc, fr, fq, lds, wid, lane); S.done(cur); }
#undef PG8_SA
#undef PG8_SB
#undef PG8_STAGE
#undef PG8_LDA
#undef PG8_LDB
#undef PG8_MMA
#undef PG8_WAIT_V
#undef PG8_WAIT_L
#undef PG8_BAR
#undef PG8_SCHED
}
}

#define GAS __attribute__((address_space(1)))
#define LAS __attribute__((address_space(3)))
#define XB_TMO      128
#define XB_XCNT(j)  (256  + 64 * (j))
#define XB_XSUB(j)  (1280 + 64 * (j))
#define XB_XGEN(j)  (2304 + 64 * (j))
#define XB_TOP      3328
#define XB_TOPGEN   3392
#define XCD_BAR_WORDS 3456
#define XB_SPIN_CAP (1u << 18)

__device__ __forceinline__ unsigned xb_ld(unsigned* p)              { return __hip_atomic_load(p, __ATOMIC_RELAXED, __HIP_MEMORY_SCOPE_AGENT); }
__device__ __forceinline__ unsigned xb_add(unsigned* p, unsigned v) { return __hip_atomic_fetch_add(p, v, __ATOMIC_RELAXED, __HIP_MEMORY_SCOPE_AGENT); }
__device__ __forceinline__ unsigned xb_xcc_id() { return (unsigned)__builtin_amdgcn_s_getreg((3 << 11) | 20) & 0xFu; }
#define XB_SPIN(cond, bar) do { unsigned _sp = 0; while (cond) { __builtin_amdgcn_s_sleep(1); \
    if ((++_sp & 255u) == 0u) { if (xb_ld(&(bar)[XB_TMO])) break; if (_sp > XB_SPIN_CAP) { atomicAdd(&(bar)[XB_TMO], 1u); break; } } } } while (0)

struct XcdBarrier {
    unsigned* bar; unsigned x;
    volatile LAS unsigned* st;
};

__device__ __forceinline__ XcdBarrier xcd_barrier_post(unsigned* bar, volatile LAS unsigned* st) {
    XcdBarrier b; b.bar = bar; b.x = xb_xcc_id(); b.st = st;
    if (threadIdx.x == 0) (void)xb_add(&bar[XB_XCNT(b.x)], 1u);
    return b;
}
__device__ __forceinline__ void xcd_barrier_complete(unsigned* bar, unsigned x, unsigned& nloc, unsigned& nx) {
    const unsigned G = gridDim.x * gridDim.y * gridDim.z;
    unsigned sum, cnt, mine, sp = 0u;
    for (;;) {
        sum = 0u; cnt = 0u; mine = 0u;
#pragma unroll
        for (unsigned j = 0; j < 16; ++j) { const unsigned c = xb_ld(&bar[XB_XCNT(j)]); sum += c; cnt += (c > 0u) ? 1u : 0u; mine = (j == x) ? c : mine; }
        if (sum == G) break;
        __builtin_amdgcn_s_sleep(1);
        if ((++sp & 255u) == 0u) { if (xb_ld(&bar[XB_TMO])) break; if (sp > XB_SPIN_CAP) { atomicAdd(&bar[XB_TMO], 1u); break; } }
    }
    nloc = mine > 0u ? mine : 1u; nx = cnt > 0u ? cnt : 1u;
}

__device__ __forceinline__ void xcd_barrier(const XcdBarrier& b) {
    asm volatile("s_waitcnt vmcnt(0)" ::: "memory");
    __syncthreads();
    if (threadIdx.x == 0) {
        unsigned* bar = b.bar;
        __builtin_amdgcn_s_waitcnt(0);
        unsigned nloc = b.st[0], nx = b.st[1];
        if (nloc == 0u) { xcd_barrier_complete(bar, b.x, nloc, nx); b.st[0] = nloc; b.st[1] = nx; }
        const unsigned old = xb_add(&bar[XB_XSUB(b.x)], 1u);
        const unsigned gen = old / nloc;
        if (old + 1u == (gen + 1u) * nloc) {
            __builtin_amdgcn_fence(__ATOMIC_RELEASE, "agent");
            asm volatile("s_waitcnt vmcnt(0)" ::: "memory");
            const unsigned og = xb_add(&bar[XB_TOP], 1u);
            const unsigned tg = og / nx;
            if (og + 1u == (tg + 1u) * nx) xb_add(&bar[XB_TOPGEN], 1u);
            else XB_SPIN(xb_ld(&bar[XB_TOPGEN]) == tg, bar);
            __builtin_amdgcn_fence(__ATOMIC_ACQUIRE, "agent");
            xb_add(&bar[XB_XGEN(b.x)], 1u);
            asm volatile("s_waitcnt vmcnt(0)" ::: "memory");
        } else {
            XB_SPIN(xb_ld(&bar[XB_XGEN(b.x)]) == gen, bar);
            __builtin_amdgcn_fence(__ATOMIC_ACQUIRE, "agent");
            asm volatile("s_waitcnt vmcnt(0)" ::: "memory");
        }
    }
    __syncthreads();
}

namespace att {
__device__ __forceinline__ int mk_lnd_v(int v) { asm volatile("" : "+v"(v)); return v; }
typedef short bf16x8 __attribute__((ext_vector_type(8)));
typedef short s16x4 __attribute__((ext_vector_type(4)));
typedef float f32x16 __attribute__((ext_vector_type(16)));
typedef float f32x4 __attribute__((ext_vector_type(4)));
typedef unsigned u32x4 __attribute__((ext_vector_type(4)));
typedef unsigned short bf16;
constexpr int NW = 8, QBLK = 32, KVBLK = 64, QB = NW * QBLK;
constexpr int SHM_V = KVBLK * 128 * 2, SHM_K = 16 * 1152, SHM_KR = 8 * 1152;
constexpr int L_V = 0, L_K = 2 * SHM_V, L_KR = L_K + 2 * SHM_K, L_WS = L_KR + 2 * SHM_KR, L_X = L_WS + NW * 64 * 4;
constexpr int L_FB = L_X + 32768, L_END = L_X + 65536;
static_assert(L_END <= 163840 - 512, "attention LDS");
constexpr float THR = 8.f;
#define KLAY(row, chunk) ((chunk) * 1152 + (((chunk) & 7) + (row)) * 16)
#define SBAR() __builtin_amdgcn_sched_barrier(0)
__device__ __forceinline__ int v_st(int k, int c) { const int kk = (k & ~0xC) | ((k & 4) << 1) | ((k & 8) >> 1); return ((kk >> 3) * 4 + (c >> 5)) * 512 + ((kk & 7) * 32 + (c & 31)) * 2; }
__device__ __forceinline__ int v_rd_base(int lane) { return ((lane & 3) << 3) | (((lane >> 2) & 3) << 6) | (((lane >> 4) & 1) << 5) | (((lane >> 5) & 1) << 8); }
constexpr int v_rd_off(int d0, int ks, int half) { return d0 * 512 + ks * 4096 + half * 2048; }
__device__ __forceinline__ int crow(int r, int hi) { return (r & 3) + 8 * (r >> 2) + 4 * hi; }
__device__ __forceinline__ unsigned cvtpk(float lo, float hi) { unsigned r; asm volatile("v_cvt_pk_bf16_f32 %0, %1, %2" : "=v"(r) : "v"(lo), "v"(hi)); return r; }
__device__ __forceinline__ bf16x8 load8(const bf16* p) { return *reinterpret_cast<const bf16x8*>(p); }
typedef float f32x2c_t __attribute__((ext_vector_type(2))); typedef __bf16 bf16x2c_t __attribute__((ext_vector_type(2)));
__device__ __forceinline__ unsigned cvtpk_c(float lo, float hi) { f32x2c_t v = {lo, hi}; bf16x2c_t b = __builtin_convertvector(v, bf16x2c_t); return __builtin_bit_cast(unsigned, b); }

__device__ __forceinline__ void mask_tile(f32x16& p0, f32x16& p1, int dq) {
    const float NEG = -__builtin_inff();
#pragma unroll
    for (int r = 0; r < 16; ++r) {
        const int c = (r & 3) + 8 * (r >> 2);
        if (dq - c < 0) p0[r] = NEG;
        if (dq - c - 32 < 0) p1[r] = NEG;
    }
}
template <bool MLA>
__device__ __forceinline__ void partialSM(f32x16& p0, f32x16& p1, float& m_reg, float& mn, float& alpha) {
    constexpr float SCALE = MLA ? 0.07216878364870322f : 0.08838834764831845f;
    float pmax = p0[0];
#pragma unroll
    for (int r = 1; r < 16; ++r) pmax = fmaxf(pmax, p0[r]);
#pragma unroll
    for (int r = 0; r < 16; ++r) pmax = fmaxf(pmax, p1[r]);
    { auto rr = __builtin_amdgcn_permlane32_swap(__float_as_uint(pmax), __float_as_uint(pmax), false, false);
      pmax = fmaxf(__uint_as_float(rr[0]), __uint_as_float(rr[1])); }
    constexpr float C2 = 1.4426950408889634f * SCALE;
    if (__builtin_expect(__all((pmax - m_reg) * SCALE <= THR), 1)) { mn = m_reg; alpha = 1.f; }
    else { mn = fmaxf(m_reg, pmax); alpha = __builtin_amdgcn_exp2f((m_reg - mn) * C2); m_reg = mn; }
    const float mnL = -mn * C2;
#pragma unroll
    for (int r = 0; r < 16; ++r) p0[r] = fmaf(p0[r], C2, mnL);
#pragma unroll
    for (int r = 0; r < 16; ++r) p1[r] = fmaf(p1[r], C2, mnL);
#pragma unroll
    for (int r = 0; r < 16; ++r) p0[r] = __builtin_amdgcn_exp2f(p0[r]);
}
#define PK4(P, B_, OUT) do { unsigned a0 = cvtpk(P[B_+0], P[B_+1]), a1 = cvtpk(P[B_+2], P[B_+3]);                          \
        unsigned b0 = cvtpk(P[B_+4], P[B_+5]), b1 = cvtpk(P[B_+6], P[B_+7]);                                             \
        auto r0 = __builtin_amdgcn_permlane32_swap(a0, b0, false, false); auto r1 = __builtin_amdgcn_permlane32_swap(a1, b1, false, false); \
        u32x4 w = {r0[0], r1[0], r0[1], r1[1]}; OUT = *reinterpret_cast<bf16x8*>(&w); } while (0)
__device__ __forceinline__ void finishSM(f32x16& p0, f32x16& p1, float alpha, float& l_reg, bf16x8& pa0, bf16x8& pa1, bf16x8& pa2, bf16x8& pa3) {
#pragma unroll
    for (int r = 0; r < 16; ++r) p1[r] = __builtin_amdgcn_exp2f(p1[r]);
    float ps = 0;
#pragma unroll
    for (int r = 0; r < 16; ++r) ps += p0[r];
#pragma unroll
    for (int r = 0; r < 16; ++r) ps += p1[r];
    { auto rr = __builtin_amdgcn_permlane32_swap(__float_as_uint(ps), __float_as_uint(ps), false, false);
      ps = __uint_as_float(rr[0]) + __uint_as_float(rr[1]); }
    l_reg = l_reg * alpha + ps;
    PK4(p0, 0, pa0); PK4(p0, 8, pa1); PK4(p1, 0, pa2); PK4(p1, 8, pa3);
}
template <int KB, bool MLA, bool BIAS>
__device__ __forceinline__ void qkt(f32x16& p0, f32x16& p1, const char* lds, int r32, int hi, const bf16x8* qr, int krb, int qrb, int fbb) {
    if constexpr (BIAS) {
        const char* fbp = lds + L_FB + fbb;
#pragma unroll
        for (int g_ = 0; g_ < 4; ++g_) { const f32x4 b0_ = *(const f32x4*)(fbp + g_ * 32), b1_ = *(const f32x4*)(fbp + 128 + g_ * 32);
#pragma unroll
            for (int e_ = 0; e_ < 4; ++e_) { p0[4 * g_ + e_] = b0_[e_]; p1[4 * g_ + e_] = b1_[e_]; } }
    } else { p0 = f32x16{}; p1 = f32x16{}; }
    const char* K_lds = lds + L_K;
    const char* kbase = K_lds + KB * SHM_K + r32 * 16 + hi * 1168;
    constexpr int NQR = MLA ? 12 : 8;
    const char* qq = lds + L_X + qrb;
#pragma unroll
    for (int d0 = 0; d0 < 8; ++d0) {
        bf16x8 b0 = *reinterpret_cast<const bf16x8*>(kbase + KLAY(0, 2 * d0));
        bf16x8 b1 = *reinterpret_cast<const bf16x8*>(kbase + KLAY(32, 2 * d0));
        bf16x8 q; if (d0 < NQR) q = qr[d0]; else q = *reinterpret_cast<const bf16x8*>(qq + (d0 - NQR) * 1024);
        p0 = __builtin_amdgcn_mfma_f32_32x32x16_bf16(b0, q, p0, 0, 0, 0);
        p1 = __builtin_amdgcn_mfma_f32_32x32x16_bf16(b1, q, p1, 0, 0, 0); }
    if constexpr (MLA) {
        const char* kr = lds + L_KR + KB * SHM_KR + krb;
#pragma unroll
        for (int dr = 0; dr < 4; ++dr) {
            bf16x8 b0 = *reinterpret_cast<const bf16x8*>(kr + KLAY(0, 2 * dr));
            bf16x8 b1 = *reinterpret_cast<const bf16x8*>(kr + KLAY(32, 2 * dr));
            bf16x8 q; if (8 + dr < NQR) q = qr[8 + dr]; else q = *reinterpret_cast<const bf16x8*>(qq + (8 + dr - NQR) * 1024);
            p0 = __builtin_amdgcn_mfma_f32_32x32x16_bf16(b0, q, p0, 0, 0, 0);
            p1 = __builtin_amdgcn_mfma_f32_32x32x16_bf16(b1, q, p1, 0, 0, 0); }
    }
}
template <int VB>
__device__ __forceinline__ void pv_tile(f32x16* o, int vb0, bf16x8 pa0, bf16x8 pa1, bf16x8 pa2, bf16x8 pa3) {
#define TRRD(dst, off) asm volatile("ds_read_b64_tr_b16 %0, %1 offset:%2" : "=&v"(dst) : "v"(vb0), "i"(off) : "memory")
#define PV_D0(d0) do { s16x4 l0, l1, l2, l3, h0, h1, h2, h3; constexpr int b_ = VB * SHM_V + v_rd_off(d0, 0, 0);   \
        TRRD(l0, b_); TRRD(h0, b_ + 2048); TRRD(l1, b_ + 4096); TRRD(h1, b_ + 6144); TRRD(l2, b_ + 8192); TRRD(h2, b_ + 10240); TRRD(l3, b_ + 12288); TRRD(h3, b_ + 14336); \
        asm volatile("s_waitcnt lgkmcnt(0)" ::: "memory"); SBAR();   \
        o[d0] = __builtin_amdgcn_mfma_f32_32x32x16_bf16(pa0, (bf16x8){l0[0], l0[1], l0[2], l0[3], h0[0], h0[1], h0[2], h0[3]}, o[d0], 0, 0, 0);   \
        o[d0] = __builtin_amdgcn_mfma_f32_32x32x16_bf16(pa1, (bf16x8){l1[0], l1[1], l1[2], l1[3], h1[0], h1[1], h1[2], h1[3]}, o[d0], 0, 0, 0);   \
        o[d0] = __builtin_amdgcn_mfma_f32_32x32x16_bf16(pa2, (bf16x8){l2[0], l2[1], l2[2], l2[3], h2[0], h2[1], h2[2], h2[3]}, o[d0], 0, 0, 0);   \
        o[d0] = __builtin_amdgcn_mfma_f32_32x32x16_bf16(pa3, (bf16x8){l3[0], l3[1], l3[2], l3[3], h3[0], h3[1], h3[2], h3[3]}, o[d0], 0, 0, 0); } while (0)
    PV_D0(0); PV_D0(1); PV_D0(2); PV_D0(3);
#undef PV_D0
#undef TRRD
}

struct HeadRef { const bf16* Q; const bf16* K; const bf16* V; bf16* O; const float* FS; };
template <bool MLA> struct Seam { bf16x8 qr[MLA ? 12 : 8]; bf16x8 st_v0, st_v1, st_k0, st_k1; bf16x8 st_kr; bf16x8 ql[1]; };
template <bool MLA> struct Geo {
    static constexpr int QP = MLA ? 192 : 128, KP = MLA ? 192 : 128, VP = MLA ? 128 : NP_G, OP = 1024;
};
#define VMW() asm volatile("s_waitcnt vmcnt(0)" ::: "memory")
#define VMWN(n) asm volatile("s_waitcnt vmcnt(%0)" :: "i"(n) : "memory")
#define SLOAD_H(Kp, Vp, k0) do { S.st_v0 = load8((Vp) + (size_t)((k0) + sr) * G::VP + sc); S.st_v1 = load8((Vp) + (size_t)((k0) + 32 + sr) * G::VP + sc);              \
                         S.st_k0 = load8((Kp) + (size_t)((k0) + sr) * G::KP + sc); S.st_k1 = load8((Kp) + (size_t)((k0) + 32 + sr) * G::KP + sc);              \
                         if constexpr (MLA) S.st_kr = load8((Kp) + (size_t)((k0) + (tid >> 3)) * G::KP + 128 + (tid & 7) * 8); } while (0)
#define SWRITE_HK(bf) do { *(bf16x8*)(K_lds + (bf) * SHM_K + kws) = S.st_k0; *(bf16x8*)(K_lds + (bf) * SHM_K + kws1) = S.st_k1;  \
                           if constexpr (MLA) *(bf16x8*)(lds + L_KR + (bf) * SHM_KR + krw) = S.st_kr; } while (0)
#define SWRITE_HV(bf) do { *(bf16x8*)(V_lds + (bf) * SHM_V + vst0) = S.st_v0; *(bf16x8*)(V_lds + (bf) * SHM_V + vst1) = S.st_v1; } while (0)
#define SWRITE_H(bf) do { SWRITE_HV(bf); SWRITE_HK(bf); } while (0)
#define QLOAD_R(ref) do { _Pragma("unroll") for (int d0 = 0; d0 < NQR; ++d0) S.qr[d0] = load8((ref) + (size_t)(wid * QBLK + r32) * G::QP + d0 * 16 + hi * 8); } while (0)
#define QLOAD_L(ref) do { _Pragma("unroll") for (int dr = 0; dr < NQLDS; ++dr) S.ql[dr] = load8((ref) + (size_t)(wid * QBLK + r32) * G::QP + NQR * 16 + dr * 16 + hi * 8); } while (0)
#define QROPE_TO_LDS() do { _Pragma("unroll") for (int dr = 0; dr < NQLDS; ++dr) *(bf16x8*)(lds + L_X + qrb + dr * 1024) = S.ql[dr]; } while (0)

template <bool MLA>
__device__ __forceinline__ void prime(const HeadRef& H, int qb_cur, char* lds, Seam<MLA>& S) {
    typedef Geo<MLA> G;
    const int tid = mk_lnd_v(threadIdx.x), wid = __builtin_amdgcn_readfirstlane(tid >> 6), lane = tid & 63, r32 = lane & 31, hi = lane >> 5;
    const int sr = tid >> 4, sc = (tid & 15) * 8, kws = KLAY(sr, tid & 15), kws1 = KLAY(32 + sr, tid & 15); char* K_lds = lds + L_K;
    constexpr int NQLDS = 0, NQR = MLA ? 12 : 8;
    const int krw = KLAY(tid >> 3, tid & 7), qrb = wid * (NQLDS * 1024) + lane * 16;
    const bf16* Qc = H.Q + (size_t)qb_cur * QB * G::QP;
    QLOAD_R(Qc); QLOAD_L(Qc);
    SLOAD_H(H.K, H.V, 0); VMW(); SWRITE_HK(0); QROPE_TO_LDS();
    __syncthreads();
}
template <bool MLA>
__device__ __forceinline__ void block(const HeadRef& H, int qb_cur, int qb_nxt, char* lds, Seam<MLA>& S) {
    typedef Geo<MLA> G;
    constexpr bool BIAS = !MLA; constexpr int NQLDS = 0, NQR = MLA ? 12 : 8;
    const int tid = mk_lnd_v(threadIdx.x), wid = __builtin_amdgcn_readfirstlane(tid >> 6), lane = tid & 63, r32 = lane & 31, hi = lane >> 5;
    const int P0 = qb_cur * QB;
    const int NT = (P0 + QB - 1) / KVBLK + 1;
    const int qlo = P0 + wid * QBLK, qm = qlo + r32 - 4 * hi;
    char* V_lds = lds + L_V; char* K_lds = lds + L_K;
    float* ws = (float*)(lds + L_WS) + wid * 64; float* li_l = ws, * al_l = ws + 32;
    float m_reg = -1e30f, l_reg = 0; f32x16 o[4] = {};
    const int sr = tid >> 4, sc = (tid & 15) * 8, vst0 = v_st(sr, sc), vst1 = v_st(32 + sr, sc), kws = KLAY(sr, tid & 15), kws1 = KLAY(32 + sr, tid & 15);
    const int krw = KLAY(tid >> 3, tid & 7), qrb = wid * (NQLDS * 1024) + lane * 16, krb = r32 * 16 + hi * 1168, fbh = hi * 16;
    const int vb0 = (int)(uintptr_t)V_lds + v_rd_base(lane);
    const bf16* Kh = H.K; const bf16* Vh = H.V;
    if constexpr (BIAS) {
        const int nk4 = (P0 + QB) / 4;
        for (int i = tid; i < nk4; i += NW * 64) *(f32x4*)(lds + L_FB + i * 16) = -*(const f32x4*)(H.FS + i * 4);
        __syncthreads();
    }
#define RESC(a) do { if (__any((a) < 1.f)) { if (hi == 0) al_l[r32] = (a); asm volatile("s_waitcnt lgkmcnt(0)" ::: "memory");              \
                     for (int d_ = 0; d_ < 4; ++d_) for (int r = 0; r < 16; ++r) o[d_][r] *= al_l[crow(r, hi)]; } } while (0)
#define KBASE(t) ((t) * KVBLK)
#define MASKT(P0_, P1_, t) do { const int kb_ = KBASE(t); if (kb_ + KVBLK - 1 > qlo) mask_tile(P0_, P1_, qm - kb_); } while (0)
    f32x16 pA0, pA1, pB0, pB1; float mnA, mnB, alA, alB; bf16x8 pa0, pa1, pa2, pa3;
    SWRITE_HV(0); SBAR();
    if (NT > 1) { SLOAD_H(Kh, Vh, KBASE(1)); }
    SBAR(); qkt<0, MLA, BIAS>(pA0, pA1, lds, r32, hi, S.qr, krb, qrb, fbh + KBASE(0) * 4);
    MASKT(pA0, pA1, 0); partialSM<MLA>(pA0, pA1, m_reg, mnA, alA);
    if (NT > 1) { VMW(); SWRITE_H(1); }
    __syncthreads();
#define HALF_STEP(PX0, PX1, mnX, alX, PY0, PY1, alY, t, KB, VB, SB) do {                                                      \
        SBAR(); qkt<KB, MLA, BIAS>(PX0, PX1, lds, r32, hi, S.qr, krb, qrb, fbh + KBASE(t) * 4);                                                         \
        finishSM(PY0, PY1, alY, l_reg, pa0, pa1, pa2, pa3); SBAR();                                                           \
        if ((t) + 1 < NT) { SLOAD_H(Kh, Vh, KBASE((t) + 1)); SBAR(); }                                                        \
        pv_tile<VB>(o, vb0, pa0, pa1, pa2, pa3); MASKT(PX0, PX1, (t)); partialSM<MLA>(PX0, PX1, m_reg, mnX, alX);             \
        __syncthreads();                                                                                                      \
        if ((t) + 1 < NT) { VMW(); SWRITE_H(SB); }                                                                            \
        RESC(alX); __syncthreads(); } while (0)
    for (int t = 1; t + 1 < NT; t += 2) {
        HALF_STEP(pB0, pB1, mnB, alB, pA0, pA1, alA, t, 1, 0, 0);
        HALF_STEP(pA0, pA1, mnA, alA, pB0, pB1, alB, t + 1, 0, 1, 1);
    }
    const bool even = (NT & 1) == 0;
    if (even) { SBAR(); qkt<1, MLA, BIAS>(pB0, pB1, lds, r32, hi, S.qr, krb, qrb, fbh + KBASE(NT - 1) * 4); SBAR(); }
    finishSM(pA0, pA1, alA, l_reg, pa0, pa1, pa2, pa3); SBAR();
    pv_tile<0>(o, vb0, pa0, pa1, pa2, pa3);
    if (even) { MASKT(pB0, pB1, NT - 1); partialSM<MLA>(pB0, pB1, m_reg, mnB, alB); __syncthreads(); RESC(alB);
        finishSM(pB0, pB1, alB, l_reg, pa0, pa1, pa2, pa3); SBAR(); pv_tile<1>(o, vb0, pa0, pa1, pa2, pa3); }
    SBAR();
    const bf16* Qn = H.Q + (size_t)qb_nxt * QB * G::QP;
    SLOAD_H(Kh, Vh, 0); QLOAD_R(Qn); SBAR();
    if (hi == 0) li_l[r32] = l_reg; asm volatile("s_waitcnt lgkmcnt(0)" ::: "memory");
    float rli[16];
#pragma unroll
    for (int r = 0; r < 16; ++r) rli[r] = __builtin_amdgcn_rcpf(li_l[crow(r, hi)]);
    bf16* Ow = H.O + (size_t)(P0 + wid * QBLK) * G::OP;
#pragma unroll
    for (int r = 0; r < 16; ++r) { const int orow = crow(r, hi);
#pragma unroll
        for (int d0 = 0; d0 < 4; ++d0) { const float v = o[d0][r] * rli[r];
            const float vn = __shfl_xor(v, 1);
            if ((r32 & 1) == 0) *(unsigned*)(Ow + (size_t)orow * G::OP + d0 * 32 + r32) = cvtpk(v, vn); } }
    SBAR(); QLOAD_L(Qn); VMW(); SWRITE_HK(0); QROPE_TO_LDS();
    __syncthreads();
#undef RESC
#undef KBASE
#undef MASKT
#undef HALF_STEP
}
#undef VMW
#undef VMWN
#undef SLOAD_H
#undef SWRITE_HK
#undef SWRITE_HV
#undef SWRITE_H
#undef QLOAD_R
#undef QLOAD_L
#undef QROPE_TO_LDS
#undef PK4
}


namespace mk {
using pg8::bf16_t; using pg8::f32x4; using pg8::u32x4; using pg8::bf16x8; using pg8::Unit; using pg8::cvt_pk_bf16;
typedef GAS unsigned gu32;
#define RLX_AGENT __ATOMIC_RELAXED, __HIP_MEMORY_SCOPE_AGENT
constexpr int NWAVES = 8, NTHREADS = 512;
constexpr int NP = NP_G;
constexpr int P_CQ = 0, P_CKV = 512, P_GQ = 1024, P_GK = 1536, P_GV = 2048, P_GR = 3072, P_FQ = 4096, P_FK = 5120, P_FV = 6144, P_GATES = 7168, P_KR = 13312, P_GA = 13376, P_FL = 13392;
__host__ __device__ __forceinline__ int map_in(int n) {
    if (n < 1024) return n;
    if (n < 1088) return P_KR + (n - 1024);
    if (n < 3136) return n - 1088 + 1024;
    if (n < 3152) return P_GA + (n - 3136);
    if (n < 7248) return n - 3152 + 3072;
    if (n < 7256) return P_FL + (n - 7248);
    return n - 7256 + P_GATES;
}
__host__ __device__ __forceinline__ int rope_pos(int i) { const int half = i >> 5, jj = i & 31; return 32 * (jj >> 4) + 8 * ((jj >> 2) & 3) + 4 * half + (jj & 3); }
__host__ __device__ __forceinline__ int map_uq(int n) { const int h = n / 192, j = n % 192; return h * 256 + (j < 128 ? j : 128 + rope_pos(j - 128)); }
__host__ __device__ __forceinline__ int map_gu(int n) { const int up = n >= FFH, j = up ? n - FFH : n; return (j >> 7) * 256 + up * 128 + (j & 127); }
__host__ __device__ __forceinline__ int map_id(int n) { return n; }

constexpr size_t MiB = 1u << 20;
constexpr size_t WS_CTL = 0, CTL_ZERO_BYTES = 64 * 1024;
constexpr size_t LW_WIN = 0, LW_WUQ = 53 * MiB, LW_WUKV = 55 * MiB, LW_WBR = 57 * MiB, LW_WOUT = 69 * MiB, LW_WGU = 77 * MiB, LW_WDN = 121 * MiB, LW_BYTES = 143 * MiB;
static_assert((size_t)NP * DM * 2 == 53 * MiB && (size_t)2 * FFH * DM * 2 == 44 * MiB && (size_t)DM * FFH * 2 == 22 * MiB, "weight sizes");
constexpr size_t WS_W = 1 * MiB;
constexpr int CW_TMO = 0, CW_CODE = 1, CW_BAR = 4096, CW_QUEUE = 65536;

constexpr int RING_OFF = 0, LDS_BYTES = 163840, LDSCTL_OFF = LDS_BYTES - 512, MISC_OFF = LDSCTL_OFF + 320;

__device__ __forceinline__ float wave_sum(float v) {
#pragma unroll
    for (int o = 1; o < 64; o <<= 1) v += __shfl_xor(v, o);
    return v;
}
__device__ __forceinline__ unsigned f2bf(float f) { unsigned u = __builtin_bit_cast(unsigned, f); return (u + 0x7fffu + ((u >> 16) & 1u)) >> 16; }
__device__ __forceinline__ unsigned pk2(float lo, float hi) { return f2bf(lo) | (f2bf(hi) << 16); }
__device__ __forceinline__ float bf2f(unsigned short b) { return __builtin_bit_cast(float, (unsigned)b << 16); }
__device__ __forceinline__ float bflo(unsigned w) { return __builtin_bit_cast(float, w << 16); }
__device__ __forceinline__ float bfhi(unsigned w) { return __builtin_bit_cast(float, w & 0xffff0000u); }
__device__ __forceinline__ float fast_sigmoid(float x) { return __builtin_amdgcn_rcpf(1.f + __builtin_amdgcn_exp2f(-1.4426950408889634f * x)); }

struct EpiStoreBf16 {
    static constexpr bool PERM = true, AFTER_DRAIN = false;
    bf16_t* O; int ldc; const LAS float* RT;
    __device__ __forceinline__ void operator()(const f32x4 (&acc)[2][2][4][2], const Unit& u, int wr, int wc, int fr, int fq) const {
        const int row0 = u.pm * 256 + wr * 64 + fr, col0 = u.pn * 256 + wc * 32 + 8 * fq;
#pragma unroll
        for (int ai = 0; ai < 2; ++ai)
#pragma unroll
            for (int m = 0; m < 4; ++m) { const int row = row0 + ai * 128 + m * 16; bf16_t* rowp = O + (size_t)row * ldc + col0;
                const float r = RT[wr * 64 + fr + ai * 128 + m * 16];
#pragma unroll
                for (int bj = 0; bj < 2; ++bj) { const f32x4 v0 = acc[ai][bj][m][0] * r, v1 = acc[ai][bj][m][1] * r;
                    u32x4 w; w.x = cvt_pk_bf16(v0[0], v0[1]); w.y = cvt_pk_bf16(v0[2], v0[3]); w.z = cvt_pk_bf16(v1[0], v1[1]); w.w = cvt_pk_bf16(v1[2], v1[3]);
                    *(u32x4*)(rowp + bj * 128) = w; } }
    }
};
struct EpiSwiglu {
    static constexpr bool PERM = true, AFTER_DRAIN = false;
    bf16_t* O; int ldc; const LAS float* RT;
    __device__ __forceinline__ void operator()(const f32x4 (&acc)[2][2][4][2], const Unit& u, int wr, int wc, int fr, int fq) const {
        const int row0 = u.pm * 256 + wr * 64 + fr, col0 = u.pn * 128 + wc * 32 + 8 * fq;
#pragma unroll
        for (int ai = 0; ai < 2; ++ai)
#pragma unroll
            for (int m = 0; m < 4; ++m) { const int row = row0 + ai * 128 + m * 16; bf16_t* rowp = O + (size_t)row * ldc + col0;
                const float rs = RT[wr * 64 + fr + ai * 128 + m * 16];
                float r[8];
#pragma unroll
                for (int n = 0; n < 2; ++n)
#pragma unroll
                    for (int e = 0; e < 4; ++e) { const float g = acc[ai][0][m][n][e] * rs, up = acc[ai][1][m][n][e] * rs; r[n * 4 + e] = g * fast_sigmoid(g) * up; }
                u32x4 w; w.x = cvt_pk_bf16(r[0], r[1]); w.y = cvt_pk_bf16(r[2], r[3]); w.z = cvt_pk_bf16(r[4], r[5]); w.w = cvt_pk_bf16(r[6], r[7]);
                *(u32x4*)rowp = w; }
    }
};
struct EpiResidF32 {
    static constexpr bool PERM = false, AFTER_DRAIN = false;
    const float* R; float* C; int ldc;
    __device__ __forceinline__ void operator()(const f32x4 (&acc)[2][2][4][2], const Unit& u, int wr, int wc, int fr, int fq) const {
        const int row0 = u.pm * 256 + wr * 64 + fr, col0 = u.pn * 256 + wc * 32 + 4 * fq;
#pragma unroll
        for (int ai = 0; ai < 2; ++ai)
#pragma unroll
            for (int m = 0; m < 4; ++m) { const size_t ro = (size_t)(row0 + ai * 128 + m * 16) * ldc + col0;
#pragma unroll
                for (int bj = 0; bj < 2; ++bj)
#pragma unroll
                    for (int n = 0; n < 2; ++n) { const f32x4 r = *(const f32x4*)(R + ro + bj * 128 + n * 16); *(f32x4*)(C + ro + bj * 128 + n * 16) = r + acc[ai][bj][m][n]; } }
    }
};
struct EpiResidNorm {
    static constexpr bool PERM = true, AFTER_DRAIN = true;
    const void* R; void* C; int ldc; float* SSP; int emit; int rb, cb;
    __device__ __forceinline__ void operator()(const f32x4 (&)[2][2][4][2], const Unit&, int, int, int, int) const {}
    template <bool RB, bool CB>
    __device__ __forceinline__ void body(const f32x4 (&acc)[2][2][4][2], const Unit& u, int wr, int wc, int fr, int fq, LAS float* P) const {
        const int col0 = u.pn * 256 + wc * 32 + 8 * fq;
#pragma unroll
        for (int ai = 0; ai < 2; ++ai) {
            f32x4 rv[4][2][2]; u32x4 rw[4][2];
#pragma unroll
            for (int m = 0; m < 4; ++m)
#pragma unroll
                for (int bj = 0; bj < 2; ++bj) { const size_t ro = (size_t)(u.pm * 256 + ai * 128 + wr * 64 + m * 16 + fr) * ldc + col0;
                    if (RB) rw[m][bj] = *(const u32x4*)((const bf16_t*)R + ro + bj * 128);
                    else { rv[m][bj][0] = *(const f32x4*)((const float*)R + ro + bj * 128); rv[m][bj][1] = *(const f32x4*)((const float*)R + ro + bj * 128 + 4); } }
#pragma unroll
            for (int m = 0; m < 4; ++m) { const int rl = ai * 128 + wr * 64 + m * 16 + fr; const size_t ro = (size_t)(u.pm * 256 + rl) * ldc + col0; float s = 0.f;
#pragma unroll
                for (int bj = 0; bj < 2; ++bj) {
                    f32x4 r0, r1;
                    if (RB) { const u32x4 w = rw[m][bj];
                        r0 = (f32x4){__uint_as_float(w.x << 16), __uint_as_float(w.x & 0xffff0000u), __uint_as_float(w.y << 16), __uint_as_float(w.y & 0xffff0000u)};
                        r1 = (f32x4){__uint_as_float(w.z << 16), __uint_as_float(w.z & 0xffff0000u), __uint_as_float(w.w << 16), __uint_as_float(w.w & 0xffff0000u)}; }
                    else { r0 = rv[m][bj][0]; r1 = rv[m][bj][1]; }
                    const f32x4 x0 = r0 + acc[ai][bj][m][0], x1 = r1 + acc[ai][bj][m][1];
                    if (CB) { u32x4 w; w.x = cvt_pk_bf16(x0[0], x0[1]); w.y = cvt_pk_bf16(x0[2], x0[3]); w.z = cvt_pk_bf16(x1[0], x1[1]); w.w = cvt_pk_bf16(x1[2], x1[3]);
                        *(u32x4*)((bf16_t*)C + ro + bj * 128) = w; }
                    else { *(f32x4*)((float*)C + ro + bj * 128) = x0; *(f32x4*)((float*)C + ro + bj * 128 + 4) = x1; }
                    if (emit) s += ((x0[0] * x0[0] + x0[1] * x0[1]) + (x0[2] * x0[2] + x0[3] * x0[3])) + ((x1[0] * x1[0] + x1[1] * x1[1]) + (x1[2] * x1[2] + x1[3] * x1[3])); }
                if (emit) { s += __shfl_xor(s, 16); s += __shfl_xor(s, 32); if (fq == 0) P[rl * 4 + wc] = s; } }
            asm volatile("" ::: "memory"); }
    }
    __device__ __forceinline__ void fused(const f32x4 (&acc)[2][2][4][2], const Unit& u, int wr, int wc, int fr, int fq, LAS unsigned char* lds, int wid, int lane) const {
        LAS float* P = (LAS float*)lds;
        if (rb && cb) body<true, true>(acc, u, wr, wc, fr, fq, P);
        else if (rb) body<true, false>(acc, u, wr, wc, fr, fq, P);
        else body<false, true>(acc, u, wr, wc, fr, fq, P);
        if (emit) {
            asm volatile("s_waitcnt lgkmcnt(0)" ::: "memory"); __builtin_amdgcn_s_barrier(); asm volatile("" ::: "memory");
            const int t = wid * 64 + lane;
            if (t < 256) { const f32x4 p = *(const LAS f32x4*)(P + t * 4); SSP[(size_t)(u.pm * 256 + t) * 8 + u.pn] = (p.x + p.y) + (p.z + p.w); }
            asm volatile("s_waitcnt lgkmcnt(0)" ::: "memory"); __builtin_amdgcn_s_barrier(); asm volatile("" ::: "memory");
        }
    }
};

struct BranchOrder {
    pg8::StaticOrder T;
    __device__ void init(int G, int c) { T.init(S, DM, G, c); }
    __device__ bool next(int i, Unit& u) const { Unit t; const int n = i % 3; if (!T.next(i / 3, t)) return false; u.pm = 32 * n + t.pm; u.pn = 8 * n + t.pn; return true; }
    __device__ __forceinline__ void a_ready(const Unit&) const {}
    __device__ __forceinline__ void done(const Unit&) const {}
};
struct EpiGateMergeAll {
    static constexpr bool PERM = true, AFTER_DRAIN = false;
    const bf16_t* G; int ldg; bf16_t* PART; bf16_t* Mb; int ldc;
    __device__ __forceinline__ void operator()(const f32x4 (&acc)[2][2][4][2], const Unit& u, int wr, int wc, int fr, int fq) const {
        const int n = u.pn >> 3, pm = u.pm & 31, pn = u.pn & 7;
        const int row0 = pm * 256 + wr * 64 + fr, col0 = pn * 256 + wc * 32 + 8 * fq;
        bf16_t* dst = (n < 2) ? PART : Mb;
#pragma unroll
        for (int ai = 0; ai < 2; ++ai) {
            u32x4 gw[4][2], pw[4][2];
#pragma unroll
            for (int m = 0; m < 4; ++m)
#pragma unroll
                for (int bj = 0; bj < 2; ++bj) { const size_t row = (size_t)(row0 + ai * 128 + m * 16);
                    gw[m][bj] = *(const u32x4*)(G + row * ldg + n * DM + col0 + bj * 128);
                    pw[m][bj] = (n > 0) ? *(const u32x4*)(PART + row * ldc + col0 + bj * 128) : (u32x4){0u, 0u, 0u, 0u}; }
#pragma unroll
            for (int m = 0; m < 4; ++m)
#pragma unroll
                for (int bj = 0; bj < 2; ++bj) { const size_t row = (size_t)(row0 + ai * 128 + m * 16);
                    const u32x4 g4 = gw[m][bj], p4 = pw[m][bj];
                    f32x4 a0 = acc[ai][bj][m][0], a1 = acc[ai][bj][m][1];
                    a0[0] = fmaf(a0[0], fast_sigmoid(bflo(g4.x)), bflo(p4.x)); a0[1] = fmaf(a0[1], fast_sigmoid(bfhi(g4.x)), bfhi(p4.x)); a0[2] = fmaf(a0[2], fast_sigmoid(bflo(g4.y)), bflo(p4.y)); a0[3] = fmaf(a0[3], fast_sigmoid(bfhi(g4.y)), bfhi(p4.y));
                    a1[0] = fmaf(a1[0], fast_sigmoid(bflo(g4.z)), bflo(p4.z)); a1[1] = fmaf(a1[1], fast_sigmoid(bfhi(g4.z)), bfhi(p4.z)); a1[2] = fmaf(a1[2], fast_sigmoid(bflo(g4.w)), bflo(p4.w)); a1[3] = fmaf(a1[3], fast_sigmoid(bfhi(g4.w)), bfhi(p4.w));
                    u32x4 w; w.x = cvt_pk_bf16(a0[0], a0[1]); w.y = cvt_pk_bf16(a0[2], a0[3]); w.z = cvt_pk_bf16(a1[0], a1[1]); w.w = cvt_pk_bf16(a1[2], a1[3]);
                    *(u32x4*)(dst + row * ldc + col0 + bj * 128) = w; }
            asm volatile("" ::: "memory"); }
    }
};

struct Args {
    const float* in[21]; float* out; unsigned char* ws;
    int pro_lo, pro_hi;
    int l_lo, l_hi, ph_lo, ph_hi;
    int li, pad;
};
struct Frame {
    LAS unsigned char* lds; volatile LAS unsigned* MISC; gu32* ctl;
    int tid, lane, wave, G, vcu;
};
__device__ __forceinline__ Frame relaunder(const Frame& F0) {
    Frame F = F0; int t = F0.tid, v = F0.vcu, g = F0.G;
    asm volatile("" : "+v"(t)); asm volatile("" : "+s"(v)); asm volatile("" : "+s"(g));
    F.tid = t; F.lane = t & 63; F.wave = __builtin_amdgcn_readfirstlane(t >> 6); F.vcu = v; F.G = g; return F;
}
#ifndef MK_WSTRIDE
#define MK_WSTRIDE 0
#endif
constexpr size_t WSTRIDE = MK_WSTRIDE;
constexpr size_t WBYTES = WSTRIDE ? (size_t)DEPTH * WSTRIDE : LW_BYTES;
constexpr size_t A_PROJ = WS_W + WBYTES, A_HN = A_PROJ + 212 * MiB, A_OA = A_HN + 32 * MiB, A_OB = A_OA + 16 * MiB, A_OC = A_OB + 16 * MiB, A_MERGED = A_OC + 16 * MiB,
                 A_CQN = A_MERGED + 64 * MiB, A_MQ = A_CQN + 16 * MiB, A_MK = A_MQ + 24 * MiB, A_MV = A_MK + 24 * MiB, A_FQ = A_MV + 16 * MiB, A_FK = A_FQ + 16 * MiB, A_FCUM = A_FK + 16 * MiB,
                 A_QT = A_FCUM + 1 * MiB, A_KT = A_QT + 8 * MiB, A_BLAST = A_KT + 8 * MiB, A_KVP = A_BLAST + 1 * MiB, A_SPREV = A_KVP + 64 * MiB, A_CS = A_SPREV + 32 * MiB, A_KRR = A_CS + 2 * MiB,
                 A_KRSS = A_KRR + 2 * MiB, A_HN2 = A_KRSS + 1 * MiB, A_SSPA = A_HN2 + 32 * MiB, A_SSPB = A_SSPA + 1 * MiB, A_XR = A_SSPB + 1 * MiB, A_END = A_XR + 32 * MiB;
typedef const __attribute__((address_space(4))) Args* ArgsP;
__device__ __forceinline__ int lnd_s(int v) { asm volatile("" : "+s"(v)); return v; }
__device__ __forceinline__ int lnd_v(int v) { asm volatile("" : "+v"(v)); return v; }
#define WSP(T, off) ((T*)(a->ws + (off)))
__device__ __forceinline__ ArgsP get_args() { ArgsP p = (ArgsP)__builtin_amdgcn_kernarg_segment_ptr(); asm volatile("" : "+s"(p)); return p; }

constexpr int I_IN = (DM / 64) * ((D_IN + 63) / 64), I_UQ = (512 / 64) * (1536 / 64), I_UKV = (512 / 64) * (2048 / 64), I_BR = (1024 / 64) * (DM / 64), I_OUT = (DM / 64) * (DM / 64),
              I_GU = (DM / 64) * (2 * FFH / 64), I_DN = (FFH / 64) * (DM / 64);
constexpr int NITEMS = I_IN + I_UQ + I_UKV + 3 * I_BR + I_OUT + I_GU + I_DN;
struct CvItem { const float* src; bf16_t* dst; const float* gk; int K, N, k0, n0, kind; };
__device__ __forceinline__ CvItem cv_decode(ArgsP a, int l, int r) {
    unsigned char* wb = a->ws + WS_W + (size_t)l * WSTRIDE;
    CvItem it; it.gk = nullptr;
    if (r < I_IN) { it.src = a->in[3] + (size_t)l * DM * D_IN; it.dst = (bf16_t*)(wb + LW_WIN); it.K = DM; it.N = D_IN; it.kind = 1; it.gk = a->in[2] + l * DM; }
    else if ((r -= I_IN) < I_UQ) { it.src = a->in[5] + (size_t)l * 512 * 1536; it.dst = (bf16_t*)(wb + LW_WUQ); it.K = 512; it.N = 1536; it.kind = 2; }
    else if ((r -= I_UQ) < I_UKV) { it.src = a->in[7] + (size_t)l * 512 * 2048; it.dst = (bf16_t*)(wb + LW_WUKV); it.K = 512; it.N = 2048; it.kind = 0; }
    else if ((r -= I_UKV) < 3 * I_BR) { const int n = r / I_BR; r -= n * I_BR; it.src = a->in[16] + (size_t)(l * 3 + n) * 1024 * DM; it.dst = (bf16_t*)(wb + LW_WBR) + (size_t)n * DM * 1024; it.K = 1024; it.N = DM; it.kind = 0; }
    else if ((r -= 3 * I_BR) < I_OUT) { it.src = a->in[17] + (size_t)l * DM * DM; it.dst = (bf16_t*)(wb + LW_WOUT); it.K = DM; it.N = DM; it.kind = 0; }
    else if ((r -= I_OUT) < I_GU) { it.src = a->in[19] + (size_t)l * DM * 2 * FFH; it.dst = (bf16_t*)(wb + LW_WGU); it.K = DM; it.N = 2 * FFH; it.kind = 3; it.gk = a->in[18] + l * DM; }
    else { r -= I_GU; it.src = a->in[20] + (size_t)l * FFH * DM; it.dst = (bf16_t*)(wb + LW_WDN); it.K = FFH; it.N = DM; it.kind = 0; }
    const int nblk = (it.N + 63) >> 6, kb = r / nblk, nb = r - kb * nblk; it.k0 = 64 * kb; it.n0 = 64 * nb;
    return it;
}
typedef float f32x2g __attribute__((ext_vector_type(2)));
__device__ __forceinline__ void cv_load(const CvItem& it, int lane, f32x4 (&v)[8][2], f32x2g (&gv)[8]) {
    const int n4 = lane & 15, kq = lane >> 4, n = it.n0 + 4 * n4;
    const bool ok = n < it.N;
    const float* src = it.src + (size_t)(it.k0 + 2 * kq) * it.N + n;
#pragma unroll
    for (int ii = 0; ii < 8; ++ii)
#pragma unroll
        for (int t = 0; t < 2; ++t) v[ii][t] = ok ? __builtin_nontemporal_load((const f32x4*)(src + (size_t)(8 * ii + t) * it.N)) : (f32x4){0.f, 0.f, 0.f, 0.f};
    if (it.gk) {
#pragma unroll
        for (int ii = 0; ii < 8; ++ii) gv[ii] = *(const f32x2g*)(it.gk + it.k0 + 2 * kq + 8 * ii); }
    else {
#pragma unroll
        for (int ii = 0; ii < 8; ++ii) gv[ii] = (f32x2g){1.f, 1.f}; }
}
__device__ __forceinline__ void cv_store(const CvItem& it, const f32x4 (&v)[8][2], const f32x2g (&gv)[8], LAS unsigned* scr, int lane) {
    const int n4 = lane & 15, kq = lane >> 4;
#pragma unroll
    for (int ii = 0; ii < 8; ++ii)
#pragma unroll
        for (int e = 0; e < 4; ++e) scr[(4 * n4 + e) * 34 + kq + 4 * ii] = cvt_pk_bf16(v[ii][0][e] * gv[ii].x, v[ii][1][e] * gv[ii].y);
    asm volatile("s_waitcnt lgkmcnt(0)" ::: "memory");
    const int c8 = lane & 7;
#pragma unroll
    for (int j = 0; j < 8; ++j) { const int nn = (lane >> 3) + 8 * j, n = it.n0 + nn;
        typedef unsigned u32x2 __attribute__((ext_vector_type(2)));
        const u32x2 lo = *(const LAS u32x2*)(scr + nn * 34 + 4 * c8), hi2 = *(const LAS u32x2*)(scr + nn * 34 + 4 * c8 + 2);
        const int dr = it.kind == 0 ? n : (it.kind == 1 ? map_in(n) : (it.kind == 2 ? map_uq(n) : map_gu(n)));
        if (n < it.N) *(u32x4*)(it.dst + (size_t)dr * it.K + it.k0 + 8 * c8) = (u32x4){lo.x, lo.y, hi2.x, hi2.y}; }
    asm volatile("s_waitcnt lgkmcnt(0)" ::: "memory");
}
__device__ __forceinline__ void cv_run(ArgsP a, int l0, int first, int stride, int count, LAS unsigned* scr, int lane, int P = NITEMS, int OFF = 0) {
    if (count <= 0) return;
    CvItem cur = cv_decode(a, l0 + first / P, OFF + first % P);
    f32x4 v[8][2]; f32x2g gv[8]; cv_load(cur, lane, v, gv);
    for (int i = 1; i <= count; ++i) {
        CvItem nxt = cur; f32x4 w[8][2]; f32x2g gw[8];
        if (i < count) { const int r = first + i * stride; nxt = cv_decode(a, l0 + r / P, OFF + r % P); cv_load(nxt, lane, w, gw); }
        cv_store(cur, v, gv, scr, lane);
        if (i < count) { cur = nxt;
#pragma unroll
            for (int ii = 0; ii < 8; ++ii) { v[ii][0] = w[ii][0]; v[ii][1] = w[ii][1]; gv[ii] = gw[ii]; } }
    }
}
constexpr int CV_W1 = 96, CV_R1 = 7, CV_W4 = 128, CV_R4 = 6, CV_W8 = 128, CV_R8 = 7, CV_P0 = I_IN + I_UQ + I_UKV, CV_B8 = 0, CV_B1 = CV_P0, CV_B4 = CV_B1 + CV_W1 * CV_R1 * 8;
static_assert(CV_W8 * CV_R8 * 8 == CV_P0 && CV_B4 + CV_W4 * CV_R4 * 8 >= NITEMS && CV_B4 < NITEMS, "conversion slices must cover a layer");
__device__ __forceinline__ void prologue_weights(const Frame& F0, int l_lo, int l_hi) {
    const Frame F = relaunder(F0);
    ArgsP a = get_args();
    LAS unsigned* scr = (LAS unsigned*)(F.lds + RING_OFF + F.wave * 16384);
    const int gw = F.vcu * NWAVES + F.wave, NGW = F.G * NWAVES, total = (l_hi - l_lo == 1 && l_lo == 0) ? CV_P0 : (l_hi - l_lo) * NITEMS;
    cv_run(a, l_lo, gw, NGW, gw < total ? (total - gw + NGW - 1) / NGW : 0, scr, F.lane);
}
__device__ __forceinline__ void convert_slice(const Frame& F0, int l, int base, int rank, int W, int R) {
    if (l >= DEPTH) return;
    const Frame F = relaunder(F0);
    ArgsP a = get_args();
    LAS unsigned* scr = (LAS unsigned*)(F.lds + RING_OFF + F.wave * 16384);
    const int first = base + rank * 8 + F.wave, stride = W * 8;
    int count = 0; if (first < NITEMS) { count = (NITEMS - first + stride - 1) / stride; if (count > R) count = R; }
    cv_run(a, l, first, stride, count, scr, F.lane);
}
__device__ __forceinline__ void phase_rms0(const Frame& F0, const float* X, bf16_t* O, float* SSP) {
    const Frame F = relaunder(F0);
    const int gw = F.vcu * NWAVES + F.wave, NGW = F.G * NWAVES, lane = F.lane;
    for (int m = gw; m < S; m += NGW) {
        const f32x4* xr = (const f32x4*)(X + (size_t)m * DM) + lane;
        f32x4 v[8]; float s = 0.f;
#pragma unroll
        for (int j = 0; j < 8; ++j) { v[j] = xr[64 * j]; s += (v[j].x * v[j].x + v[j].y * v[j].y) + (v[j].z * v[j].z + v[j].w * v[j].w); }
        s = wave_sum(s);
        unsigned long long* o8 = (unsigned long long*)(O + (size_t)m * DM) + lane;
#pragma unroll
        for (int j = 0; j < 8; ++j) o8[64 * j] = (unsigned long long)pk2(v[j].x, v[j].y) | ((unsigned long long)pk2(v[j].z, v[j].w) << 32);
        if (lane < 2) *(f32x4*)(SSP + (size_t)m * 8 + 4 * lane) = (f32x4){lane == 0 ? s : 0.f, 0.f, 0.f, 0.f};
    }
}
constexpr int RT_OFF = 131072;
__device__ __forceinline__ int first_unit_pm(int nN, int G, int cidx) {
    const int nM = S / 256, nwg = nM * nN; if (cidx >= nwg) return -1;
    int wgid = cidx; { const int q = nwg / pg8::NXCD, r = nwg % pg8::NXCD, xcd = wgid % pg8::NXCD, off = wgid / pg8::NXCD; wgid = (xcd < r ? xcd * (q + 1) : r * (q + 1) + (xcd - r) * q) + off; }
    const int nig = pg8::WGM * nN, gid = wgid / nig, fm = gid * pg8::WGM, gsz = (nM - fm) < pg8::WGM ? (nM - fm) : pg8::WGM;
    return fm + ((wgid % nig) % gsz);
}
__device__ __forceinline__ void fill_rstd_table(const Frame& F0, const float* SSP, int pm) {
    const Frame F = relaunder(F0);
    if (F.tid < 256) { const int row = pm * 256 + F.tid;
        const f32x4 s0 = *(const f32x4*)(SSP + (size_t)row * 8), s1 = *(const f32x4*)(SSP + (size_t)row * 8 + 4);
        ((LAS float*)(F.lds + RT_OFF))[F.tid] = rsqrtf((((s0.x + s0.y) + (s0.z + s0.w)) + ((s1.x + s1.y) + (s1.z + s1.w))) * (1.f / DM) + EPS); }
    __syncthreads();
}

__device__ __forceinline__ float log_sigmoid_f(float x) { return fminf(x, 0.f) - __logf(1.f + __expf(-fabsf(x))); }
__device__ __forceinline__ void unpack8(const u32x4 w, float (&f)[8]) {
    f[0] = bflo(w.x); f[1] = bfhi(w.x); f[2] = bflo(w.y); f[3] = bfhi(w.y); f[4] = bflo(w.z); f[5] = bfhi(w.z); f[6] = bflo(w.w); f[7] = bfhi(w.w);
}
__device__ __forceinline__ u32x4 pack8f(const float (&f)[8]) { u32x4 w; w.x = cvt_pk_bf16(f[0], f[1]); w.y = cvt_pk_bf16(f[2], f[3]); w.z = cvt_pk_bf16(f[4], f[5]); w.w = cvt_pk_bf16(f[6], f[7]); return w; }

__device__ __forceinline__ void sincos_d(double a, double& sn, double& cn) {
    const double TWO_PI = 6.283185307179586476925286766559, HALF_PI = 1.5707963267948966192313216916398;
    const double k = rint(a / TWO_PI); double r = a - k * TWO_PI;
    const double q = rint(r / HALF_PI); r = r - q * HALF_PI; const int qi = ((int)q) & 3;
    const double r2 = r * r;
    const double sp = r * (1.0 + r2 * (-1.0 / 6 + r2 * (1.0 / 120 + r2 * (-1.0 / 5040 + r2 * (1.0 / 362880 + r2 * (-1.0 / 39916800 + r2 * (1.0 / 6227020800.0)))))));
    const double cp = 1.0 + r2 * (-0.5 + r2 * (1.0 / 24 + r2 * (-1.0 / 720 + r2 * (1.0 / 40320 + r2 * (-1.0 / 3628800 + r2 * (1.0 / 479001600.0 + r2 * (-1.0 / 87178291200.0)))))));
    if (qi == 0) { sn = sp; cn = cp; } else if (qi == 1) { sn = cp; cn = -sp; } else if (qi == 2) { sn = -sp; cn = -cp; } else { sn = -cp; cn = sp; }
}
__device__ __forceinline__ void rope_tables(const Frame& F0) {
    const Frame F = relaunder(F0);
    ArgsP a = get_args(); const int* pos = (const int*)a->in[1]; float* CS = WSP(float, A_CS);
    for (int i = F.vcu * NTHREADS + F.tid; i < S * 32; i += F.G * NTHREADS) {
        const int s = i >> 5, f = i & 31;
        const float inv = (float)exp2(-(double)f / 32.0 * 13.287712379549449391481277717958);
        const float ang = (float)pos[s] * inv;
        double sn, cn; sincos_d((double)ang, sn, cn);
        CS[s * 64 + f] = (float)cn; CS[s * 64 + 32 + f] = (float)sn;
    }
}

__device__ __forceinline__ void prep_row(int lane, int row, int l, ArgsP a) {
    const bf16_t* pr = WSP(bf16_t, A_PROJ) + (size_t)row * NP;
    const u32x4 cw0 = *(const u32x4*)(pr + P_CQ + 16 * lane), cw1 = *(const u32x4*)(pr + P_CQ + 16 * lane + 8);
    const u32x4 qw0 = *(const u32x4*)(pr + P_FQ + 16 * lane), qw1 = *(const u32x4*)(pr + P_FQ + 16 * lane + 8);
    const u32x4 kw0 = *(const u32x4*)(pr + P_FK + 16 * lane), kw1 = *(const u32x4*)(pr + P_FK + 16 * lane + 8);
    const float krv = bf2f(pr[P_KR + lane]);
    const float* cs = WSP(float, A_CS) + (size_t)row * 64;
    const float cc = cs[lane & 31], sn = cs[32 + (lane & 31)];
    {
        float v0[8], v1[8]; unpack8(cw0, v0); unpack8(cw1, v1);
        float s = 0.f;
#pragma unroll
        for (int i = 0; i < 8; ++i) s += v0[i] * v0[i] + v1[i] * v1[i];
#pragma unroll
        for (int o = 1; o < 32; o <<= 1) s += __shfl_xor(s, o);
        const float r = rsqrtf(s * (1.f / 512.f) + EPS);
        const float* g = (lane < 32) ? (a->in[4] + l * 512 + 16 * lane) : (a->in[6] + l * 512 + 16 * (lane - 32));
#pragma unroll
        for (int i = 0; i < 8; ++i) { v0[i] *= r * g[i]; v1[i] *= r * g[8 + i]; }
        bf16_t* op = WSP(bf16_t, A_CQN) + (size_t)row * 1024 + 16 * lane;
        *(u32x4*)op = pack8f(v0); *(u32x4*)(op + 8) = pack8f(v1);
    }
    {
        const float ss = wave_sum(krv * krv);
        const float y = krv * (a->in[9][l * 192 + 128 + lane]);
        const float yo = __shfl_xor(y, 32);
        WSP(float, A_KRR)[(size_t)row * 64 + rope_pos(lane)] = (lane < 32) ? (y * cc - yo * sn) : (y * cc + yo * sn);
        if (lane == 0) WSP(float, A_KRSS)[row] = ss;
    }
#pragma unroll
    for (int which = 0; which < 2; ++which) {
        float v0[8], v1[8]; unpack8(which ? kw0 : qw0, v0); unpack8(which ? kw1 : qw1, v1);
        float s = 0.f;
#pragma unroll
        for (int i = 0; i < 8; ++i) s += v0[i] * v0[i] + v1[i] * v1[i];
        s += __shfl_xor(s, 1); s += __shfl_xor(s, 2); s += __shfl_xor(s, 4);
        const float r = rsqrtf(s * (1.f / 128.f) + EPS);
        const float* g = a->in[which ? 14 : 13] + l * 128 + 16 * (lane & 7);
#pragma unroll
        for (int i = 0; i < 8; ++i) { v0[i] *= r * g[i]; v1[i] *= r * g[8 + i]; }
        bf16_t* op = WSP(bf16_t, which ? A_FK : A_FQ) + ((size_t)(lane >> 3) * S + row) * 128 + 16 * (lane & 7);
        *(u32x4*)op = pack8f(v0); *(u32x4*)(op + 8) = pack8f(v1);
    }
}
__device__ __forceinline__ void fox_cumsum(const Frame& F, int h, int l, ArgsP a) {
    LAS float* tot = (LAS float*)(F.lds);
    const bf16_t* P = WSP(bf16_t, A_PROJ) + P_FL + h; const float bf = a->in[15][l * 8 + h];
    const int t = F.tid; float v[16]; float run = 0.f;
    unsigned short raw[16];
#pragma unroll
    for (int i = 0; i < 16; ++i) raw[i] = P[(size_t)(t * 16 + i) * NP];
    asm volatile("" ::: "memory");
#pragma unroll
    for (int i = 0; i < 16; ++i) { run += log_sigmoid_f(bf2f(raw[i]) + bf); v[i] = run; }
    float inc = run;
#pragma unroll
    for (int o = 1; o < 64; o <<= 1) { const float n = __shfl_up(inc, o); if (F.lane >= o) inc += n; }
    if (F.lane == 63) tot[F.wave] = inc;
    __syncthreads();
    float woff = 0.f;
    for (int w = 0; w < F.wave; ++w) woff += tot[w];
    const float off = woff + inc - run;
    float* O = WSP(float, A_FCUM) + (size_t)h * S + t * 16;
#pragma unroll
    for (int i = 0; i < 16; ++i) O[i] = (v[i] + off) * 11.313708498984761f;
    __syncthreads();
}
__device__ __forceinline__ void gla_prep_unit(const Frame& F, int chunk, int h, int l, ArgsP a) {
    using namespace att;
    const int tid = lnd_v(F.tid), lane = tid & 63, w = __builtin_amdgcn_readfirstlane(tid >> 6), r32 = lane & 31, hi = lane >> 5, row0 = chunk * 64;
    char* lds = (char*)F.lds;
    char* Vl = lds;
    char* Kl = lds + 2 * SHM_V;
    float* LA = (float*)(lds + 3 * SHM_V);
    float* WA = (float*)(lds + 3 * SHM_V + 32768);
    float* GA = (float*)(lds + 3 * SHM_V + 32768 + 8192);
    float* TOT = (float*)(lds + 3 * SHM_V + 32768 + 8192 + 4096);
    const mk::bf16_t* PR = WSP(mk::bf16_t, A_PROJ) + (size_t)row0 * NP;
    if (tid < 128) { const int r = tid >> 1, hf = tid & 1; const u32x4 wv = *(const u32x4*)(PR + (size_t)r * NP + P_GA + 8 * hf); float t[8]; mk::unpack8(wv, t);
#pragma unroll
        for (int i = 0; i < 8; ++i) GA[r * 16 + 8 * hf + i] = t[i]; }
    { const int k = tid >> 5, d4 = (tid & 31) * 4; *(f32x4*)(WA + k * 128 + d4) = *(const f32x4*)(a->in[10] + (size_t)l * 16 * 512 + k * 512 + h * 128 + d4); }
    const int sr = tid >> 4, sc = (tid & 15) * 8, vst0 = v_st(sr, sc), vst1 = v_st(32 + sr, sc);
    { const bf16x8 v00 = load8(PR + (size_t)sr * NP + P_GV + h * 256 + sc), v01 = load8(PR + (size_t)(32 + sr) * NP + P_GV + h * 256 + sc);
      const bf16x8 v10 = load8(PR + (size_t)sr * NP + P_GV + h * 256 + 128 + sc), v11 = load8(PR + (size_t)(32 + sr) * NP + P_GV + h * 256 + 128 + sc);
      *(bf16x8*)(Vl + vst0) = v00; *(bf16x8*)(Vl + vst1) = v01; *(bf16x8*)(Vl + SHM_V + vst0) = v10; *(bf16x8*)(Vl + SHM_V + vst1) = v11; }
    __syncthreads();
    const int dg = tid & 15, jq = tid >> 4;
    {   float x0[8], x1[8];
        const f32x4 b0 = *(const f32x4*)(a->in[11] + l * 512 + h * 128 + dg * 8), b1 = *(const f32x4*)(a->in[11] + l * 512 + h * 128 + dg * 8 + 4);
#pragma unroll
        for (int i = 0; i < 4; ++i) { x0[i] = b0[i]; x0[4 + i] = b1[i]; x1[i] = b0[i]; x1[4 + i] = b1[i]; }
#pragma unroll
        for (int k = 0; k < 16; ++k) { const f32x4 w0 = *(const f32x4*)(WA + k * 128 + dg * 8), w1 = *(const f32x4*)(WA + k * 128 + dg * 8 + 4);
            const float g0 = GA[(2 * jq) * 16 + k], g1 = GA[(2 * jq + 1) * 16 + k];
#pragma unroll
            for (int i = 0; i < 4; ++i) { x0[i] = fmaf(g0, w0[i], x0[i]); x0[4 + i] = fmaf(g0, w1[i], x0[4 + i]); x1[i] = fmaf(g1, w0[i], x1[i]); x1[4 + i] = fmaf(g1, w1[i], x1[4 + i]); } }
#pragma unroll
        for (int i = 0; i < 8; ++i) { x0[i] = mk::log_sigmoid_f(x0[i]) * (1.f / 16.f); x1[i] = mk::log_sigmoid_f(x1[i]) * (1.f / 16.f); }
        *(f32x4*)(LA + (2 * jq) * 128 + dg * 8) = (f32x4){x0[0], x0[1], x0[2], x0[3]}; *(f32x4*)(LA + (2 * jq) * 128 + dg * 8 + 4) = (f32x4){x0[4], x0[5], x0[6], x0[7]};
        *(f32x4*)(LA + (2 * jq + 1) * 128 + dg * 8) = (f32x4){x1[0], x1[1], x1[2], x1[3]}; *(f32x4*)(LA + (2 * jq + 1) * 128 + dg * 8 + 4) = (f32x4){x1[4], x1[5], x1[6], x1[7]};
    }
    __syncthreads();
    { const int d = tid & 127, q = tid >> 7; float run = 0.f;
#pragma unroll
      for (int j = 0; j < 16; ++j) { run += LA[(16 * q + j) * 128 + d]; LA[(16 * q + j) * 128 + d] = run; }
      TOT[q * 128 + d] = run;
      __syncthreads();
      float off = 0.f;
      for (int qq = 0; qq < q; ++qq) off += TOT[qq * 128 + d];
      if (q > 0) {
#pragma unroll
          for (int j = 0; j < 16; ++j) LA[(16 * q + j) * 128 + d] += off; }
      if (q == 3) WSP(float, A_BLAST)[chunk * 512 + h * 128 + d] = run + off; }
    __syncthreads();
#pragma unroll
    for (int rr = 0; rr < 2; ++rr) { const int j = 2 * jq + rr;
        const u32x4 qw = *(const u32x4*)(PR + (size_t)j * NP + P_GQ + h * 128 + dg * 8), kw = *(const u32x4*)(PR + (size_t)j * NP + P_GK + h * 128 + dg * 8);
        float qv[8], kv[8]; mk::unpack8(qw, qv); mk::unpack8(kw, kv);
        const f32x4 c0 = *(const f32x4*)(LA + j * 128 + dg * 8), c1 = *(const f32x4*)(LA + j * 128 + dg * 8 + 4);
#pragma unroll
        for (int i = 0; i < 8; ++i) { const float bb = i < 4 ? c0[i] : c1[i - 4]; qv[i] *= 0.08838834764831845f * __expf(bb); kv[i] *= __expf(-bb); }
        const u32x4 qo = mk::pack8f(qv), ko = mk::pack8f(kv);
        *(u32x4*)(WSP(mk::bf16_t, A_QT) + (size_t)(row0 + j) * 512 + h * 128 + dg * 8) = qo;
        *(u32x4*)(WSP(mk::bf16_t, A_KT) + (size_t)(row0 + j) * 512 + h * 128 + dg * 8) = ko;
        *(u32x4*)(Kl + v_st(j, dg * 8)) = ko; }
    __syncthreads();
    {   const int vb = (int)(uintptr_t)Vl + v_rd_base(lane) + (w >> 2) * SHM_V + (w & 3) * 512;
        const int kb = (int)(uintptr_t)Kl + v_rd_base(lane);
#define TRRDV(dst, off) asm volatile("ds_read_b64_tr_b16 %0, %1 offset:%2" : "=&v"(dst) : "v"(vb), "i"(off) : "memory")
#define TRRDK(dst, off) asm volatile("ds_read_b64_tr_b16 %0, %1 offset:%2" : "=&v"(dst) : "v"(kb), "i"(off) : "memory")
        s16x4 vl0, vl1, vl2, vl3, vh0, vh1, vh2, vh3;
        TRRDV(vl0, 0); TRRDV(vh0, 2048); TRRDV(vl1, 4096); TRRDV(vh1, 6144); TRRDV(vl2, 8192); TRRDV(vh2, 10240); TRRDV(vl3, 12288); TRRDV(vh3, 14336);
        mk::bf16_t* O = WSP(mk::bf16_t, A_KVP) + ((size_t)(chunk * 4 + h) * 256 + w * 32 + r32) * 128 + 4 * hi;
#define KV_DB(db) do { s16x4 l0, l1, l2, l3, h0, h1, h2, h3; constexpr int b_ = (db) * 512;                                                                                                       \
            TRRDK(l0, b_); TRRDK(h0, b_ + 2048); TRRDK(l1, b_ + 4096); TRRDK(h1, b_ + 6144); TRRDK(l2, b_ + 8192); TRRDK(h2, b_ + 10240); TRRDK(l3, b_ + 12288); TRRDK(h3, b_ + 14336);         \
            asm volatile("s_waitcnt lgkmcnt(0)" ::: "memory"); SBAR();                                                                                                                          \
            f32x16 c = {};                                                                                                                                                                      \
            c = __builtin_amdgcn_mfma_f32_32x32x16_bf16((bf16x8){l0[0], l0[1], l0[2], l0[3], h0[0], h0[1], h0[2], h0[3]}, (bf16x8){vl0[0], vl0[1], vl0[2], vl0[3], vh0[0], vh0[1], vh0[2], vh0[3]}, c, 0, 0, 0);   \
            c = __builtin_amdgcn_mfma_f32_32x32x16_bf16((bf16x8){l1[0], l1[1], l1[2], l1[3], h1[0], h1[1], h1[2], h1[3]}, (bf16x8){vl1[0], vl1[1], vl1[2], vl1[3], vh1[0], vh1[1], vh1[2], vh1[3]}, c, 0, 0, 0);   \
            c = __builtin_amdgcn_mfma_f32_32x32x16_bf16((bf16x8){l2[0], l2[1], l2[2], l2[3], h2[0], h2[1], h2[2], h2[3]}, (bf16x8){vl2[0], vl2[1], vl2[2], vl2[3], vh2[0], vh2[1], vh2[2], vh2[3]}, c, 0, 0, 0);   \
            c = __builtin_amdgcn_mfma_f32_32x32x16_bf16((bf16x8){l3[0], l3[1], l3[2], l3[3], h3[0], h3[1], h3[2], h3[3]}, (bf16x8){vl3[0], vl3[1], vl3[2], vl3[3], vh3[0], vh3[1], vh3[2], vh3[3]}, c, 0, 0, 0);   \
                                                                                       \
            _Pragma("unroll") for (int g_ = 0; g_ < 4; ++g_) { typedef unsigned u32x2_ __attribute__((ext_vector_type(2))); *(u32x2_*)(O + (db) * 32 + 8 * g_) = (u32x2_){cvtpk_c(c[4 * g_], c[4 * g_ + 1]), cvtpk_c(c[4 * g_ + 2], c[4 * g_ + 3])}; } } while (0)
        KV_DB(0); KV_DB(1); KV_DB(2); KV_DB(3);
#undef KV_DB
#undef TRRDV
#undef TRRDK
    }
    __syncthreads();
}
__device__ __forceinline__ void phase_prep(const Frame& F0, int l) {
    const Frame F = relaunder(F0);
    ArgsP a = get_args();
    const int v = lnd_s(F.vcu);
    for (int u = v; u < 512; u += F.G) gla_prep_unit(F, u >> 2, u & 3, l, a);
    for (int u = v; u < 136; u += F.G) if (u >= 128) fox_cumsum(F, u - 128, l, a);
    const int gw = lnd_s(F.vcu * NWAVES + F.wave), NGW = F.G * NWAVES, lane = lnd_v(F.lane);
    for (int m = gw; m < S; m += NGW) prep_row(lane, m, l, a);
}

__device__ __forceinline__ void gla_scan(const Frame& F0) {
    const Frame F = relaunder(F0);
    ArgsP a = get_args();
    typedef float f32x2 __attribute__((ext_vector_type(2)));
    const bf16_t* KVP = WSP(bf16_t, A_KVP); const float* BL = WSP(float, A_BLAST); bf16_t* SP = WSP(bf16_t, A_SPREV);
    if (F.tid < 256)
    for (int e = lnd_s(F.vcu) * 256 + lnd_v(F.tid); e < 4 * 256 * 64; e += F.G * 256) {
        const int dp = e & 63, hc = e >> 6, h = hc >> 8;
        f32x2 st = {0.f, 0.f};
#pragma unroll 32
        for (int c = 0; c < 128; ++c) {
            const size_t o = ((size_t)c * 1024 + hc) * 128 + 2 * dp;
            const unsigned kw = *(const unsigned*)(KVP + o); const f32x2 kv = {bflo(kw), bfhi(kw)}; const f32x2 bl = *(const f32x2*)(BL + c * 512 + h * 128 + 2 * dp);
            *(unsigned*)(SP + o) = cvt_pk_bf16(st.x, st.y);
            st.x = __expf(bl.x) * (st.x + kv.x); st.y = __expf(bl.y) * (st.y + kv.y);
        }
    }
}

struct EpiMlaQ {
    static constexpr bool PERM = true, AFTER_DRAIN = true;
    bf16_t* MQ; const float* g; const float* CS;
    __device__ __forceinline__ void operator()(const f32x4 (&)[2][2][4][2], const Unit&, int, int, int, int) const {}
    __device__ __forceinline__ void fused(const f32x4 (&acc)[2][2][4][2], const Unit& u, int wr, int wc, int fr, int fq, LAS unsigned char* lds, int wid, int lane) const {
        LAS float* P = (LAS float*)lds;
#pragma unroll
        for (int ai = 0; ai < 2; ++ai)
#pragma unroll
            for (int m = 0; m < 4; ++m) { float s = 0.f;
#pragma unroll
                for (int n = 0; n < 2; ++n) { const f32x4 x = acc[ai][0][m][n]; s += (x[0] * x[0] + x[1] * x[1]) + (x[2] * x[2] + x[3] * x[3]);
                    if (wc < 2) { const f32x4 y = acc[ai][1][m][n]; s += (y[0] * y[0] + y[1] * y[1]) + (y[2] * y[2] + y[3] * y[3]); } }
                s += __shfl_xor(s, 16); s += __shfl_xor(s, 32);
                if (fq == 0) P[(ai * 128 + wr * 64 + m * 16 + fr) * 4 + wc] = s; }
        asm volatile("s_waitcnt lgkmcnt(0)" ::: "memory"); __builtin_amdgcn_s_barrier(); asm volatile("" ::: "memory");
        const int h = u.pn;
        const f32x4 g0 = *(const f32x4*)(g + 32 * wc + 8 * fq), g1 = *(const f32x4*)(g + 32 * wc + 8 * fq + 4);
        f32x4 gr1 = {0.f, 0.f, 0.f, 0.f}, gr2 = gr1;
        if (wc < 2) { gr1 = *(const f32x4*)(g + 128 + 16 * wc + 4 * fq); gr2 = *(const f32x4*)(g + 160 + 16 * wc + 4 * fq); }
#pragma unroll
        for (int ai = 0; ai < 2; ++ai)
#pragma unroll
            for (int m = 0; m < 4; ++m) { const int rl = ai * 128 + wr * 64 + m * 16 + fr; const int row = u.pm * 256 + rl;
                const f32x4 pp = *(const LAS f32x4*)(P + rl * 4);
                const float r = rsqrtf(((pp.x + pp.y) + (pp.z + pp.w)) * (1.f / 192.f) + EPS);
                bf16_t* ob = MQ + ((size_t)h * S + row) * 192;
                { const f32x4 a0 = acc[ai][0][m][0] * r * g0, a1 = acc[ai][0][m][1] * r * g1;
                  u32x4 w; w.x = cvt_pk_bf16(a0[0], a0[1]); w.y = cvt_pk_bf16(a0[2], a0[3]); w.z = cvt_pk_bf16(a1[0], a1[1]); w.w = cvt_pk_bf16(a1[2], a1[3]);
                  *(u32x4*)(ob + 32 * wc + 8 * fq) = w; }
                if (wc < 2) { const f32x4 y1 = acc[ai][1][m][0] * r * gr1, y2 = acc[ai][1][m][1] * r * gr2;
                  const f32x4 c = *(const f32x4*)(CS + (size_t)row * 64 + 16 * wc + 4 * fq), sn = *(const f32x4*)(CS + (size_t)row * 64 + 32 + 16 * wc + 4 * fq);
                  const f32x4 o1 = y1 * c - y2 * sn, o2 = y2 * c + y1 * sn;
                  u32x4 w; w.x = cvt_pk_bf16(o1[0], o1[1]); w.y = cvt_pk_bf16(o1[2], o1[3]); w.z = cvt_pk_bf16(o2[0], o2[1]); w.w = cvt_pk_bf16(o2[2], o2[3]);
                  *(u32x4*)(ob + 128 + 32 * wc + 8 * fq) = w; }
                asm volatile("" ::: "memory"); }
        asm volatile("s_waitcnt lgkmcnt(0)" ::: "memory"); __builtin_amdgcn_s_barrier(); asm volatile("" ::: "memory");
    }
};
struct EpiMlaKV {
    static constexpr bool PERM = true, AFTER_DRAIN = true;
    bf16_t* MK; bf16_t* MV; const float* g; const float* KRR; const float* KRSS;
    __device__ __forceinline__ void operator()(const f32x4 (&)[2][2][4][2], const Unit&, int, int, int, int) const {}
    __device__ __forceinline__ void fused(const f32x4 (&acc)[2][2][4][2], const Unit& u, int wr, int wc, int fr, int fq, LAS unsigned char* lds, int wid, int lane) const {
        LAS float* P = (LAS float*)lds;
#pragma unroll
        for (int ai = 0; ai < 2; ++ai)
#pragma unroll
            for (int m = 0; m < 4; ++m) { float s = 0.f;
#pragma unroll
                for (int n = 0; n < 2; ++n) { const f32x4 x = acc[ai][0][m][n]; s += (x[0] * x[0] + x[1] * x[1]) + (x[2] * x[2] + x[3] * x[3]); }
                s += __shfl_xor(s, 16); s += __shfl_xor(s, 32);
                if (fq == 0) P[(ai * 128 + wr * 64 + m * 16 + fr) * 4 + wc] = s; }
        asm volatile("s_waitcnt lgkmcnt(0)" ::: "memory"); __builtin_amdgcn_s_barrier(); asm volatile("" ::: "memory");
        const int h = u.pn;
        const f32x4 g0 = *(const f32x4*)(g + 32 * wc + 8 * fq), g1 = *(const f32x4*)(g + 32 * wc + 8 * fq + 4);
#pragma unroll
        for (int ai = 0; ai < 2; ++ai)
#pragma unroll
            for (int m = 0; m < 4; ++m) { const int rl = ai * 128 + wr * 64 + m * 16 + fr; const int row = u.pm * 256 + rl;
                const f32x4 pp = *(const LAS f32x4*)(P + rl * 4);
                const float r = rsqrtf((((pp.x + pp.y) + (pp.z + pp.w)) + KRSS[row]) * (1.f / 192.f) + EPS);
                bf16_t* kb = MK + ((size_t)h * S + row) * 192; bf16_t* vb = MV + ((size_t)h * S + row) * 128;
                { const f32x4 a0 = acc[ai][0][m][0] * r * g0, a1 = acc[ai][0][m][1] * r * g1;
                  u32x4 w; w.x = cvt_pk_bf16(a0[0], a0[1]); w.y = cvt_pk_bf16(a0[2], a0[3]); w.z = cvt_pk_bf16(a1[0], a1[1]); w.w = cvt_pk_bf16(a1[2], a1[3]);
                  *(u32x4*)(kb + 32 * wc + 8 * fq) = w; }
                { const f32x4 a0 = acc[ai][1][m][0], a1 = acc[ai][1][m][1];
                  u32x4 w; w.x = cvt_pk_bf16(a0[0], a0[1]); w.y = cvt_pk_bf16(a0[2], a0[3]); w.z = cvt_pk_bf16(a1[0], a1[1]); w.w = cvt_pk_bf16(a1[2], a1[3]);
                  *(u32x4*)(vb + 32 * wc + 8 * fq) = w; }
                { const f32x4 k4 = *(const f32x4*)(KRR + (size_t)row * 64 + 16 * wc + 4 * fq) * r;
                  typedef unsigned u32x2 __attribute__((ext_vector_type(2)));
                  u32x2 w; w.x = cvt_pk_bf16(k4[0], k4[1]); w.y = cvt_pk_bf16(k4[2], k4[3]);
                  *(u32x2*)(kb + 128 + 16 * wc + 4 * fq) = w; }
                asm volatile("" ::: "memory"); }
        asm volatile("s_waitcnt lgkmcnt(0)" ::: "memory"); __builtin_amdgcn_s_barrier(); asm volatile("" ::: "memory");
    }
};

__device__ __forceinline__ void gla_out_unit(const Frame& F, char* lds, int chunk, int l, ArgsP a) {
    using namespace att;
    typedef unsigned short bf16;
    const int w = F.wave, rb = w & 1, cp = w >> 1, row0 = chunk * 64;
    char* V_lds = lds + L_V; float* RS = (float*)(lds + L_WS);
    const bf16* PR = WSP(bf16, A_PROJ) + (size_t)row0 * NP;
    const bf16* QT = WSP(bf16, A_QT) + (size_t)row0 * 512; const bf16* KT = WSP(bf16, A_KT) + (size_t)row0 * 512;
    const float* gO = a->in[12] + l * 256;
#define PK4G(P, B_, OUT) do { unsigned a0 = cvtpk_c(P[B_+0], P[B_+1]), a1 = cvtpk_c(P[B_+2], P[B_+3]); unsigned b0 = cvtpk_c(P[B_+4], P[B_+5]), b1 = cvtpk_c(P[B_+6], P[B_+7]);        \
        auto r0 = __builtin_amdgcn_permlane32_swap(a0, b0, false, false); auto r1 = __builtin_amdgcn_permlane32_swap(a1, b1, false, false); \
        u32x4 w_ = {r0[0], r1[0], r0[1], r1[1]}; OUT = *reinterpret_cast<bf16x8*>(&w_); } while (0)
    for (int h = 0; h < 4; ++h) {
        const int tid = lnd_v(F.tid), lane = tid & 63, r32 = lane & 31, hi = lane >> 5;
        const int sr = tid >> 4, sc = (tid & 15) * 8, vst0 = v_st(sr, sc), vst1 = v_st(32 + sr, sc);
        const bf16x8 v00 = load8(PR + (size_t)sr * NP + P_GV + h * 256 + sc), v01 = load8(PR + (size_t)(32 + sr) * NP + P_GV + h * 256 + sc);
        const bf16x8 v10 = load8(PR + (size_t)sr * NP + P_GV + h * 256 + 128 + sc), v11 = load8(PR + (size_t)(32 + sr) * NP + P_GV + h * 256 + 128 + sc);
        bf16x8 qf[8];
#pragma unroll
        for (int d0 = 0; d0 < 8; ++d0) qf[d0] = load8(QT + (size_t)(rb * 32 + r32) * 512 + h * 128 + d0 * 16 + hi * 8);
        f32x16 p0 = {}, p1 = {};
        {   bf16x8 kf[8];
#pragma unroll
            for (int d0 = 0; d0 < 8; ++d0) kf[d0] = load8(KT + (size_t)r32 * 512 + h * 128 + d0 * 16 + hi * 8);
#pragma unroll
            for (int d0 = 0; d0 < 8; ++d0) p0 = __builtin_amdgcn_mfma_f32_32x32x16_bf16(kf[d0], qf[d0], p0, 0, 0, 0); }
        if (rb == 1) {
            bf16x8 kf[8];
#pragma unroll
            for (int d0 = 0; d0 < 8; ++d0) kf[d0] = load8(KT + (size_t)(32 + r32) * 512 + h * 128 + d0 * 16 + hi * 8);
#pragma unroll
            for (int d0 = 0; d0 < 8; ++d0) p1 = __builtin_amdgcn_mfma_f32_32x32x16_bf16(kf[d0], qf[d0], p1, 0, 0, 0);
        }
#pragma unroll
        for (int r = 0; r < 16; ++r) { const bool keep = ((r & 3) + 8 * (r >> 2) + 4 * hi) <= r32; if (rb == 0) { if (!keep) p0[r] = 0.f; } else { if (!keep) p1[r] = 0.f; } }
        bf16x8 pa0, pa1, pa2, pa3;
        PK4G(p0, 0, pa0); PK4G(p0, 8, pa1); PK4G(p1, 0, pa2); PK4G(p1, 8, pa3);
        *(bf16x8*)(V_lds + vst0) = v00; *(bf16x8*)(V_lds + vst1) = v01; *(bf16x8*)(V_lds + SHM_V + vst0) = v10; *(bf16x8*)(V_lds + SHM_V + vst1) = v11;
        __syncthreads();
        f32x16 o[2] = {};
#pragma unroll
        for (int cbi = 0; cbi < 2; ++cbi) {
            const int cb = 2 * cp + cbi;
            const int vb = (int)(uintptr_t)V_lds + v_rd_base(lane) + (cb >> 2) * SHM_V + (cb & 3) * 512;
#define TRRDG(dst, off) asm volatile("ds_read_b64_tr_b16 %0, %1 offset:%2" : "=&v"(dst) : "v"(vb), "i"(off) : "memory")
            s16x4 l0, l1, l2, l3, h0, h1, h2, h3;
            TRRDG(l0, 0); TRRDG(h0, 2048); TRRDG(l1, 4096); TRRDG(h1, 6144); TRRDG(l2, 8192); TRRDG(h2, 10240); TRRDG(l3, 12288); TRRDG(h3, 14336);
            asm volatile("s_waitcnt lgkmcnt(0)" ::: "memory"); SBAR();
            o[cbi] = __builtin_amdgcn_mfma_f32_32x32x16_bf16(pa0, (bf16x8){l0[0], l0[1], l0[2], l0[3], h0[0], h0[1], h0[2], h0[3]}, o[cbi], 0, 0, 0);
            o[cbi] = __builtin_amdgcn_mfma_f32_32x32x16_bf16(pa1, (bf16x8){l1[0], l1[1], l1[2], l1[3], h1[0], h1[1], h1[2], h1[3]}, o[cbi], 0, 0, 0);
            o[cbi] = __builtin_amdgcn_mfma_f32_32x32x16_bf16(pa2, (bf16x8){l2[0], l2[1], l2[2], l2[3], h2[0], h2[1], h2[2], h2[3]}, o[cbi], 0, 0, 0);
            o[cbi] = __builtin_amdgcn_mfma_f32_32x32x16_bf16(pa3, (bf16x8){l3[0], l3[1], l3[2], l3[3], h3[0], h3[1], h3[2], h3[3]}, o[cbi], 0, 0, 0);
#undef TRRDG
            const bf16* SPc = WSP(bf16, A_SPREV) + ((size_t)(chunk * 4 + h) * 256 + cb * 32 + r32) * 128 + hi * 8;
            bf16x8 sf[8];
#pragma unroll
            for (int d0 = 0; d0 < 8; ++d0) sf[d0] = load8(SPc + d0 * 16);
#pragma unroll
            for (int d0 = 0; d0 < 8; ++d0) o[cbi] = __builtin_amdgcn_mfma_f32_32x32x16_bf16(qf[d0], sf[d0], o[cbi], 0, 0, 0);
        }
        float ss[16];
#pragma unroll
        for (int r = 0; r < 16; ++r) { float s = o[0][r] * o[0][r] + o[1][r] * o[1][r];
            s += __shfl_xor(s, 1); s += __shfl_xor(s, 2); s += __shfl_xor(s, 4); s += __shfl_xor(s, 8); s += __shfl_xor(s, 16); ss[r] = s; }
        if (r32 == 0) {
#pragma unroll
            for (int r = 0; r < 16; ++r) RS[(rb * 32 + crow(r, hi)) * 4 + cp] = ss[r]; }
        __syncthreads();
        float grv[16][2];
#pragma unroll
        for (int r = 0; r < 16; ++r)
#pragma unroll
            for (int cbi = 0; cbi < 2; ++cbi) grv[r][cbi] = mk::bf2f(PR[(size_t)(rb * 32 + crow(r, hi)) * NP + P_GR + h * 256 + (2 * cp + cbi) * 32 + r32]);
        const float go0 = gO[(2 * cp) * 32 + r32], go1 = gO[(2 * cp + 1) * 32 + r32];
#pragma unroll
        for (int r = 0; r < 16; ++r) { const int rr = rb * 32 + crow(r, hi); const f32x4 t = *(const f32x4*)(RS + rr * 4);
            const float rs = rsqrtf(((t.x + t.y) + (t.z + t.w)) * (1.f / 256.f) + EPS);
#pragma unroll
            for (int cbi = 0; cbi < 2; ++cbi) { const int col = (2 * cp + cbi) * 32 + r32;
                const float gr = grv[r][cbi];
                const float v = o[cbi][r] * rs * (cbi ? go1 : go0) * (gr * fast_sigmoid(gr));
                const float vn = __shfl_xor(v, 1);
                if ((r32 & 1) == 0) *(unsigned*)(WSP(bf16, A_OB) + (size_t)(row0 + rr) * 1024 + h * 256 + col) = cvtpk(v, vn); } }
    }
    __syncthreads();
#undef PK4G
}

__device__ __forceinline__ void phase_attn(const Frame& F0, unsigned char* lds_generic, int l) {
    const Frame F = relaunder(F0);
    for (int it = lnd_s((int)blockIdx.x); it < 256; it += F.G) {
        ArgsP a = get_args();
        const int h = it & 7, idx = it >> 3, mixer = idx >> 4, x = idx & 15;
        if (mixer == 0) {
            const att::HeadRef H{WSP(bf16_t, A_MQ) + (size_t)h * S * 192, WSP(bf16_t, A_MK) + (size_t)h * S * 192, WSP(bf16_t, A_MV) + (size_t)h * S * 128, WSP(bf16_t, A_OA) + h * 128, nullptr};
            att::Seam<true> Sm;
            att::prime<true>(H, x, (char*)lds_generic, Sm);
            for (int pass = 0; pass < 2; ++pass) att::block<true>(H, pass ? 31 - x : x, 31 - x, (char*)lds_generic, Sm);
        } else {
            const att::HeadRef H{WSP(bf16_t, A_FQ) + (size_t)h * S * 128, WSP(bf16_t, A_FK) + (size_t)h * S * 128, WSP(bf16_t, A_PROJ) + P_FV + h * 128, WSP(bf16_t, A_OC) + h * 128, WSP(float, A_FCUM) + (size_t)h * S};
            att::Seam<false> Sm;
            att::prime<false>(H, x, (char*)lds_generic, Sm);
            for (int pass = 0; pass < 2; ++pass) att::block<false>(H, pass ? 31 - x : x, 31 - x, (char*)lds_generic, Sm);
        }
    }
}
__device__ __forceinline__ void phase_gla_out(const Frame& F0, unsigned char* lds_generic, int l) {
    const Frame F = relaunder(F0);
    for (int it = lnd_s((int)blockIdx.x); it < 256; it += F.G) {
        ArgsP a = get_args();
        const int h = it & 7, idx = it >> 3;
        if ((idx >> 4) == 1) gla_out_unit(F, (char*)lds_generic, h * 16 + (idx & 15), l, a);
    }
}

__global__ void __launch_bounds__(NTHREADS, 2) mk_fwd(Args args_unused) {
    extern __shared__ __attribute__((aligned(16))) unsigned char lds[];
    Frame F;
    F.lds = (LAS unsigned char*)lds; F.MISC = (volatile LAS unsigned*)(F.lds + MISC_OFF);
    F.tid = threadIdx.x; F.lane = F.tid & 63; F.wave = __builtin_amdgcn_readfirstlane(F.tid >> 6);
    F.G = gridDim.x; { const int bx = blockIdx.x; F.vcu = (F.G % 8 == 0) ? (bx % 8) * (F.G / 8) + bx / 8 : bx; }
    for (int u = F.tid; u < (LDS_BYTES - LDSCTL_OFF) / 4; u += NTHREADS) ((LAS unsigned*)(F.lds + LDSCTL_OFF))[u] = 0u;
    __syncthreads();
    XcdBarrier bar;
    { ArgsP a = get_args(); F.ctl = (gu32*)(a->ws + WS_CTL); bar = xcd_barrier_post((unsigned*)(F.ctl + CW_BAR) + a->li * XCD_BAR_WORDS, F.MISC + 8); }
    int l_lo, l_hi, lo, hi, lazy;
    { ArgsP a = get_args(); const int p0 = a->pro_lo, p1 = a->pro_hi; l_lo = a->l_lo; l_hi = a->l_hi; lo = a->ph_lo; hi = a->ph_hi; lazy = a->pad;
      if (p0 == 0 && p1 > 0) rope_tables(F);
      prologue_weights(F, p0, p1);
      if (p0 == 0 && p1 > 0 && l_lo == 0 && l_hi > 0 && lo == 0) phase_rms0(F, a->in[0], WSP(bf16_t, A_XR), WSP(float, A_SSPA));
      if (p1 > p0 && l_hi > l_lo) xcd_barrier(bar); }

#define IN(k) (lo <= (k) && (k) < hi)
#define SEAM(k) do { if (!(l == l_hi - 1 && (k) == hi - 1)) xcd_barrier(bar); } while (0)
#define WB(off) ((const bf16_t*)(a->ws + WS_W + (size_t)l * WSTRIDE + (off)))
    for (int l = l_lo; l < l_hi; ++l) {
        if (IN(1)) { { ArgsP a = get_args();
            pg8::Gemm g{WSP(bf16_t, A_XR), WB(LW_WIN), S, NP, DM, DM, DM}; pg8::StaticOrder So; So.init(S, NP, lnd_s(F.G), lnd_s((int)blockIdx.x));
            { const int pm0 = first_unit_pm(NP / 256, lnd_s(F.G), lnd_s((int)blockIdx.x)); if (pm0 >= 0) fill_rstd_table(F, WSP(float, A_SSPA), pm0); }
            EpiStoreBf16 E{WSP(bf16_t, A_PROJ), NP, (const LAS float*)(F.lds + RT_OFF)};
            pg8::gemm_phase<EpiStoreBf16, pg8::StaticOrder, true, true>(F.lds + RING_OFF, g, So, E); }
            if (lazy && (int)blockIdx.x >= 256 - CV_W1) convert_slice(F, l, CV_B1, (int)blockIdx.x - (256 - CV_W1), CV_W1, CV_R1);
            SEAM(1);
        }
        if (IN(2)) { phase_prep(F, l); SEAM(2); }
        if (IN(3)) { {
            gla_scan(F);
            pg8::StaticOrder So; So.init(S, 2048, lnd_s(F.G), lnd_s((int)blockIdx.x));
            { ArgsP a = get_args(); pg8::Gemm g{WSP(bf16_t, A_CQN), WB(LW_WUQ), S, 2048, 512, 1024, 512};
              EpiMlaQ E{WSP(bf16_t, A_MQ), a->in[8] + l * 192, WSP(float, A_CS)};
              pg8::gemm_phase<EpiMlaQ, pg8::StaticOrder, false, true>(F.lds + RING_OFF, g, So, E); }
            { ArgsP a = get_args(); pg8::Gemm g{WSP(bf16_t, A_CQN) + 512, WB(LW_WUKV), S, 2048, 512, 1024, 512};
              EpiMlaKV E{WSP(bf16_t, A_MK), WSP(bf16_t, A_MV), a->in[9] + l * 192, WSP(float, A_KRR), WSP(float, A_KRSS)};
              pg8::gemm_phase<EpiMlaKV, pg8::StaticOrder, false, true>(F.lds + RING_OFF, g, So, E); } }
            SEAM(3);
        }
        if (IN(4)) { { phase_attn(F, lds + RING_OFF, l); phase_gla_out(F, lds + RING_OFF, l); }
            if (lazy && (int)blockIdx.x >= 256 - CV_W4) convert_slice(F, l, CV_B4, (int)blockIdx.x - (256 - CV_W4), CV_W4, CV_R4);
            SEAM(4); }
        if (IN(5)) { { ArgsP a = get_args();
            BranchOrder So; So.init(lnd_s(F.G), lnd_s((int)blockIdx.x));
            pg8::Gemm g{WSP(bf16_t, A_OA), WB(LW_WBR), 3 * S, 3 * DM, 1024, 1024, 1024};
            EpiGateMergeAll E{WSP(bf16_t, A_PROJ) + P_GATES, NP, WSP(bf16_t, A_MERGED), WSP(bf16_t, A_HN), DM};
            pg8::gemm_phase<EpiGateMergeAll, BranchOrder, true, true>(F.lds + RING_OFF, g, So, E); }
            SEAM(5);
        }
        if (IN(6)) { { ArgsP a = get_args();
            pg8::Gemm g{WSP(bf16_t, A_HN), WB(LW_WOUT), S, DM, DM, DM, DM}; pg8::StaticOrder So; So.init(S, DM, lnd_s(F.G), lnd_s((int)blockIdx.x));
            EpiResidNorm E{(l == 0) ? (const void*)a->in[0] : (const void*)WSP(bf16_t, A_XR), (void*)WSP(bf16_t, A_XR), DM, WSP(float, A_SSPB), 1, (l == 0) ? 0 : 1, 1};
            pg8::gemm_phase<EpiResidNorm, pg8::StaticOrder, false, true>(F.lds + RING_OFF, g, So, E); }
            SEAM(6);
        }
        if (IN(8)) { { ArgsP a = get_args();
            pg8::Gemm g{WSP(bf16_t, A_XR), WB(LW_WGU), S, 2 * FFH, DM, DM, DM}; pg8::StaticOrder So; So.init(S, 2 * FFH, lnd_s(F.G), lnd_s((int)blockIdx.x));
            { const int pm0 = first_unit_pm(2 * FFH / 256, lnd_s(F.G), lnd_s((int)blockIdx.x)); if (pm0 >= 0) fill_rstd_table(F, WSP(float, A_SSPB), pm0); }
            EpiSwiglu E{WSP(bf16_t, A_PROJ), FFH, (const LAS float*)(F.lds + RT_OFF)};
            pg8::gemm_phase<EpiSwiglu, pg8::StaticOrder, true, true>(F.lds + RING_OFF, g, So, E); }
            if (lazy && (int)blockIdx.x >= 256 - CV_W8) convert_slice(F, l + 1, CV_B8, (int)blockIdx.x - (256 - CV_W8), CV_W8, CV_R8);
            SEAM(8);
        }
        if (IN(9)) { { ArgsP a = get_args();
            pg8::Gemm g{WSP(bf16_t, A_PROJ), WB(LW_WDN), S, DM, FFH, FFH, FFH}; pg8::StaticOrder So; So.init(S, DM, lnd_s(F.G), lnd_s((int)blockIdx.x));
            EpiResidNorm E{(const void*)WSP(bf16_t, A_XR), (l + 1 < DEPTH) ? (void*)WSP(bf16_t, A_XR) : (void*)a->out, DM, WSP(float, A_SSPA), (l + 1 < DEPTH) ? 1 : 0, 1, (l + 1 < DEPTH) ? 1 : 0};
            pg8::gemm_phase<EpiResidNorm, pg8::StaticOrder, false, true>(F.lds + RING_OFF, g, So, E); }
            SEAM(9);
        }
    }
#undef IN
#undef SEAM
}

}

extern "C" void kernel_launch(void* const* d_in, const int* in_sizes, int n_in, void* d_out, int out_size, void* d_ws, size_t ws_size, hipStream_t stream) {
    static int grid = 0;
    if (grid == 0) {
        int dev = 0, cus = 0;
        if (n_in != 21 || out_size != S * DM || ws_size < mk::A_END) { fprintf(stderr, "kernel_launch: unexpected shapes / workspace (%d inputs, out %d, ws %zu < %zu)\n", n_in, out_size, ws_size, (size_t)mk::A_END); grid = -1; return; }
        if (hipGetDevice(&dev) != hipSuccess || hipDeviceGetAttribute(&cus, hipDeviceAttributeMultiprocessorCount, dev) != hipSuccess) { grid = -1; return; }
        if (hipFuncSetAttribute((const void*)mk::mk_fwd, hipFuncAttributeMaxDynamicSharedMemorySize, mk::LDS_BYTES) != hipSuccess) { fprintf(stderr, "hipFuncSetAttribute failed\n"); grid = -1; return; }
        int per_cu = 0;
        if (hipOccupancyMaxActiveBlocksPerMultiprocessor(&per_cu, (const void*)mk::mk_fwd, mk::NTHREADS, mk::LDS_BYTES) != hipSuccess || per_cu < 1) { fprintf(stderr, "occupancy query: %d blocks per CU\n", per_cu); (void)hipGetLastError(); }
        grid = cus;
        if (cus != 256) { fprintf(stderr, "kernel_launch: this kernel's unit deal (one 256x256 unit per workgroup in the N = 2048 GEMM phases, one row panel per workgroup in the wide ones) needs exactly 256 CUs, found %d\n", cus); grid = -1; return; }
    }
    if (grid < 0) return;
    (void)hipMemsetAsync((unsigned char*)d_ws + mk::WS_CTL, 0, mk::CTL_ZERO_BYTES, stream);
    mk::Args a{};
    for (int i = 0; i < 21; ++i) a.in[i] = (const float*)d_in[i];
    a.out = (float*)d_out; a.ws = (unsigned char*)d_ws;
    const int lazy = (grid == 256) ? 1 : 0;
    a.pro_lo = 0; a.pro_hi = lazy ? 1 : DEPTH; a.l_lo = 0; a.l_hi = DEPTH; a.ph_lo = 0; a.ph_hi = 10; a.li = 0; a.pad = lazy;
    mk::mk_fwd<<<dim3(grid), mk::NTHREADS, mk::LDS_BYTES, stream>>>(a);
}
```

```cpp
#include <hip/hip_runtime.h>
#include <cstdio>
#include <cstdint>

constexpr int S = 8192, DM = 2048, DEPTH = 4;
constexpr int D_IN = 13400, FFH = 5632;
constexpr int C_CQ = 0, C_CKV = 512, C_KR = 1024, C_GQ = 1088, C_GK = 1600, C_GV = 2112, C_GA = 3136, C_GR = 3152,
              C_FQ = 4176, C_FK = 5200, C_FV = 6224, C_FL = 7248, C_GATES = 7256;
constexpr float EPS = 1e-6f;
#define MK_WSTRIDE 149946368ull
constexpr int NP_G = 13568;


namespace pg8 {
#define PG8_LAS __attribute__((address_space(3)))
typedef unsigned short bf16_t;
typedef short bf16x8 __attribute__((ext_vector_type(8)));
typedef float f32x4 __attribute__((ext_vector_type(4)));
typedef unsigned u32x4 __attribute__((ext_vector_type(4)));
constexpr int BM = 256, BK = 64, HALF = 128, HTB = HALF * BK * 2  , STAGE_BYTES = 8 * HTB, NXCD = 8, WGM = 8;

__host__ __device__ __forceinline__ int lds_byte(int r, int c) { const int st = (r >> 4) * 2 + (c >> 5), rr = r & 15, cc = c & 31, ob = rr * 64 + cc * 2; return st * 1024 + (ob ^ (((ob >> 9) & 1) << 5)); }
__host__ __device__ __forceinline__ void stage_rc(int b, int& R, int& C) { const int st = b / 1024, sb = b % 1024, swz = sb ^ (((sb >> 9) & 1) << 5); R = (st >> 1) * 16 + swz / 64; C = (st & 1) * 32 + (swz % 64) / 2; }
__host__ __device__ __forceinline__ int perm32(int rho) { const int n = rho >> 4, i = rho & 15; return 8 * (i >> 2) + 4 * n + (i & 3); }

struct Unit { int pm, pn; };
struct Gemm { const bf16_t* A; const bf16_t* Bt; int M, N, K, lda, ldb; };

struct StaticOrder {
    int nM, nN, nwg, G, c;
    __host__ __device__ void init(int M, int N, int G_, int c_) { nM = M / BM; nN = N / BM; nwg = nM * nN; G = G_; c = c_; }
    __host__ __device__ bool next(int i, Unit& u) const {
        const long L = (long)i * G + c; if (L >= nwg) return false;
        int wgid = (int)L; { const int q = nwg / NXCD, r = nwg % NXCD, xcd = wgid % NXCD, off = wgid / NXCD; wgid = (xcd < r ? xcd * (q + 1) : r * (q + 1) + (xcd - r) * q) + off; }
        const int nig = WGM * nN, gid = wgid / nig, fm = gid * WGM, gsz = (nM - fm) < WGM ? (nM - fm) : WGM;
        u.pm = fm + ((wgid % nig) % gsz); u.pn = (wgid % nig) / gsz; return true;
    }
    __device__ __forceinline__ void a_ready(const Unit&) const {}
    __device__ __forceinline__ void done(const Unit&) const {}
};

__device__ __forceinline__ unsigned cvt_pk_bf16(float lo, float hi) { unsigned r; asm volatile("v_cvt_pk_bf16_f32 %0, %1, %2" : "=v"(r) : "v"(lo), "v"(hi)); return r; }
template <class Epi, class Sched, bool ALIGN_EPI = false, bool SP2 = false>
__device__ __forceinline__ void gemm_phase(PG8_LAS unsigned char* lds, const Gemm g, const Sched& S, const Epi& E) {
    int tid_ = threadIdx.x; asm volatile("" : "+v"(tid_));
    const int tid = tid_, wid = __builtin_amdgcn_readfirstlane(tid >> 6), lane = tid & 63, wr = wid >> 2, wc = wid & 3, fr = lane & 15, fq = lane >> 4;
    const int K = g.K, nt = K / BK;
    unsigned voffA[2], voffB[2];
#pragma unroll
    for (int i = 0; i < 2; ++i) { int R, C; stage_rc(tid * 16 + i * 8192, R, C); const int Rb = Epi::PERM ? ((R & ~31) + perm32(R & 31)) : R;
        voffA[i] = (unsigned)(R * g.lda + C) * 2u; voffB[i] = (unsigned)(Rb * g.ldb + C) * 2u; }
    const size_t kstep = (size_t)(BK * 2);
    const size_t hstepA = (size_t)HALF * g.lda * 2, hstepB = (size_t)HALF * g.ldb * 2;
    const size_t tstepA = 2 * hstepA, tstepB = 2 * hstepB;
    const unsigned ldsw = (unsigned)wid * 1024u;
    const int aoff = lds_byte(wr * 64 + fr, fq * 8), boff = lds_byte(wc * 32 + fr, fq * 8);
#define PG8_SA(b, h) (((b) * 2 + (h)) * HTB)
#define PG8_SB(b, h) ((4 + (b) * 2 + (h)) * HTB)
#define PG8_STAGE(bufoff, gbase, voff) do { _Pragma("unroll") for (int _i = 0; _i < 2; ++_i) \
        __builtin_amdgcn_global_load_lds((const unsigned*)((const char*)(gbase) + (voff)[_i]), (PG8_LAS unsigned*)(lds + (bufoff) + ldsw + _i * 8192), 16, 0, 0); } while (0)
#define PG8_LDA(dst, b, h) do { _Pragma("unroll") for (int m = 0; m < 4; ++m) _Pragma("unroll") for (int k = 0; k < 2; ++k) dst[m][k] = *(const PG8_LAS bf16x8*)(lds + PG8_SA(b, h) + aoff + m * 2048 + k * 1024); } while (0)
#define PG8_LDB(dst, b, h) do { _Pragma("unroll") for (int n = 0; n < 2; ++n) _Pragma("unroll") for (int k = 0; k < 2; ++k) dst[n][k] = *(const PG8_LAS bf16x8*)(lds + PG8_SB(b, h) + boff + n * 2048 + k * 1024); } while (0)
#define PG8_MMA(ai, bj, At, Bt) do { __builtin_amdgcn_s_setprio(1); _Pragma("unroll") for (int m = 0; m < 4; ++m) _Pragma("unroll") for (int n = 0; n < 2; ++n) _Pragma("unroll") for (int k = 0; k < 2; ++k) \
        acc[ai][bj][m][n] = __builtin_amdgcn_mfma_f32_16x16x32_bf16(Bt[n][k], At[m][k], acc[ai][bj][m][n], 0, 0, 0); __builtin_amdgcn_s_setprio(0); } while (0)
#define PG8_WAIT_V(n) asm volatile("s_waitcnt vmcnt(" #n ")" ::: "memory")
#define PG8_WAIT_L(n) asm volatile("s_waitcnt lgkmcnt(" #n ")" ::: "memory")
#define PG8_BAR __builtin_amdgcn_s_barrier()
#define PG8_SCHED __builtin_amdgcn_sched_barrier(0)
    Unit cur, nxt; int ui = 0;
    if (!S.next(0, cur)) return;
    f32x4 acc[2][2][4][2];
#pragma unroll
    for (int a = 0; a < 2; ++a)
#pragma unroll
        for (int b = 0; b < 2; ++b)
#pragma unroll
            for (int m = 0; m < 4; ++m)
#pragma unroll
                for (int n = 0; n < 2; ++n) acc[a][b][m][n] = (f32x4){0.f, 0.f, 0.f, 0.f};
    bf16x8 At[4][2], B0[2][2], B1[2][2];
    const char* cA = (const char*)g.A + (size_t)cur.pm * tstepA; const char* cB = (const char*)g.Bt + (size_t)cur.pn * tstepB;
    S.a_ready(cur);
    if constexpr (SP2) {
        PG8_STAGE(PG8_SB(0, 0), cB, voffB); PG8_STAGE(PG8_SB(0, 1), cB + hstepB, voffB); PG8_STAGE(PG8_SA(0, 0), cA, voffA); PG8_STAGE(PG8_SA(0, 1), cA + hstepA, voffA);
        if (wr == 1) PG8_BAR;
        PG8_WAIT_V(2); PG8_BAR;
        PG8_STAGE(PG8_SB(1, 0), cB + kstep, voffB); PG8_STAGE(PG8_SA(1, 0), cA + kstep, voffA); PG8_STAGE(PG8_SB(1, 1), cB + hstepB + kstep, voffB);
        PG8_WAIT_V(6); PG8_BAR;
    } else {
        PG8_STAGE(PG8_SB(0, 0), cB, voffB); PG8_STAGE(PG8_SA(0, 0), cA, voffA); PG8_STAGE(PG8_SB(0, 1), cB + hstepB, voffB); PG8_STAGE(PG8_SA(0, 1), cA + hstepA, voffA);
        if (wr == 1) PG8_BAR;
        PG8_WAIT_V(4); PG8_BAR;
        PG8_STAGE(PG8_SB(1, 0), cB + kstep, voffB); PG8_STAGE(PG8_SA(1, 0), cA + kstep, voffA); PG8_STAGE(PG8_SB(1, 1), cB + hstepB + kstep, voffB);
        PG8_WAIT_V(6); PG8_BAR;
    }
    for (;;) {
        const bool has_next = S.next(ui + 1, nxt);
        const char* nA = has_next ? (const char*)g.A + (size_t)nxt.pm * tstepA : cA; const char* nB = has_next ? (const char*)g.Bt + (size_t)nxt.pn * tstepB : cB;
        for (int t = 0; t < nt; t += 2) {
            const bool last = (t == nt - 2);
            const char* a1 = cA + (size_t)(t + 1) * kstep;
            const char* a2 = last ? nA : cA + (size_t)(t + 2) * kstep; const char* b2 = last ? nB : cB + (size_t)(t + 2) * kstep;
            const char* a3 = a2 + kstep; const char* b3 = b2 + kstep;
            if (last && has_next) S.a_ready(nxt);
            if constexpr (SP2) {
            PG8_LDB(B0, 0, 0); PG8_LDB(B1, 0, 1); PG8_SCHED; PG8_LDA(At, 0, 0); PG8_STAGE(PG8_SA(1, 1), a1 + hstepA, voffA);
            PG8_WAIT_V(8); PG8_WAIT_L(0); PG8_BAR; PG8_MMA(0, 0, At, B0); PG8_MMA(0, 1, At, B1); PG8_BAR; PG8_SCHED;
            PG8_LDA(At, 0, 1); PG8_STAGE(PG8_SB(0, 0), b2, voffB); PG8_STAGE(PG8_SB(0, 1), b2 + hstepB, voffB); PG8_STAGE(PG8_SA(0, 0), a2, voffA);
            PG8_WAIT_V(8); PG8_WAIT_L(0); PG8_BAR; PG8_MMA(1, 0, At, B0); PG8_MMA(1, 1, At, B1); PG8_BAR; PG8_SCHED;
            PG8_LDB(B0, 1, 0); PG8_LDB(B1, 1, 1); PG8_SCHED; PG8_LDA(At, 1, 0); PG8_STAGE(PG8_SA(0, 1), a2 + hstepA, voffA);
            PG8_WAIT_V(8); PG8_WAIT_L(0); PG8_BAR; PG8_MMA(0, 0, At, B0); PG8_MMA(0, 1, At, B1); PG8_BAR; PG8_SCHED;
            PG8_LDA(At, 1, 1); PG8_STAGE(PG8_SB(1, 0), b3, voffB); PG8_STAGE(PG8_SB(1, 1), b3 + hstepB, voffB); PG8_STAGE(PG8_SA(1, 0), a3, voffA);
            PG8_WAIT_V(8); PG8_WAIT_L(0); PG8_BAR; PG8_MMA(1, 0, At, B0); PG8_MMA(1, 1, At, B1); PG8_BAR; PG8_SCHED;
            } else {
            PG8_LDB(B0, 0, 0); PG8_SCHED; PG8_LDA(At, 0, 0); PG8_STAGE(PG8_SA(1, 1), a1 + hstepA, voffA);
            PG8_WAIT_L(8); PG8_BAR; PG8_WAIT_L(0); PG8_MMA(0, 0, At, B0); PG8_BAR; PG8_SCHED;
            PG8_LDB(B1, 0, 1); PG8_STAGE(PG8_SB(0, 0), b2, voffB);
            PG8_BAR; PG8_WAIT_L(0); PG8_MMA(0, 1, At, B1); PG8_BAR;
            PG8_LDA(At, 0, 1); PG8_STAGE(PG8_SA(0, 0), a2, voffA);
            PG8_BAR; PG8_WAIT_L(0); PG8_MMA(1, 0, At, B0); PG8_BAR; PG8_SCHED;
            PG8_STAGE(PG8_SB(0, 1), b2 + hstepB, voffB);
            PG8_WAIT_V(6); PG8_BAR; PG8_MMA(1, 1, At, B1); PG8_BAR;
            PG8_LDB(B0, 1, 0); PG8_SCHED; PG8_LDA(At, 1, 0); PG8_STAGE(PG8_SA(0, 1), a2 + hstepA, voffA);
            PG8_WAIT_L(8); PG8_BAR; PG8_WAIT_L(0); PG8_MMA(0, 0, At, B0); PG8_BAR; PG8_SCHED;
            PG8_LDB(B1, 1, 1); PG8_STAGE(PG8_SB(1, 0), b3, voffB);
            PG8_BAR; PG8_WAIT_L(0); PG8_MMA(0, 1, At, B1); PG8_BAR;
            PG8_LDA(At, 1, 1); PG8_STAGE(PG8_SA(1, 0), a3, voffA);
            PG8_BAR; PG8_WAIT_L(0); PG8_MMA(1, 0, At, B0); PG8_BAR; PG8_SCHED;
            PG8_STAGE(PG8_SB(1, 1), b3 + hstepB, voffB);
            PG8_WAIT_V(6); PG8_BAR; PG8_MMA(1, 1, At, B1); PG8_BAR;
            }
        }
        if constexpr (ALIGN_EPI) { if (wr == 0) PG8_BAR; }
        if constexpr (!Epi::AFTER_DRAIN) { E(acc, cur, wr, wc, fr, fq); S.done(cur); }
        if (!has_next) break;
#pragma unroll
        for (int a = 0; a < 2; ++a)
#pragma unroll
            for (int b = 0; b < 2; ++b)
#pragma unroll
                for (int m = 0; m < 4; ++m)
#pragma unroll
                    for (int n = 0; n < 2; ++n) acc[a][b][m][n] = (f32x4){0.f, 0.f, 0.f, 0.f};
        cur = nxt; cA = nA; cB = nB; ++ui;
        if constexpr (ALIGN_EPI) { if (wr == 1) PG8_BAR; }
    }
    PG8_WAIT_V(0);
    if constexpr (!ALIGN_EPI) { if (wr == 0) PG8_BAR; }
    PG8_BAR;
    if constexpr (Epi::AFTER_DRAIN) { E.fused(acc, cur, wr, wc, fr, fq, lds, wid, lane); S.done(cur); }
#undef PG8_SA
#undef PG8_SB
#undef PG8_STAGE
#undef PG8_LDA
#undef PG8_LDB
#undef PG8_MMA
#undef PG8_WAIT_V
#undef PG8_WAIT_L
#undef PG8_BAR
#undef PG8_SCHED
}
}

#define GAS __attribute__((address_space(1)))
#define LAS __attribute__((address_space(3)))
#define XB_TMO      128
#define XB_XCNT(j)  (256  + 64 * (j))
#define XB_XSUB(j)  (1280 + 64 * (j))
#define XB_XGEN(j)  (2304 + 64 * (j))
#define XB_TOP      3328
#define XB_TOPGEN   3392
#define XCD_BAR_WORDS 3456
#define XB_SPIN_CAP (1u << 18)

__device__ __forceinline__ unsigned xb_ld(unsigned* p)              { return __hip_atomic_load(p, __ATOMIC_RELAXED, __HIP_MEMORY_SCOPE_AGENT); }
__device__ __forceinline__ unsigned xb_add(unsigned* p, unsigned v) { return __hip_atomic_fetch_add(p, v, __ATOMIC_RELAXED, __HIP_MEMORY_SCOPE_AGENT); }
__device__ __forceinline__ unsigned xb_xcc_id() { return (unsigned)__builtin_amdgcn_s_getreg((3 << 11) | 20) & 0xFu; }
#define XB_SPIN(cond, bar) do { unsigned _sp = 0; while (cond) { __builtin_amdgcn_s_sleep(1); \
    if ((++_sp & 255u) == 0u) { if (xb_ld(&(bar)[XB_TMO])) break; if (_sp > XB_SPIN_CAP) { atomicAdd(&(bar)[XB_TMO], 1u); break; } } } } while (0)

struct XcdBarrier {
    unsigned* bar; unsigned x;
    volatile LAS unsigned* st;
};

__device__ __forceinline__ XcdBarrier xcd_barrier_post(unsigned* bar, volatile LAS unsigned* st) {
    XcdBarrier b; b.bar = bar; b.x = xb_xcc_id(); b.st = st;
    if (threadIdx.x == 0) (void)xb_add(&bar[XB_XCNT(b.x)], 1u);
    return b;
}
__device__ __forceinline__ void xcd_barrier_complete(unsigned* bar, unsigned x, unsigned& nloc, unsigned& nx) {
    const unsigned G = gridDim.x * gridDim.y * gridDim.z;
    unsigned sum, cnt, mine, sp = 0u;
    for (;;) {
        sum = 0u; cnt = 0u; mine = 0u;
#pragma unroll
        for (unsigned j = 0; j < 16; ++j) { const unsigned c = xb_ld(&bar[XB_XCNT(j)]); sum += c; cnt += (c > 0u) ? 1u : 0u; mine = (j == x) ? c : mine; }
        if (sum == G) break;
        __builtin_amdgcn_s_sleep(1);
        if ((++sp & 255u) == 0u) { if (xb_ld(&bar[XB_TMO])) break; if (sp > XB_SPIN_CAP) { atomicAdd(&bar[XB_TMO], 1u); break; } }
    }
    nloc = mine > 0u ? mine : 1u; nx = cnt > 0u ? cnt : 1u;
}

__device__ __forceinline__ void xcd_barrier(const XcdBarrier& b) {
    asm volatile("s_waitcnt vmcnt(0)" ::: "memory");
    __syncthreads();
    if (threadIdx.x == 0) {
        unsigned* bar = b.bar;
        __builtin_amdgcn_s_waitcnt(0);
        unsigned nloc = b.st[0], nx = b.st[1];
        if (nloc == 0u) { xcd_barrier_complete(bar, b.x, nloc, nx); b.st[0] = nloc; b.st[1] = nx; }
        const unsigned old = xb_add(&bar[XB_XSUB(b.x)], 1u);
        const unsigned gen = old / nloc;
        if (old + 1u == (gen + 1u) * nloc) {
            __builtin_amdgcn_fence(__ATOMIC_RELEASE, "agent");
            asm volatile("s_waitcnt vmcnt(0)" ::: "memory");
            const unsigned og = xb_add(&bar[XB_TOP], 1u);
            const unsigned tg = og / nx;
            if (og + 1u == (tg + 1u) * nx) xb_add(&bar[XB_TOPGEN], 1u);
            else XB_SPIN(xb_ld(&bar[XB_TOPGEN]) == tg, bar);
            __builtin_amdgcn_fence(__ATOMIC_ACQUIRE, "agent");
            xb_add(&bar[XB_XGEN(b.x)], 1u);
            asm volatile("s_waitcnt vmcnt(0)" ::: "memory");
        } else {
            XB_SPIN(xb_ld(&bar[XB_XGEN(b.x)]) == gen, bar);
            __builtin_amdgcn_fence(__ATOMIC_ACQUIRE, "agent");
            asm volatile("s_waitcnt vmcnt(0)" ::: "memory");
        }
    }
    __syncthreads();
}

namespace att {
__device__ __forceinline__ int mk_lnd_v(int v) { asm volatile("" : "+v"(v)); return v; }
typedef short bf16x8 __attribute__((ext_vector_type(8)));
typedef short s16x4 __attribute__((ext_vector_type(4)));
typedef float f32x16 __attribute__((ext_vector_type(16)));
typedef float f32x4 __attribute__((ext_vector_type(4)));
typedef unsigned u32x4 __attribute__((ext_vector_type(4)));
typedef unsigned short bf16;
constexpr int NW = 8, QBLK = 32, KVBLK = 64, QB = NW * QBLK;
constexpr int SHM_V = KVBLK * 128 * 2, SHM_K = 16 * 1152, SHM_KR = 8 * 1152;
constexpr int L_V = 0, L_K = 2 * SHM_V, L_KR = L_K + 2 * SHM_K, L_WS = L_KR + 2 * SHM_KR, L_X = L_WS + NW * 64 * 4;
constexpr int L_FB = L_X + 32768, L_END = L_X + 65536;
static_assert(L_END <= 163840 - 512, "attention LDS");
constexpr float THR = 8.f;
#define KLAY(row, chunk) ((chunk) * 1152 + (((chunk) & 7) + (row)) * 16)
#define SBAR() __builtin_amdgcn_sched_barrier(0)
__device__ __forceinline__ int v_st(int k, int c) { const int kk = (k & ~0xC) | ((k & 4) << 1) | ((k & 8) >> 1); return ((kk >> 3) * 4 + (c >> 5)) * 512 + ((kk & 7) * 32 + (c & 31)) * 2; }
__device__ __forceinline__ int v_rd_base(int lane) { return ((lane & 3) << 3) | (((lane >> 2) & 3) << 6) | (((lane >> 4) & 1) << 5) | (((lane >> 5) & 1) << 8); }
constexpr int v_rd_off(int d0, int ks, int half) { return d0 * 512 + ks * 4096 + half * 2048; }
__device__ __forceinline__ int crow(int r, int hi) { return (r & 3) + 8 * (r >> 2) + 4 * hi; }
__device__ __forceinline__ unsigned cvtpk(float lo, float hi) { unsigned r; asm volatile("v_cvt_pk_bf16_f32 %0, %1, %2" : "=v"(r) : "v"(lo), "v"(hi)); return r; }
__device__ __forceinline__ bf16x8 load8(const bf16* p) { return *reinterpret_cast<const bf16x8*>(p); }
typedef float f32x2c_t __attribute__((ext_vector_type(2))); typedef __bf16 bf16x2c_t __attribute__((ext_vector_type(2)));
__device__ __forceinline__ unsigned cvtpk_c(float lo, float hi) { f32x2c_t v = {lo, hi}; bf16x2c_t b = __builtin_convertvector(v, bf16x2c_t); return __builtin_bit_cast(unsigned, b); }

__device__ __forceinline__ void mask_tile(f32x16& p0, f32x16& p1, int dq) {
    const float NEG = -__builtin_inff();
#pragma unroll
    for (int r = 0; r < 16; ++r) {
        const int c = (r & 3) + 8 * (r >> 2);
        if (dq - c < 0) p0[r] = NEG;
        if (dq - c - 32 < 0) p1[r] = NEG;
    }
}
template <bool MLA>
__device__ __forceinline__ void partialSM(f32x16& p0, f32x16& p1, float& m_reg, float& mn, float& alpha) {
    constexpr float SCALE = MLA ? 0.07216878364870322f : 0.08838834764831845f;
    float pmax = p0[0];
#pragma unroll
    for (int r = 1; r < 16; ++r) pmax = fmaxf(pmax, p0[r]);
#pragma unroll
    for (int r = 0; r < 16; ++r) pmax = fmaxf(pmax, p1[r]);
    { auto rr = __builtin_amdgcn_permlane32_swap(__float_as_uint(pmax), __float_as_uint(pmax), false, false);
      pmax = fmaxf(__uint_as_float(rr[0]), __uint_as_float(rr[1])); }
    constexpr float C2 = 1.4426950408889634f * SCALE;
    if (__builtin_expect(__all((pmax - m_reg) * SCALE <= THR), 1)) { mn = m_reg; alpha = 1.f; }
    else { mn = fmaxf(m_reg, pmax); alpha = __builtin_amdgcn_exp2f((m_reg - mn) * C2); m_reg = mn; }
    const float mnL = -mn * C2;
#pragma unroll
    for (int r = 0; r < 16; ++r) p0[r] = fmaf(p0[r], C2, mnL);
#pragma unroll
    for (int r = 0; r < 16; ++r) p1[r] = fmaf(p1[r], C2, mnL);
#pragma unroll
    for (int r = 0; r < 16; ++r) p0[r] = __builtin_amdgcn_exp2f(p0[r]);
}
#define PK4(P, B_, OUT) do { unsigned a0 = cvtpk(P[B_+0], P[B_+1]), a1 = cvtpk(P[B_+2], P[B_+3]);                          \
        unsigned b0 = cvtpk(P[B_+4], P[B_+5]), b1 = cvtpk(P[B_+6], P[B_+7]);                                             \
        auto r0 = __builtin_amdgcn_permlane32_swap(a0, b0, false, false); auto r1 = __builtin_amdgcn_permlane32_swap(a1, b1, false, false); \
        u32x4 w = {r0[0], r1[0], r0[1], r1[1]}; OUT = *reinterpret_cast<bf16x8*>(&w); } while (0)
__device__ __forceinline__ void finishSM(f32x16& p0, f32x16& p1, float alpha, float& l_reg, bf16x8& pa0, bf16x8& pa1, bf16x8& pa2, bf16x8& pa3) {
#pragma unroll
    for (int r = 0; r < 16; ++r) p1[r] = __builtin_amdgcn_exp2f(p1[r]);
    float ps = 0;
#pragma unroll
    for (int r = 0; r < 16; ++r) ps += p0[r];
#pragma unroll
    for (int r = 0; r < 16; ++r) ps += p1[r];
    { auto rr = __builtin_amdgcn_permlane32_swap(__float_as_uint(ps), __float_as_uint(ps), false, false);
      ps = __uint_as_float(rr[0]) + __uint_as_float(rr[1]); }
    l_reg = l_reg * alpha + ps;
    PK4(p0, 0, pa0); PK4(p0, 8, pa1); PK4(p1, 0, pa2); PK4(p1, 8, pa3);
}
template <int KB, bool MLA, bool BIAS>
__device__ __forceinline__ void qkt(f32x16& p0, f32x16& p1, const char* lds, int r32, int hi, const bf16x8* qr, int krb, int qrb, int fbb) {
    if constexpr (BIAS) {
        const char* fbp = lds + L_FB + fbb;
#pragma unroll
        for (int g_ = 0; g_ < 4; ++g_) { const f32x4 b0_ = *(const f32x4*)(fbp + g_ * 32), b1_ = *(const f32x4*)(fbp + 128 + g_ * 32);
#pragma unroll
            for (int e_ = 0; e_ < 4; ++e_) { p0[4 * g_ + e_] = b0_[e_]; p1[4 * g_ + e_] = b1_[e_]; } }
    } else { p0 = f32x16{}; p1 = f32x16{}; }
    const char* K_lds = lds + L_K;
    const char* kbase = K_lds + KB * SHM_K + r32 * 16 + hi * 1168;
    constexpr int NQR = MLA ? 12 : 8;
    const char* qq = lds + L_X + qrb;
#pragma unroll
    for (int d0 = 0; d0 < 8; ++d0) {
        bf16x8 b0 = *reinterpret_cast<const bf16x8*>(kbase + KLAY(0, 2 * d0));
        bf16x8 b1 = *reinterpret_cast<const bf16x8*>(kbase + KLAY(32, 2 * d0));
        bf16x8 q; if (d0 < NQR) q = qr[d0]; else q = *reinterpret_cast<const bf16x8*>(qq + (d0 - NQR) * 1024);
        p0 = __builtin_amdgcn_mfma_f32_32x32x16_bf16(b0, q, p0, 0, 0, 0);
        p1 = __builtin_amdgcn_mfma_f32_32x32x16_bf16(b1, q, p1, 0, 0, 0); }
    if constexpr (MLA) {
        const char* kr = lds + L_KR + KB * SHM_KR + krb;
#pragma unroll
        for (int dr = 0; dr < 4; ++dr) {
            bf16x8 b0 = *reinterpret_cast<const bf16x8*>(kr + KLAY(0, 2 * dr));
            bf16x8 b1 = *reinterpret_cast<const bf16x8*>(kr + KLAY(32, 2 * dr));
            bf16x8 q; if (8 + dr < NQR) q = qr[8 + dr]; else q = *reinterpret_cast<const bf16x8*>(qq + (8 + dr - NQR) * 1024);
            p0 = __builtin_amdgcn_mfma_f32_32x32x16_bf16(b0, q, p0, 0, 0, 0);
            p1 = __builtin_amdgcn_mfma_f32_32x32x16_bf16(b1, q, p1, 0, 0, 0); }
    }
}
template <int VB>
__device__ __forceinline__ void pv_tile(f32x16* o, int vb0, bf16x8 pa0, bf16x8 pa1, bf16x8 pa2, bf16x8 pa3) {
#define TRRD(dst, off) asm volatile("ds_read_b64_tr_b16 %0, %1 offset:%2" : "=&v"(dst) : "v"(vb0), "i"(off) : "memory")
#define PV_D0(d0) do { s16x4 l0, l1, l2, l3, h0, h1, h2, h3; constexpr int b_ = VB * SHM_V + v_rd_off(d0, 0, 0);   \
        TRRD(l0, b_); TRRD(h0, b_ + 2048); TRRD(l1, b_ + 4096); TRRD(h1, b_ + 6144); TRRD(l2, b_ + 8192); TRRD(h2, b_ + 10240); TRRD(l3, b_ + 12288); TRRD(h3, b_ + 14336); \
        asm volatile("s_waitcnt lgkmcnt(0)" ::: "memory"); SBAR();   \
        o[d0] = __builtin_amdgcn_mfma_f32_32x32x16_bf16(pa0, (bf16x8){l0[0], l0[1], l0[2], l0[3], h0[0], h0[1], h0[2], h0[3]}, o[d0], 0, 0, 0);   \
        o[d0] = __builtin_amdgcn_mfma_f32_32x32x16_bf16(pa1, (bf16x8){l1[0], l1[1], l1[2], l1[3], h1[0], h1[1], h1[2], h1[3]}, o[d0], 0, 0, 0);   \
        o[d0] = __builtin_amdgcn_mfma_f32_32x32x16_bf16(pa2, (bf16x8){l2[0], l2[1], l2[2], l2[3], h2[0], h2[1], h2[2], h2[3]}, o[d0], 0, 0, 0);   \
        o[d0] = __builtin_amdgcn_mfma_f32_32x32x16_bf16(pa3, (bf16x8){l3[0], l3[1], l3[2], l3[3], h3[0], h3[1], h3[2], h3[3]}, o[d0], 0, 0, 0); } while (0)
    PV_D0(0); PV_D0(1); PV_D0(2); PV_D0(3);
#undef PV_D0
#undef TRRD
}

struct HeadRef { const bf16* Q; const bf16* K; const bf16* V; bf16* O; const float* FS; };
template <bool MLA> struct Seam { bf16x8 qr[MLA ? 12 : 8]; bf16x8 st_v0, st_v1, st_k0, st_k1; bf16x8 st_kr; bf16x8 ql[1]; };
template <bool MLA> struct Geo {
    static constexpr int QP = MLA ? 192 : 128, KP = MLA ? 192 : 128, VP = MLA ? 128 : NP_G, OP = 1024;
};
#define VMW() asm volatile("s_waitcnt vmcnt(0)" ::: "memory")
#define VMWN(n) asm volatile("s_waitcnt vmcnt(%0)" :: "i"(n) : "memory")
#define SLOAD_H(Kp, Vp, k0) do { S.st_v0 = load8((Vp) + (size_t)((k0) + sr) * G::VP + sc); S.st_v1 = load8((Vp) + (size_t)((k0) + 32 + sr) * G::VP + sc);              \
                         S.st_k0 = load8((Kp) + (size_t)((k0) + sr) * G::KP + sc); S.st_k1 = load8((Kp) + (size_t)((k0) + 32 + sr) * G::KP + sc);              \
                         if constexpr (MLA) S.st_kr = load8((Kp) + (size_t)((k0) + (tid >> 3)) * G::KP + 128 + (tid & 7) * 8); } while (0)
#define SWRITE_HK(bf) do { *(bf16x8*)(K_lds + (bf) * SHM_K + kws) = S.st_k0; *(bf16x8*)(K_lds + (bf) * SHM_K + kws1) = S.st_k1;  \
                           if constexpr (MLA) *(bf16x8*)(lds + L_KR + (bf) * SHM_KR + krw) = S.st_kr; } while (0)
#define SWRITE_HV(bf) do { *(bf16x8*)(V_lds + (bf) * SHM_V + vst0) = S.st_v0; *(bf16x8*)(V_lds + (bf) * SHM_V + vst1) = S.st_v1; } while (0)
#define SWRITE_H(bf) do { SWRITE_HV(bf); SWRITE_HK(bf); } while (0)
#define QLOAD_R(ref) do { _Pragma("unroll") for (int d0 = 0; d0 < NQR; ++d0) S.qr[d0] = load8((ref) + (size_t)(wid * QBLK + r32) * G::QP + d0 * 16 + hi * 8); } while (0)
#define QLOAD_L(ref) do { _Pragma("unroll") for (int dr = 0; dr < NQLDS; ++dr) S.ql[dr] = load8((ref) + (size_t)(wid * QBLK + r32) * G::QP + NQR * 16 + dr * 16 + hi * 8); } while (0)
#define QROPE_TO_LDS() do { _Pragma("unroll") for (int dr = 0; dr < NQLDS; ++dr) *(bf16x8*)(lds + L_X + qrb + dr * 1024) = S.ql[dr]; } while (0)

template <bool MLA>
__device__ __forceinline__ void prime(const HeadRef& H, int qb_cur, char* lds, Seam<MLA>& S) {
    typedef Geo<MLA> G;
    const int tid = mk_lnd_v(threadIdx.x), wid = __builtin_amdgcn_readfirstlane(tid >> 6), lane = tid & 63, r32 = lane & 31, hi = lane >> 5;
    const int sr = tid >> 4, sc = (tid & 15) * 8, kws = KLAY(sr, tid & 15), kws1 = KLAY(32 + sr, tid & 15); char* K_lds = lds + L_K;
    constexpr int NQLDS = 0, NQR = MLA ? 12 : 8;
    const int krw = KLAY(tid >> 3, tid & 7), qrb = wid * (NQLDS * 1024) + lane * 16;
    const bf16* Qc = H.Q + (size_t)qb_cur * QB * G::QP;
    QLOAD_R(Qc); QLOAD_L(Qc);
    SLOAD_H(H.K, H.V, 0); VMW(); SWRITE_HK(0); QROPE_TO_LDS();
    __syncthreads();
}
template <bool MLA>
__device__ __forceinline__ void block(const HeadRef& H, int qb_cur, int qb_nxt, char* lds, Seam<MLA>& S) {
    typedef Geo<MLA> G;
    constexpr bool BIAS = !MLA; constexpr int NQLDS = 0, NQR = MLA ? 12 : 8;
    const int tid = mk_lnd_v(threadIdx.x), wid = __builtin_amdgcn_readfirstlane(tid >> 6), lane = tid & 63, r32 = lane & 31, hi = lane >> 5;
    const int P0 = qb_cur * QB;
    const int NT = (P0 + QB - 1) / KVBLK + 1;
    const int qlo = P0 + wid * QBLK, qm = qlo + r32 - 4 * hi;
    char* V_lds = lds + L_V; char* K_lds = lds + L_K;
    float* ws = (float*)(lds + L_WS) + wid * 64; float* li_l = ws, * al_l = ws + 32;
    float m_reg = -1e30f, l_reg = 0; f32x16 o[4] = {};
    const int sr = tid >> 4, sc = (tid & 15) * 8, vst0 = v_st(sr, sc), vst1 = v_st(32 + sr, sc), kws = KLAY(sr, tid & 15), kws1 = KLAY(32 + sr, tid & 15);
    const int krw = KLAY(tid >> 3, tid & 7), qrb = wid * (NQLDS * 1024) + lane * 16, krb = r32 * 16 + hi * 1168, fbh = hi * 16;
    const int vb0 = (int)(uintptr_t)V_lds + v_rd_base(lane);
    const bf16* Kh = H.K; const bf16* Vh = H.V;
    if constexpr (BIAS) {
        const int nk4 = (P0 + QB) / 4;
        for (int i = tid; i < nk4; i += NW * 64) *(f32x4*)(lds + L_FB + i * 16) = -*(const f32x4*)(H.FS + i * 4);
        __syncthreads();
    }
#define RESC(a) do { if (__any((a) < 1.f)) { if (hi == 0) al_l[r32] = (a); asm volatile("s_waitcnt lgkmcnt(0)" ::: "memory");              \
                     for (int d_ = 0; d_ < 4; ++d_) for (int r = 0; r < 16; ++r) o[d_][r] *= al_l[crow(r, hi)]; } } while (0)
#define KBASE(t) ((t) * KVBLK)
#define MASKT(P0_, P1_, t) do { const int kb_ = KBASE(t); if (kb_ + KVBLK - 1 > qlo) mask_tile(P0_, P1_, qm - kb_); } while (0)
    f32x16 pA0, pA1, pB0, pB1; float mnA, mnB, alA, alB; bf16x8 pa0, pa1, pa2, pa3;
    SWRITE_HV(0); SBAR();
    if (NT > 1) { SLOAD_H(Kh, Vh, KBASE(1)); }
    SBAR(); qkt<0, MLA, BIAS>(pA0, pA1, lds, r32, hi, S.qr, krb, qrb, fbh + KBASE(0) * 4);
    MASKT(pA0, pA1, 0); partialSM<MLA>(pA0, pA1, m_reg, mnA, alA);
    if (NT > 1) { VMW(); SWRITE_H(1); }
    __syncthreads();
#define HALF_STEP(PX0, PX1, mnX, alX, PY0, PY1, alY, t, KB, VB, SB) do {                                                      \
        SBAR(); qkt<KB, MLA, BIAS>(PX0, PX1, lds, r32, hi, S.qr, krb, qrb, fbh + KBASE(t) * 4);                                                         \
        finishSM(PY0, PY1, alY, l_reg, pa0, pa1, pa2, pa3); SBAR();                                                           \
        if ((t) + 1 < NT) { SLOAD_H(Kh, Vh, KBASE((t) + 1)); SBAR(); }                                                        \
        pv_tile<VB>(o, vb0, pa0, pa1, pa2, pa3); MASKT(PX0, PX1, (t)); partialSM<MLA>(PX0, PX1, m_reg, mnX, alX);             \
        __syncthreads();                                                                                                      \
        if ((t) + 1 < NT) { VMW(); SWRITE_H(SB); }                                                                            \
        RESC(alX); __syncthreads(); } while (0)
    for (int t = 1; t + 1 < NT; t += 2) {
        HALF_STEP(pB0, pB1, mnB, alB, pA0, pA1, alA, t, 1, 0, 0);
        HALF_STEP(pA0, pA1, mnA, alA, pB0, pB1, alB, t + 1, 0, 1, 1);
    }
    const bool even = (NT & 1) == 0;
    if (even) { SBAR(); qkt<1, MLA, BIAS>(pB0, pB1, lds, r32, hi, S.qr, krb, qrb, fbh + KBASE(NT - 1) * 4); SBAR(); }
    finishSM(pA0, pA1, alA, l_reg, pa0, pa1, pa2, pa3); SBAR();
    pv_tile<0>(o, vb0, pa0, pa1, pa2, pa3);
    if (even) { MASKT(pB0, pB1, NT - 1); partialSM<MLA>(pB0, pB1, m_reg, mnB, alB); __syncthreads(); RESC(alB);
        finishSM(pB0, pB1, alB, l_reg, pa0, pa1, pa2, pa3); SBAR(); pv_tile<1>(o, vb0, pa0, pa1, pa2, pa3); }
    SBAR();
    const bf16* Qn = H.Q + (size_t)qb_nxt * QB * G::QP;
    SLOAD_H(Kh, Vh, 0); QLOAD_R(Qn); SBAR();
    if (hi == 0) li_l[r32] = l_reg; asm volatile("s_waitcnt lgkmcnt(0)" ::: "memory");
    float rli[16];
#pragma unroll
    for (int r = 0; r < 16; ++r) rli[r] = __builtin_amdgcn_rcpf(li_l[crow(r, hi)]);
    bf16* Ow = H.O + (size_t)(P0 + wid * QBLK) * G::OP;
#pragma unroll
    for (int r = 0; r < 16; ++r) { const int orow = crow(r, hi);
#pragma unroll
        for (int d0 = 0; d0 < 4; ++d0) { const float v = o[d0][r] * rli[r];
            const float vn = __shfl_xor(v, 1);
            if ((r32 & 1) == 0) *(unsigned*)(Ow + (size_t)orow * G::OP + d0 * 32 + r32) = cvtpk(v, vn); } }
    SBAR(); QLOAD_L(Qn); VMW(); SWRITE_HK(0); QROPE_TO_LDS();
    __syncthreads();
#undef RESC
#undef KBASE
#undef MASKT
#undef HALF_STEP
}
#undef VMW
#undef VMWN
#undef SLOAD_H
#undef SWRITE_HK
#undef SWRITE_HV
#undef SWRITE_H
#undef QLOAD_R
#undef QLOAD_L
#undef QROPE_TO_LDS
#undef PK4
}


namespace mk {
using pg8::bf16_t; using pg8::f32x4; using pg8::u32x4; using pg8::bf16x8; using pg8::Unit; using pg8::cvt_pk_bf16;
typedef GAS unsigned gu32;
#define RLX_AGENT __ATOMIC_RELAXED, __HIP_MEMORY_SCOPE_AGENT
constexpr int NWAVES = 8, NTHREADS = 512;
constexpr int NP = NP_G;
constexpr int P_CQ = 0, P_CKV = 512, P_GQ = 1024, P_GK = 1536, P_GV = 2048, P_GR = 3072, P_FQ = 4096, P_FK = 5120, P_FV = 6144, P_GATES = 7168, P_KR = 13312, P_GA = 13376, P_FL = 13392;
__host__ __device__ __forceinline__ int map_in(int n) {
    if (n < 1024) return n;
    if (n < 1088) return P_KR + (n - 1024);
    if (n < 3136) return n - 1088 + 1024;
    if (n < 3152) return P_GA + (n - 3136);
    if (n < 7248) return n - 3152 + 3072;
    if (n < 7256) return P_FL + (n - 7248);
    return n - 7256 + P_GATES;
}
__host__ __device__ __forceinline__ int rope_pos(int i) { const int half = i >> 5, jj = i & 31; return 32 * (jj >> 4) + 8 * ((jj >> 2) & 3) + 4 * half + (jj & 3); }
__host__ __device__ __forceinline__ int map_uq(int n) { const int h = n / 192, j = n % 192; return h * 256 + (j < 128 ? j : 128 + rope_pos(j - 128)); }
__host__ __device__ __forceinline__ int map_gu(int n) { const int up = n >= FFH, j = up ? n - FFH : n; return (j >> 7) * 256 + up * 128 + (j & 127); }
__host__ __device__ __forceinline__ int map_id(int n) { return n; }

constexpr size_t MiB = 1u << 20;
constexpr size_t WS_CTL = 0, CTL_ZERO_BYTES = 64 * 1024;
constexpr size_t LW_WIN = 0, LW_WUQ = 53 * MiB, LW_WUKV = 55 * MiB, LW_WBR = 57 * MiB, LW_WOUT = 69 * MiB, LW_WGU = 77 * MiB, LW_WDN = 121 * MiB, LW_BYTES = 143 * MiB;
static_assert((size_t)NP * DM * 2 == 53 * MiB && (size_t)2 * FFH * DM * 2 == 44 * MiB && (size_t)DM * FFH * 2 == 22 * MiB, "weight sizes");
constexpr size_t WS_W = 1 * MiB;
constexpr int CW_TMO = 0, CW_CODE = 1, CW_BAR = 4096, CW_QUEUE = 65536;

constexpr int RING_OFF = 0, LDS_BYTES = 163840, LDSCTL_OFF = LDS_BYTES - 512, MISC_OFF = LDSCTL_OFF + 320;

__device__ __forceinline__ float wave_sum(float v) {
#pragma unroll
    for (int o = 1; o < 64; o <<= 1) v += __shfl_xor(v, o);
    return v;
}
__device__ __forceinline__ unsigned f2bf(float f) { unsigned u = __builtin_bit_cast(unsigned, f); return (u + 0x7fffu + ((u >> 16) & 1u)) >> 16; }
__device__ __forceinline__ unsigned pk2(float lo, float hi) { return f2bf(lo) | (f2bf(hi) << 16); }
__device__ __forceinline__ float bf2f(unsigned short b) { return __builtin_bit_cast(float, (unsigned)b << 16); }
__device__ __forceinline__ float bflo(unsigned w) { return __builtin_bit_cast(float, w << 16); }
__device__ __forceinline__ float bfhi(unsigned w) { return __builtin_bit_cast(float, w & 0xffff0000u); }
__device__ __forceinline__ float fast_sigmoid(float x) { return __builtin_amdgcn_rcpf(1.f + __builtin_amdgcn_exp2f(-1.4426950408889634f * x)); }

struct EpiStoreBf16 {
    static constexpr bool PERM = true, AFTER_DRAIN = false;
    bf16_t* O; int ldc; const LAS float* RT;
    __device__ __forceinline__ void operator()(const f32x4 (&acc)[2][2][4][2], const Unit& u, int wr, int wc, int fr, int fq) const {
        const int row0 = u.pm * 256 + wr * 64 + fr, col0 = u.pn * 256 + wc * 32 + 8 * fq;
#pragma unroll
        for (int ai = 0; ai < 2; ++ai)
#pragma unroll
            for (int m = 0; m < 4; ++m) { const int row = row0 + ai * 128 + m * 16; bf16_t* rowp = O + (size_t)row * ldc + col0;
                const float r = RT[wr * 64 + fr + ai * 128 + m * 16];
#pragma unroll
                for (int bj = 0; bj < 2; ++bj) { const f32x4 v0 = acc[ai][bj][m][0] * r, v1 = acc[ai][bj][m][1] * r;
                    u32x4 w; w.x = cvt_pk_bf16(v0[0], v0[1]); w.y = cvt_pk_bf16(v0[2], v0[3]); w.z = cvt_pk_bf16(v1[0], v1[1]); w.w = cvt_pk_bf16(v1[2], v1[3]);
                    *(u32x4*)(rowp + bj * 128) = w; } }
    }
};
struct EpiSwiglu {
    static constexpr bool PERM = true, AFTER_DRAIN = false;
    bf16_t* O; int ldc; const LAS float* RT;
    __device__ __forceinline__ void operator()(const f32x4 (&acc)[2][2][4][2], const Unit& u, int wr, int wc, int fr, int fq) const {
        const int row0 = u.pm * 256 + wr * 64 + fr, col0 = u.pn * 128 + wc * 32 + 8 * fq;
#pragma unroll
        for (int ai = 0; ai < 2; ++ai)
#pragma unroll
            for (int m = 0; m < 4; ++m) { const int row = row0 + ai * 128 + m * 16; bf16_t* rowp = O + (size_t)row * ldc + col0;
                const float rs = RT[wr * 64 + fr + ai * 128 + m * 16];
                float r[8];
#pragma unroll
                for (int n = 0; n < 2; ++n)
#pragma unroll
                    for (int e = 0; e < 4; ++e) { const float g = acc[ai][0][m][n][e] * rs, up = acc[ai][1][m][n][e] * rs; r[n * 4 + e] = g * fast_sigmoid(g) * up; }
                u32x4 w; w.x = cvt_pk_bf16(r[0], r[1]); w.y = cvt_pk_bf16(r[2], r[3]); w.z = cvt_pk_bf16(r[4], r[5]); w.w = cvt_pk_bf16(r[6], r[7]);
                *(u32x4*)rowp = w; }
    }
};
struct EpiResidF32 {
    static constexpr bool PERM = false, AFTER_DRAIN = false;
    const float* R; float* C; int ldc;
    __device__ __forceinline__ void operator()(const f32x4 (&acc)[2][2][4][2], const Unit& u, int wr, int wc, int fr, int fq) const {
        const int row0 = u.pm * 256 + wr * 64 + fr, col0 = u.pn * 256 + wc * 32 + 4 * fq;
#pragma unroll
        for (int ai = 0; ai < 2; ++ai)
#pragma unroll
            for (int m = 0; m < 4; ++m) { const size_t ro = (size_t)(row0 + ai * 128 + m * 16) * ldc + col0;
#pragma unroll
                for (int bj = 0; bj < 2; ++bj)
#pragma unroll
                    for (int n = 0; n < 2; ++n) { const f32x4 r = *(const f32x4*)(R + ro + bj * 128 + n * 16); *(f32x4*)(C + ro + bj * 128 + n * 16) = r + acc[ai][bj][m][n]; } }
    }
};
struct EpiResidNorm {
    static constexpr bool PERM = true, AFTER_DRAIN = true;
    const void* R; void* C; int ldc; float* SSP; int emit; int rb, cb;
    __device__ __forceinline__ void operator()(const f32x4 (&)[2][2][4][2], const Unit&, int, int, int, int) const {}
    template <bool RB, bool CB>
    __device__ __forceinline__ void body(const f32x4 (&acc)[2][2][4][2], const Unit& u, int wr, int wc, int fr, int fq, LAS float* P) const {
        const int col0 = u.pn * 256 + wc * 32 + 8 * fq;
#pragma unroll
        for (int ai = 0; ai < 2; ++ai) {
            f32x4 rv[4][2][2]; u32x4 rw[4][2];
#pragma unroll
            for (int m = 0; m < 4; ++m)
#pragma unroll
                for (int bj = 0; bj < 2; ++bj) { const size_t ro = (size_t)(u.pm * 256 + ai * 128 + wr * 64 + m * 16 + fr) * ldc + col0;
                    if (RB) rw[m][bj] = *(const u32x4*)((const bf16_t*)R + ro + bj * 128);
                    else { rv[m][bj][0] = *(const f32x4*)((const float*)R + ro + bj * 128); rv[m][bj][1] = *(const f32x4*)((const float*)R + ro + bj * 128 + 4); } }
#pragma unroll
            for (int m = 0; m < 4; ++m) { const int rl = ai * 128 + wr * 64 + m * 16 + fr; const size_t ro = (size_t)(u.pm * 256 + rl) * ldc + col0; float s = 0.f;
#pragma unroll
                for (int bj = 0; bj < 2; ++bj) {
                    f32x4 r0, r1;
                    if (RB) { const u32x4 w = rw[m][bj];
                        r0 = (f32x4){__uint_as_float(w.x << 16), __uint_as_float(w.x & 0xffff0000u), __uint_as_float(w.y << 16), __uint_as_float(w.y & 0xffff0000u)};
                        r1 = (f32x4){__uint_as_float(w.z << 16), __uint_as_float(w.z & 0xffff0000u), __uint_as_float(w.w << 16), __uint_as_float(w.w & 0xffff0000u)}; }
                    else { r0 = rv[m][bj][0]; r1 = rv[m][bj][1]; }
                    const f32x4 x0 = r0 + acc[ai][bj][m][0], x1 = r1 + acc[ai][bj][m][1];
                    if (CB) { u32x4 w; w.x = cvt_pk_bf16(x0[0], x0[1]); w.y = cvt_pk_bf16(x0[2], x0[3]); w.z = cvt_pk_bf16(x1[0], x1[1]); w.w = cvt_pk_bf16(x1[2], x1[3]);
                        *(u32x4*)((bf16_t*)C + ro + bj * 128) = w; }
                    else { *(f32x4*)((float*)C + ro + bj * 128) = x0; *(f32x4*)((float*)C + ro + bj * 128 + 4) = x1; }
                    if (emit) s += ((x0[0] * x0[0] + x0[1] * x0[1]) + (x0[2] * x0[2] + x0[3] * x0[3])) + ((x1[0] * x1[0] + x1[1] * x1[1]) + (x1[2] * x1[2] + x1[3] * x1[3])); }
                if (emit) { s += __shfl_xor(s, 16); s += __shfl_xor(s, 32); if (fq == 0) P[rl * 4 + wc] = s; } }
            asm volatile("" ::: "memory"); }
    }
    __device__ __forceinline__ void fused(const f32x4 (&acc)[2][2][4][2], const Unit& u, int wr, int wc, int fr, int fq, LAS unsigned char* lds, int wid, int lane) const {
        LAS float* P = (LAS float*)lds;
        if (rb && cb) body<true, true>(acc, u, wr, wc, fr, fq, P);
        else if (rb) body<true, false>(acc, u, wr, wc, fr, fq, P);
        else body<false, true>(acc, u, wr, wc, fr, fq, P);
        if (emit) {
            asm volatile("s_waitcnt lgkmcnt(0)" ::: "memory"); __builtin_amdgcn_s_barrier(); asm volatile("" ::: "memory");
            const int t = wid * 64 + lane;
            if (t < 256) { const f32x4 p = *(const LAS f32x4*)(P + t * 4); SSP[(size_t)(u.pm * 256 + t) * 8 + u.pn] = (p.x + p.y) + (p.z + p.w); }
            asm volatile("s_waitcnt lgkmcnt(0)" ::: "memory"); __builtin_amdgcn_s_barrier(); asm volatile("" ::: "memory");
        }
    }
};

struct BranchOrder {
    pg8::StaticOrder T;
    __device__ void init(int G, int c) { T.init(S, DM, G, c); }
    __device__ bool next(int i, Unit& u) const { Unit t; const int n = i % 3; if (!T.next(i / 3, t)) return false; u.pm = 32 * n + t.pm; u.pn = 8 * n + t.pn; return true; }
    __device__ __forceinline__ void a_ready(const Unit&) const {}
    __device__ __forceinline__ void done(const Unit&) const {}
};
struct EpiGateMergeAll {
    static constexpr bool PERM = true, AFTER_DRAIN = false;
    const bf16_t* G; int ldg; bf16_t* PART; bf16_t* Mb; int ldc;
    __device__ __forceinline__ void operator()(const f32x4 (&acc)[2][2][4][2], const Unit& u, int wr, int wc, int fr, int fq) const {
        const int n = u.pn >> 3, pm = u.pm & 31, pn = u.pn & 7;
        const int row0 = pm * 256 + wr * 64 + fr, col0 = pn * 256 + wc * 32 + 8 * fq;
        bf16_t* dst = (n < 2) ? PART : Mb;
#pragma unroll
        for (int ai = 0; ai < 2; ++ai) {
            u32x4 gw[4][2], pw[4][2];
#pragma unroll
            for (int m = 0; m < 4; ++m)
#pragma unroll
                for (int bj = 0; bj < 2; ++bj) { const size_t row = (size_t)(row0 + ai * 128 + m * 16);
                    gw[m][bj] = *(const u32x4*)(G + row * ldg + n * DM + col0 + bj * 128);
                    pw[m][bj] = (n > 0) ? *(const u32x4*)(PART + row * ldc + col0 + bj * 128) : (u32x4){0u, 0u, 0u, 0u}; }
#pragma unroll
            for (int m = 0; m < 4; ++m)
#pragma unroll
                for (int bj = 0; bj < 2; ++bj) { const size_t row = (size_t)(row0 + ai * 128 + m * 16);
                    const u32x4 g4 = gw[m][bj], p4 = pw[m][bj];
                    f32x4 a0 = acc[ai][bj][m][0], a1 = acc[ai][bj][m][1];
                    a0[0] = fmaf(a0[0], fast_sigmoid(bflo(g4.x)), bflo(p4.x)); a0[1] = fmaf(a0[1], fast_sigmoid(bfhi(g4.x)), bfhi(p4.x)); a0[2] = fmaf(a0[2], fast_sigmoid(bflo(g4.y)), bflo(p4.y)); a0[3] = fmaf(a0[3], fast_sigmoid(bfhi(g4.y)), bfhi(p4.y));
                    a1[0] = fmaf(a1[0], fast_sigmoid(bflo(g4.z)), bflo(p4.z)); a1[1] = fmaf(a1[1], fast_sigmoid(bfhi(g4.z)), bfhi(p4.z)); a1[2] = fmaf(a1[2], fast_sigmoid(bflo(g4.w)), bflo(p4.w)); a1[3] = fmaf(a1[3], fast_sigmoid(bfhi(g4.w)), bfhi(p4.w));
                    u32x4 w; w.x = cvt_pk_bf16(a0[0], a0[1]); w.y = cvt_pk_bf16(a0[2], a0[3]); w.z = cvt_pk_bf16(a1[0], a1[1]); w.w = cvt_pk_bf16(a1[2], a1[3]);
                    *(u32x4*)(dst + row * ldc + col0 + bj * 128) = w; }
            asm volatile("" ::: "memory"); }
    }
};

struct Args {
    const float* in[21]; float* out; unsigned char* ws;
    int pro_lo, pro_hi;
    int l_lo, l_hi, ph_lo, ph_hi;
    int li, pad;
};
struct Frame {
    LAS unsigned char* lds; volatile LAS unsigned* MISC; gu32* ctl;
    int tid, lane, wave, G, vcu;
};
__device__ __forceinline__ Frame relaunder(const Frame& F0) {
    Frame F = F0; int t = F0.tid, v = F0.vcu, g = F0.G;
    asm volatile("" : "+v"(t)); asm volatile("" : "+s"(v)); asm volatile("" : "+s"(g));
    F.tid = t; F.lane = t & 63; F.wave = __builtin_amdgcn_readfirstlane(t >> 6); F.vcu = v; F.G = g; return F;
}
#ifndef MK_WSTRIDE
#define MK_WSTRIDE 0
#endif
constexpr size_t WSTRIDE = MK_WSTRIDE;
constexpr size_t WBYTES = WSTRIDE ? (size_t)DEPTH * WSTRIDE : LW_BYTES;
constexpr size_t A_PROJ = WS_W + WBYTES, A_HN = A_PROJ + 212 * MiB, A_OA = A_HN + 32 * MiB, A_OB = A_OA + 16 * MiB, A_OC = A_OB + 16 * MiB, A_MERGED = A_OC + 16 * MiB,
                 A_CQN = A_MERGED + 64 * MiB, A_MQ = A_CQN + 16 * MiB, A_MK = A_MQ + 24 * MiB, A_MV = A_MK + 24 * MiB, A_FQ = A_MV + 16 * MiB, A_FK = A_FQ + 16 * MiB, A_FCUM = A_FK + 16 * MiB,
                 A_QT = A_FCUM + 1 * MiB, A_KT = A_QT + 8 * MiB, A_BLAST = A_KT + 8 * MiB, A_KVP = A_BLAST + 1 * MiB, A_SPREV = A_KVP + 64 * MiB, A_CS = A_SPREV + 32 * MiB, A_KRR = A_CS + 2 * MiB,
                 A_KRSS = A_KRR + 2 * MiB, A_HN2 = A_KRSS + 1 * MiB, A_SSPA = A_HN2 + 32 * MiB, A_SSPB = A_SSPA + 1 * MiB, A_XR = A_SSPB + 1 * MiB, A_END = A_XR + 32 * MiB;
typedef const __attribute__((address_space(4))) Args* ArgsP;
__device__ __forceinline__ int lnd_s(int v) { asm volatile("" : "+s"(v)); return v; }
__device__ __forceinline__ int lnd_v(int v) { asm volatile("" : "+v"(v)); return v; }
#define WSP(T, off) ((T*)(a->ws + (off)))
__device__ __forceinline__ ArgsP get_args() { ArgsP p = (ArgsP)__builtin_amdgcn_kernarg_segment_ptr(); asm volatile("" : "+s"(p)); return p; }

constexpr int I_IN = (DM / 64) * ((D_IN + 63) / 64), I_UQ = (512 / 64) * (1536 / 64), I_UKV = (512 / 64) * (2048 / 64), I_BR = (1024 / 64) * (DM / 64), I_OUT = (DM / 64) * (DM / 64),
              I_GU = (DM / 64) * (2 * FFH / 64), I_DN = (FFH / 64) * (DM / 64);
constexpr int NITEMS = I_IN + I_UQ + I_UKV + 3 * I_BR + I_OUT + I_GU + I_DN;
struct CvItem { const float* src; bf16_t* dst; const float* gk; int K, N, k0, n0, kind; };
__device__ __forceinline__ CvItem cv_decode(ArgsP a, int l, int r) {
    unsigned char* wb = a->ws + WS_W + (size_t)l * WSTRIDE;
    CvItem it; it.gk = nullptr;
    if (r < I_IN) { it.src = a->in[3] + (size_t)l * DM * D_IN; it.dst = (bf16_t*)(wb + LW_WIN); it.K = DM; it.N = D_IN; it.kind = 1; it.gk = a->in[2] + l * DM; }
    else if ((r -= I_IN) < I_UQ) { it.src = a->in[5] + (size_t)l * 512 * 1536; it.dst = (bf16_t*)(wb + LW_WUQ); it.K = 512; it.N = 1536; it.kind = 2; }
    else if ((r -= I_UQ) < I_UKV) { it.src = a->in[7] + (size_t)l * 512 * 2048; it.dst = (bf16_t*)(wb + LW_WUKV); it.K = 512; it.N = 2048; it.kind = 0; }
    else if ((r -= I_UKV) < 3 * I_BR) { const int n = r / I_BR; r -= n * I_BR; it.src = a->in[16] + (size_t)(l * 3 + n) * 1024 * DM; it.dst = (bf16_t*)(wb + LW_WBR) + (size_t)n * DM * 1024; it.K = 1024; it.N = DM; it.kind = 0; }
    else if ((r -= 3 * I_BR) < I_OUT) { it.src = a->in[17] + (size_t)l * DM * DM; it.dst = (bf16_t*)(wb + LW_WOUT); it.K = DM; it.N = DM; it.kind = 0; }
    else if ((r -= I_OUT) < I_GU) { it.src = a->in[19] + (size_t)l * DM * 2 * FFH; it.dst = (bf16_t*)(wb + LW_WGU); it.K = DM; it.N = 2 * FFH; it.kind = 3; it.gk = a->in[18] + l * DM; }
    else { r -= I_GU; it.src = a->in[20] + (size_t)l * FFH * DM; it.dst = (bf16_t*)(wb + LW_WDN); it.K = FFH; it.N = DM; it.kind = 0; }
    const int nblk = (it.N + 63) >> 6, kb = r / nblk, nb = r - kb * nblk; it.k0 = 64 * kb; it.n0 = 64 * nb;
    return it;
}
typedef float f32x2g __attribute__((ext_vector_type(2)));
__device__ __forceinline__ void cv_load(const CvItem& it, int lane, f32x4 (&v)[8][2], f32x2g (&gv)[8]) {
    const int n4 = lane & 15, kq = lane >> 4, n = it.n0 + 4 * n4;
    const bool ok = n < it.N;
    const float* src = it.src + (size_t)(it.k0 + 2 * kq) * it.N + n;
#pragma unroll
    for (int ii = 0; ii < 8; ++ii)
#pragma unroll
        for (int t = 0; t < 2; ++t) v[ii][t] = ok ? __builtin_nontemporal_load((const f32x4*)(src + (size_t)(8 * ii + t) * it.N)) : (f32x4){0.f, 0.f, 0.f, 0.f};
    if (it.gk) {
#pragma unroll
        for (int ii = 0; ii < 8; ++ii) gv[ii] = *(const f32x2g*)(it.gk + it.k0 + 2 * kq + 8 * ii); }
    else {
#pragma unroll
        for (int ii = 0; ii < 8; ++ii) gv[ii] = (f32x2g){1.f, 1.f}; }
}
__device__ __forceinline__ void cv_store(const CvItem& it, const f32x4 (&v)[8][2], const f32x2g (&gv)[8], LAS unsigned* scr, int lane) {
    const int n4 = lane & 15, kq = lane >> 4;
#pragma unroll
    for (int ii = 0; ii < 8; ++ii)
#pragma unroll
        for (int e = 0; e < 4; ++e) scr[(4 * n4 + e) * 34 + kq + 4 * ii] = cvt_pk_bf16(v[ii][0][e] * gv[ii].x, v[ii][1][e] * gv[ii].y);
    asm volatile("s_waitcnt lgkmcnt(0)" ::: "memory");
    const int c8 = lane & 7;
#pragma unroll
    for (int j = 0; j < 8; ++j) { const int nn = (lane >> 3) + 8 * j, n = it.n0 + nn;
        typedef unsigned u32x2 __attribute__((ext_vector_type(2)));
        const u32x2 lo = *(const LAS u32x2*)(scr + nn * 34 + 4 * c8), hi2 = *(const LAS u32x2*)(scr + nn * 34 + 4 * c8 + 2);
        const int dr = it.kind == 0 ? n : (it.kind == 1 ? map_in(n) : (it.kind == 2 ? map_uq(n) : map_gu(n)));
        if (n < it.N) *(u32x4*)(it.dst + (size_t)dr * it.K + it.k0 + 8 * c8) = (u32x4){lo.x, lo.y, hi2.x, hi2.y}; }
    asm volatile("s_waitcnt lgkmcnt(0)" ::: "memory");
}
__device__ __forceinline__ void cv_run(ArgsP a, int l0, int first, int stride, int count, LAS unsigned* scr, int lane, int P = NITEMS, int OFF = 0) {
    if (count <= 0) return;
    CvItem cur = cv_decode(a, l0 + first / P, OFF + first % P);
    f32x4 v[8][2]; f32x2g gv[8]; cv_load(cur, lane, v, gv);
    for (int i = 1; i <= count; ++i) {
        CvItem nxt = cur; f32x4 w[8][2]; f32x2g gw[8];
        if (i < count) { const int r = first + i * stride; nxt = cv_decode(a, l0 + r / P, OFF + r % P); cv_load(nxt, lane, w, gw); }
        cv_store(cur, v, gv, scr, lane);
        if (i < count) { cur = nxt;
#pragma unroll
            for (int ii = 0; ii < 8; ++ii) { v[ii][0] = w[ii][0]; v[ii][1] = w[ii][1]; gv[ii] = gw[ii]; } }
    }
}
constexpr int CV_W1 = 96, CV_R1 = 7, CV_W4 = 128, CV_R4 = 6, CV_W8 = 128, CV_R8 = 7, CV_P0 = I_IN + I_UQ + I_UKV, CV_B8 = 0, CV_B1 = CV_P0, CV_B4 = CV_B1 + CV_W1 * CV_R1 * 8;
static_assert(CV_W8 * CV_R8 * 8 == CV_P0 && CV_B4 + CV_W4 * CV_R4 * 8 >= NITEMS && CV_B4 < NITEMS, "conversion slices must cover a layer");
__device__ __forceinline__ void prologue_weights(const Frame& F0, int l_lo, int l_hi) {
    const Frame F = relaunder(F0);
    ArgsP a = get_args();
    LAS unsigned* scr = (LAS unsigned*)(F.lds + RING_OFF + F.wave * 16384);
    const int gw = F.vcu * NWAVES + F.wave, NGW = F.G * NWAVES, total = (l_hi - l_lo == 1 && l_lo == 0) ? CV_P0 : (l_hi - l_lo) * NITEMS;
    cv_run(a, l_lo, gw, NGW, gw < total ? (total - gw + NGW - 1) / NGW : 0, scr, F.lane);
}
__device__ __forceinline__ void convert_slice(const Frame& F0, int l, int base, int rank, int W, int R) {
    if (l >= DEPTH) return;
    const Frame F = relaunder(F0);
    ArgsP a = get_args();
    LAS unsigned* scr = (LAS unsigned*)(F.lds + RING_OFF + F.wave * 16384);
    const int first = base + rank * 8 + F.wave, stride = W * 8;
    int count = 0; if (first < NITEMS) { count = (NITEMS - first + stride - 1) / stride; if (count > R) count = R; }
    cv_run(a, l, first, stride, count, scr, F.lane);
}
__device__ __forceinline__ void phase_rms0(const Frame& F0, const float* X, bf16_t* O, float* SSP) {
    const Frame F = relaunder(F0);
    const int gw = F.vcu * NWAVES + F.wave, NGW = F.G * NWAVES, lane = F.lane;
    for (int m = gw; m < S; m += NGW) {
        const f32x4* xr = (const f32x4*)(X + (size_t)m * DM) + lane;
        f32x4 v[8]; float s = 0.f;
#pragma unroll
        for (int j = 0; j < 8; ++j) { v[j] = xr[64 * j]; s += (v[j].x * v[j].x + v[j].y * v[j].y) + (v[j].z * v[j].z + v[j].w * v[j].w); }
        s = wave_sum(s);
        unsigned long long* o8 = (unsigned long long*)(O + (size_t)m * DM) + lane;
#pragma unroll
        for (int j = 0; j < 8; ++j) o8[64 * j] = (unsigned long long)pk2(v[j].x, v[j].y) | ((unsigned long long)pk2(v[j].z, v[j].w) << 32);
        if (lane < 2) *(f32x4*)(SSP + (size_t)m * 8 + 4 * lane) = (f32x4){lane == 0 ? s : 0.f, 0.f, 0.f, 0.f};
    }
}
constexpr int RT_OFF = 131072;
__device__ __forceinline__ int first_unit_pm(int nN, int G, int cidx) {
    const int nM = S / 256, nwg = nM * nN; if (cidx >= nwg) return -1;
    int wgid = cidx; { const int q = nwg / pg8::NXCD, r = nwg % pg8::NXCD, xcd = wgid % pg8::NXCD, off = wgid / pg8::NXCD; wgid = (xcd < r ? xcd * (q + 1) : r * (q + 1) + (xcd - r) * q) + off; }
    const int nig = pg8::WGM * nN, gid = wgid / nig, fm = gid * pg8::WGM, gsz = (nM - fm) < pg8::WGM ? (nM - fm) : pg8::WGM;
    return fm + ((wgid % nig) % gsz);
}
__device__ __forceinline__ void fill_rstd_table(const Frame& F0, const float* SSP, int pm) {
    const Frame F = relaunder(F0);
    if (F.tid < 256) { const int row = pm * 256 + F.tid;
        const f32x4 s0 = *(const f32x4*)(SSP + (size_t)row * 8), s1 = *(const f32x4*)(SSP + (size_t)row * 8 + 4);
        ((LAS float*)(F.lds + RT_OFF))[F.tid] = rsqrtf((((s0.x + s0.y) + (s0.z + s0.w)) + ((s1.x + s1.y) + (s1.z + s1.w))) * (1.f / DM) + EPS); }
    __syncthreads();
}

__device__ __forceinline__ float log_sigmoid_f(float x) { return fminf(x, 0.f) - __logf(1.f + __expf(-fabsf(x))); }
__device__ __forceinline__ void unpack8(const u32x4 w, float (&f)[8]) {
    f[0] = bflo(w.x); f[1] = bfhi(w.x); f[2] = bflo(w.y); f[3] = bfhi(w.y); f[4] = bflo(w.z); f[5] = bfhi(w.z); f[6] = bflo(w.w); f[7] = bfhi(w.w);
}
__device__ __forceinline__ u32x4 pack8f(const float (&f)[8]) { u32x4 w; w.x = cvt_pk_bf16(f[0], f[1]); w.y = cvt_pk_bf16(f[2], f[3]); w.z = cvt_pk_bf16(f[4], f[5]); w.w = cvt_pk_bf16(f[6], f[7]); return w; }

__device__ __forceinline__ void sincos_d(double a, double& sn, double& cn) {
    const double TWO_PI = 6.283185307179586476925286766559, HALF_PI = 1.5707963267948966192313216916398;
    const double k = rint(a / TWO_PI); double r = a - k * TWO_PI;
    const double q = rint(r / HALF_PI); r = r - q * HALF_PI; const int qi = ((int)q) & 3;
    const double r2 = r * r;
    const double sp = r * (1.0 + r2 * (-1.0 / 6 + r2 * (1.0 / 120 + r2 * (-1.0 / 5040 + r2 * (1.0 / 362880 + r2 * (-1.0 / 39916800 + r2 * (1.0 / 6227020800.0)))))));
    const double cp = 1.0 + r2 * (-0.5 + r2 * (1.0 / 24 + r2 * (-1.0 / 720 + r2 * (1.0 / 40320 + r2 * (-1.0 / 3628800 + r2 * (1.0 / 479001600.0 + r2 * (-1.0 / 87178291200.0)))))));
    if (qi == 0) { sn = sp; cn = cp; } else if (qi == 1) { sn = cp; cn = -sp; } else if (qi == 2) { sn = -sp; cn = -cp; } else { sn = -cp; cn = sp; }
}
__device__ __forceinline__ void rope_tables(const Frame& F0) {
    const Frame F = relaunder(F0);
    ArgsP a = get_args(); const int* pos = (const int*)a->in[1]; float* CS = WSP(float, A_CS);
    for (int i = F.vcu * NTHREADS + F.tid; i < S * 32; i += F.G * NTHREADS) {
        const int s = i >> 5, f = i & 31;
        const float inv = (float)exp2(-(double)f / 32.0 * 13.287712379549449391481277717958);
        const float ang = (float)pos[s] * inv;
        double sn, cn; sincos_d((double)ang, sn, cn);
        CS[s * 64 + f] = (float)cn; CS[s * 64 + 32 + f] = (float)sn;
    }
}

__device__ __forceinline__ void prep_row(int lane, int row, int l, ArgsP a) {
    const bf16_t* pr = WSP(bf16_t, A_PROJ) + (size_t)row * NP;
    const u32x4 cw0 = *(const u32x4*)(pr + P_CQ + 16 * lane), cw1 = *(const u32x4*)(pr + P_CQ + 16 * lane + 8);
    const u32x4 qw0 = *(const u32x4*)(pr + P_FQ + 16 * lane), qw1 = *(const u32x4*)(pr + P_FQ + 16 * lane + 8);
    const u32x4 kw0 = *(const u32x4*)(pr + P_FK + 16 * lane), kw1 = *(const u32x4*)(pr + P_FK + 16 * lane + 8);
    const float krv = bf2f(pr[P_KR + lane]);
    const float* cs = WSP(float, A_CS) + (size_t)row * 64;
    const float cc = cs[lane & 31], sn = cs[32 + (lane & 31)];
    {
        float v0[8], v1[8]; unpack8(cw0, v0); unpack8(cw1, v1);
        float s = 0.f;
#pragma unroll
        for (int i = 0; i < 8; ++i) s += v0[i] * v0[i] + v1[i] * v1[i];
#pragma unroll
        for (int o = 1; o < 32; o <<= 1) s += __shfl_xor(s, o);
        const float r = rsqrtf(s * (1.f / 512.f) + EPS);
        const float* g = (lane < 32) ? (a->in[4] + l * 512 + 16 * lane) : (a->in[6] + l * 512 + 16 * (lane - 32));
#pragma unroll
        for (int i = 0; i < 8; ++i) { v0[i] *= r * g[i]; v1[i] *= r * g[8 + i]; }
        bf16_t* op = WSP(bf16_t, A_CQN) + (size_t)row * 1024 + 16 * lane;
        *(u32x4*)op = pack8f(v0); *(u32x4*)(op + 8) = pack8f(v1);
    }
    {
        const float ss = wave_sum(krv * krv);
        const float y = krv * (a->in[9][l * 192 + 128 + lane]);
        const float yo = __shfl_xor(y, 32);
        WSP(float, A_KRR)[(size_t)row * 64 + rope_pos(lane)] = (lane < 32) ? (y * cc - yo * sn) : (y * cc + yo * sn);
        if (lane == 0) WSP(float, A_KRSS)[row] = ss;
    }
#pragma unroll
    for (int which = 0; which < 2; ++which) {
        float v0[8], v1[8]; unpack8(which ? kw0 : qw0, v0); unpack8(which ? kw1 : qw1, v1);
        float s = 0.f;
#pragma unroll
        for (int i = 0; i < 8; ++i) s += v0[i] * v0[i] + v1[i] * v1[i];
        s += __shfl_xor(s, 1); s += __shfl_xor(s, 2); s += __shfl_xor(s, 4);
        const float r = rsqrtf(s * (1.f / 128.f) + EPS);
        const float* g = a->in[which ? 14 : 13] + l * 128 + 16 * (lane & 7);
#pragma unroll
        for (int i = 0; i < 8; ++i) { v0[i] *= r * g[i]; v1[i] *= r * g[8 + i]; }
        bf16_t* op = WSP(bf16_t, which ? A_FK : A_FQ) + ((size_t)(lane >> 3) * S + row) * 128 + 16 * (lane & 7);
        *(u32x4*)op = pack8f(v0); *(u32x4*)(op + 8) = pack8f(v1);
    }
}
__device__ __forceinline__ void fox_cumsum(const Frame& F, int h, int l, ArgsP a) {
    LAS float* tot = (LAS float*)(F.lds);
    const bf16_t* P = WSP(bf16_t, A_PROJ) + P_FL + h; const float bf = a->in[15][l * 8 + h];
    const int t = F.tid; float v[16]; float run = 0.f;
    unsigned short raw[16];
#pragma unroll
    for (int i = 0; i < 16; ++i) raw[i] = P[(size_t)(t * 16 + i) * NP];
    asm volatile("" ::: "memory");
#pragma unroll
    for (int i = 0; i < 16; ++i) { run += log_sigmoid_f(bf2f(raw[i]) + bf); v[i] = run; }
    float inc = run;
#pragma unroll
    for (int o = 1; o < 64; o <<= 1) { const float n = __shfl_up(inc, o); if (F.lane >= o) inc += n; }
    if (F.lane == 63) tot[F.wave] = inc;
    __syncthreads();
    float woff = 0.f;
    for (int w = 0; w < F.wave; ++w) woff += tot[w];
    const float off = woff + inc - run;
    float* O = WSP(float, A_FCUM) + (size_t)h * S + t * 16;
#pragma unroll
    for (int i = 0; i < 16; ++i) O[i] = (v[i] + off) * 11.313708498984761f;
    __syncthreads();
}
__device__ __forceinline__ void gla_prep_unit(const Frame& F, int chunk, int h, int l, ArgsP a) {
    using namespace att;
    const int tid = lnd_v(F.tid), lane = tid & 63, w = __builtin_amdgcn_readfirstlane(tid >> 6), r32 = lane & 31, hi = lane >> 5, row0 = chunk * 64;
    char* lds = (char*)F.lds;
    char* Vl = lds;
    char* Kl = lds + 2 * SHM_V;
    float* LA = (float*)(lds + 3 * SHM_V);
    float* WA = (float*)(lds + 3 * SHM_V + 32768);
    float* GA = (float*)(lds + 3 * SHM_V + 32768 + 8192);
    float* TOT = (float*)(lds + 3 * SHM_V + 32768 + 8192 + 4096);
    const mk::bf16_t* PR = WSP(mk::bf16_t, A_PROJ) + (size_t)row0 * NP;
    if (tid < 128) { const int r = tid >> 1, hf = tid & 1; const u32x4 wv = *(const u32x4*)(PR + (size_t)r * NP + P_GA + 8 * hf); float t[8]; mk::unpack8(wv, t);
#pragma unroll
        for (int i = 0; i < 8; ++i) GA[r * 16 + 8 * hf + i] = t[i]; }
    { const int k = tid >> 5, d4 = (tid & 31) * 4; *(f32x4*)(WA + k * 128 + d4) = *(const f32x4*)(a->in[10] + (size_t)l * 16 * 512 + k * 512 + h * 128 + d4); }
    const int sr = tid >> 4, sc = (tid & 15) * 8, vst0 = v_st(sr, sc), vst1 = v_st(32 + sr, sc);
    { const bf16x8 v00 = load8(PR + (size_t)sr * NP + P_GV + h * 256 + sc), v01 = load8(PR + (size_t)(32 + sr) * NP + P_GV + h * 256 + sc);
      const bf16x8 v10 = load8(PR + (size_t)sr * NP + P_GV + h * 256 + 128 + sc), v11 = load8(PR + (size_t)(32 + sr) * NP + P_GV + h * 256 + 128 + sc);
      *(bf16x8*)(Vl + vst0) = v00; *(bf16x8*)(Vl + vst1) = v01; *(bf16x8*)(Vl + SHM_V + vst0) = v10; *(bf16x8*)(Vl + SHM_V + vst1) = v11; }
    __syncthreads();
    const int dg = tid & 15, jq = tid >> 4;
    {   float x0[8], x1[8];
        const f32x4 b0 = *(const f32x4*)(a->in[11] + l * 512 + h * 128 + dg * 8), b1 = *(const f32x4*)(a->in[11] + l * 512 + h * 128 + dg * 8 + 4);
#pragma unroll
        for (int i = 0; i < 4; ++i) { x0[i] = b0[i]; x0[4 + i] = b1[i]; x1[i] = b0[i]; x1[4 + i] = b1[i]; }
#pragma unroll
        for (int k = 0; k < 16; ++k) { const f32x4 w0 = *(const f32x4*)(WA + k * 128 + dg * 8), w1 = *(const f32x4*)(WA + k * 128 + dg * 8 + 4);
            const float g0 = GA[(2 * jq) * 16 + k], g1 = GA[(2 * jq + 1) * 16 + k];
#pragma unroll
            for (int i = 0; i < 4; ++i) { x0[i] = fmaf(g0, w0[i], x0[i]); x0[4 + i] = fmaf(g0, w1[i], x0[4 + i]); x1[i] = fmaf(g1, w0[i], x1[i]); x1[4 + i] = fmaf(g1, w1[i], x1[4 + i]); } }
#pragma unroll
        for (int i = 0; i < 8; ++i) { x0[i] = mk::log_sigmoid_f(x0[i]) * (1.f / 16.f); x1[i] = mk::log_sigmoid_f(x1[i]) * (1.f / 16.f); }
        *(f32x4*)(LA + (2 * jq) * 128 + dg * 8) = (f32x4){x0[0], x0[1], x0[2], x0[3]}; *(f32x4*)(LA + (2 * jq) * 128 + dg * 8 + 4) = (f32x4){x0[4], x0[5], x0[6], x0[7]};
        *(f32x4*)(LA + (2 * jq + 1) * 128 + dg * 8) = (f32x4){x1[0], x1[1], x1[2], x1[3]}; *(f32x4*)(LA + (2 * jq + 1) * 128 + dg * 8 + 4) = (f32x4){x1[4], x1[5], x1[6], x1[7]};
    }
    __syncthreads();
    { const int d = tid & 127, q = tid >> 7; float run = 0.f;
#pragma unroll
      for (int j = 0; j < 16; ++j) { run += LA[(16 * q + j) * 128 + d]; LA[(16 * q + j) * 128 + d] = run; }
      TOT[q * 128 + d] = run;
      __syncthreads();
      float off = 0.f;
      for (int qq = 0; qq < q; ++qq) off += TOT[qq * 128 + d];
      if (q > 0) {
#pragma unroll
          for (int j = 0; j < 16; ++j) LA[(16 * q + j) * 128 + d] += off; }
      if (q == 3) WSP(float, A_BLAST)[chunk * 512 + h * 128 + d] = run + off; }
    __syncthreads();
#pragma unroll
    for (int rr = 0; rr < 2; ++rr) { const int j = 2 * jq + rr;
        const u32x4 qw = *(const u32x4*)(PR + (size_t)j * NP + P_GQ + h * 128 + dg * 8), kw = *(const u32x4*)(PR + (size_t)j * NP + P_GK + h * 128 + dg * 8);
        float qv[8], kv[8]; mk::unpack8(qw, qv); mk::unpack8(kw, kv);
        const f32x4 c0 = *(const f32x4*)(LA + j * 128 + dg * 8), c1 = *(const f32x4*)(LA + j * 128 + dg * 8 + 4);
#pragma unroll
        for (int i = 0; i < 8; ++i) { const float bb = i < 4 ? c0[i] : c1[i - 4]; qv[i] *= 0.08838834764831845f * __expf(bb); kv[i] *= __expf(-bb); }
        const u32x4 qo = mk::pack8f(qv), ko = mk::pack8f(kv);
        *(u32x4*)(WSP(mk::bf16_t, A_QT) + (size_t)(row0 + j) * 512 + h * 128 + dg * 8) = qo;
        *(u32x4*)(WSP(mk::bf16_t, A_KT) + (size_t)(row0 + j) * 512 + h * 128 + dg * 8) = ko;
        *(u32x4*)(Kl + v_st(j, dg * 8)) = ko; }
    __syncthreads();
    {   const int vb = (int)(uintptr_t)Vl + v_rd_base(lane) + (w >> 2) * SHM_V + (w & 3) * 512;
        const int kb = (int)(uintptr_t)Kl + v_rd_base(lane);
#define TRRDV(dst, off) asm volatile("ds_read_b64_tr_b16 %0, %1 offset:%2" : "=&v"(dst) : "v"(vb), "i"(off) : "memory")
#define TRRDK(dst, off) asm volatile("ds_read_b64_tr_b16 %0, %1 offset:%2" : "=&v"(dst) : "v"(kb), "i"(off) : "memory")
        s16x4 vl0, vl1, vl2, vl3, vh0, vh1, vh2, vh3;
        TRRDV(vl0, 0); TRRDV(vh0, 2048); TRRDV(vl1, 4096); TRRDV(vh1, 6144); TRRDV(vl2, 8192); TRRDV(vh2, 10240); TRRDV(vl3, 12288); TRRDV(vh3, 14336);
        mk::bf16_t* O = WSP(mk::bf16_t, A_KVP) + ((size_t)(chunk * 4 + h) * 256 + w * 32 + r32) * 128 + 4 * hi;
#define KV_DB(db) do { s16x4 l0, l1, l2, l3, h0, h1, h2, h3; constexpr int b_ = (db) * 512;                                                                                                       \
            TRRDK(l0, b_); TRRDK(h0, b_ + 2048); TRRDK(l1, b_ + 4096); TRRDK(h1, b_ + 6144); TRRDK(l2, b_ + 8192); TRRDK(h2, b_ + 10240); TRRDK(l3, b_ + 12288); TRRDK(h3, b_ + 14336);         \
            asm volatile("s_waitcnt lgkmcnt(0)" ::: "memory"); SBAR();                                                                                                                          \
            f32x16 c = {};                                                                                                                                                                      \
            c = __builtin_amdgcn_mfma_f32_32x32x16_bf16((bf16x8){l0[0], l0[1], l0[2], l0[3], h0[0], h0[1], h0[2], h0[3]}, (bf16x8){vl0[0], vl0[1], vl0[2], vl0[3], vh0[0], vh0[1], vh0[2], vh0[3]}, c, 0, 0, 0);   \
            c = __builtin_amdgcn_mfma_f32_32x32x16_bf16((bf16x8){l1[0], l1[1], l1[2], l1[3], h1[0], h1[1], h1[2], h1[3]}, (bf16x8){vl1[0], vl1[1], vl1[2], vl1[3], vh1[0], vh1[1], vh1[2], vh1[3]}, c, 0, 0, 0);   \
            c = __builtin_amdgcn_mfma_f32_32x32x16_bf16((bf16x8){l2[0], l2[1], l2[2], l2[3], h2[0], h2[1], h2[2], h2[3]}, (bf16x8){vl2[0], vl2[1], vl2[2], vl2[3], vh2[0], vh2[1], vh2[2], vh2[3]}, c, 0, 0, 0);   \
            c = __builtin_amdgcn_mfma_f32_32x32x16_bf16((bf16x8){l3[0], l3[1], l3[2], l3[3], h3[0], h3[1], h3[2], h3[3]}, (bf16x8){vl3[0], vl3[1], vl3[2], vl3[3], vh3[0], vh3[1], vh3[2], vh3[3]}, c, 0, 0, 0);   \
                                                                                       \
            _Pragma("unroll") for (int g_ = 0; g_ < 4; ++g_) { typedef unsigned u32x2_ __attribute__((ext_vector_type(2))); *(u32x2_*)(O + (db) * 32 + 8 * g_) = (u32x2_){cvtpk_c(c[4 * g_], c[4 * g_ + 1]), cvtpk_c(c[4 * g_ + 2], c[4 * g_ + 3])}; } } while (0)
        KV_DB(0); KV_DB(1); KV_DB(2); KV_DB(3);
#undef KV_DB
#undef TRRDV
#undef TRRDK
    }
    __syncthreads();
}
__device__ __forceinline__ void phase_prep(const Frame& F0, int l) {
    const Frame F = relaunder(F0);
    ArgsP a = get_args();
    const int v = lnd_s(F.vcu);
    for (int u = v; u < 512; u += F.G) gla_prep_unit(F, u >> 2, u & 3, l, a);
    for (int u = v; u < 136; u += F.G) if (u >= 128) fox_cumsum(F, u - 128, l, a);
    const int gw = lnd_s(F.vcu * NWAVES + F.wave), NGW = F.G * NWAVES, lane = lnd_v(F.lane);
    for (int m = gw; m < S; m += NGW) prep_row(lane, m, l, a);
}

__device__ __forceinline__ void gla_scan(const Frame& F0) {
    const Frame F = relaunder(F0);
    ArgsP a = get_args();
    typedef float f32x2 __attribute__((ext_vector_type(2)));
    const bf16_t* KVP = WSP(bf16_t, A_KVP); const float* BL = WSP(float, A_BLAST); bf16_t* SP = WSP(bf16_t, A_SPREV);
    if (F.tid < 256)
    for (int e = lnd_s(F.vcu) * 256 + lnd_v(F.tid); e < 4 * 256 * 64; e += F.G * 256) {
        const int dp = e & 63, hc = e >> 6, h = hc >> 8;
        f32x2 st = {0.f, 0.f};
#pragma unroll 32
        for (int c = 0; c < 128; ++c) {
            const size_t o = ((size_t)c * 1024 + hc) * 128 + 2 * dp;
            const unsigned kw = *(const unsigned*)(KVP + o); const f32x2 kv = {bflo(kw), bfhi(kw)}; const f32x2 bl = *(const f32x2*)(BL + c * 512 + h * 128 + 2 * dp);
            *(unsigned*)(SP + o) = cvt_pk_bf16(st.x, st.y);
            st.x = __expf(bl.x) * (st.x + kv.x); st.y = __expf(bl.y) * (st.y + kv.y);
        }
    }
}

struct EpiMlaQ {
    static constexpr bool PERM = true, AFTER_DRAIN = true;
    bf16_t* MQ; const float* g; const float* CS;
    __device__ __forceinline__ void operator()(const f32x4 (&)[2][2][4][2], const Unit&, int, int, int, int) const {}
    __device__ __forceinline__ void fused(const f32x4 (&acc)[2][2][4][2], const Unit& u, int wr, int wc, int fr, int fq, LAS unsigned char* lds, int wid, int lane) const {
        LAS float* P = (LAS float*)lds;
#pragma unroll
        for (int ai = 0; ai < 2; ++ai)
#pragma unroll
            for (int m = 0; m < 4; ++m) { float s = 0.f;
#pragma unroll
                for (int n = 0; n < 2; ++n) { const f32x4 x = acc[ai][0][m][n]; s += (x[0] * x[0] + x[1] * x[1]) + (x[2] * x[2] + x[3] * x[3]);
                    if (wc < 2) { const f32x4 y = acc[ai][1][m][n]; s += (y[0] * y[0] + y[1] * y[1]) + (y[2] * y[2] + y[3] * y[3]); } }
                s += __shfl_xor(s, 16); s += __shfl_xor(s, 32);
                if (fq == 0) P[(ai * 128 + wr * 64 + m * 16 + fr) * 4 + wc] = s; }
        asm volatile("s_waitcnt lgkmcnt(0)" ::: "memory"); __builtin_amdgcn_s_barrier(); asm volatile("" ::: "memory");
        const int h = u.pn;
        const f32x4 g0 = *(const f32x4*)(g + 32 * wc + 8 * fq), g1 = *(const f32x4*)(g + 32 * wc + 8 * fq + 4);
        f32x4 gr1 = {0.f, 0.f, 0.f, 0.f}, gr2 = gr1;
        if (wc < 2) { gr1 = *(const f32x4*)(g + 128 + 16 * wc + 4 * fq); gr2 = *(const f32x4*)(g + 160 + 16 * wc + 4 * fq); }
#pragma unroll
        for (int ai = 0; ai < 2; ++ai)
#pragma unroll
            for (int m = 0; m < 4; ++m) { const int rl = ai * 128 + wr * 64 + m * 16 + fr; const int row = u.pm * 256 + rl;
                const f32x4 pp = *(const LAS f32x4*)(P + rl * 4);
                const float r = rsqrtf(((pp.x + pp.y) + (pp.z + pp.w)) * (1.f / 192.f) + EPS);
                bf16_t* ob = MQ + ((size_t)h * S + row) * 192;
                { const f32x4 a0 = acc[ai][0][m][0] * r * g0, a1 = acc[ai][0][m][1] * r * g1;
                  u32x4 w; w.x = cvt_pk_bf16(a0[0], a0[1]); w.y = cvt_pk_bf16(a0[2], a0[3]); w.z = cvt_pk_bf16(a1[0], a1[1]); w.w = cvt_pk_bf16(a1[2], a1[3]);
                  *(u32x4*)(ob + 32 * wc + 8 * fq) = w; }
                if (wc < 2) { const f32x4 y1 = acc[ai][1][m][0] * r * gr1, y2 = acc[ai][1][m][1] * r * gr2;
                  const f32x4 c = *(const f32x4*)(CS + (size_t)row * 64 + 16 * wc + 4 * fq), sn = *(const f32x4*)(CS + (size_t)row * 64 + 32 + 16 * wc + 4 * fq);
                  const f32x4 o1 = y1 * c - y2 * sn, o2 = y2 * c + y1 * sn;
                  u32x4 w; w.x = cvt_pk_bf16(o1[0], o1[1]); w.y = cvt_pk_bf16(o1[2], o1[3]); w.z = cvt_pk_bf16(o2[0], o2[1]); w.w = cvt_pk_bf16(o2[2], o2[3]);
                  *(u32x4*)(ob + 128 + 32 * wc + 8 * fq) = w; }
                asm volatile("" ::: "memory"); }
        asm volatile("s_waitcnt lgkmcnt(0)" ::: "memory"); __builtin_amdgcn_s_barrier(); asm volatile("" ::: "memory");
    }
};
struct EpiMlaKV {
    static constexpr bool PERM = true, AFTER_DRAIN = true;
    bf16_t* MK; bf16_t* MV; const float* g; const float* KRR; const float* KRSS;
    __device__ __forceinline__ void operator()(const f32x4 (&)[2][2][4][2], const Unit&, int, int, int, int) const {}
    __device__ __forceinline__ void fused(const f32x4 (&acc)[2][2][4][2], const Unit& u, int wr, int wc, int fr, int fq, LAS unsigned char* lds, int wid, int lane) const {
        LAS float* P = (LAS float*)lds;
#pragma unroll
        for (int ai = 0; ai < 2; ++ai)
#pragma unroll
            for (int m = 0; m < 4; ++m) { float s = 0.f;
#pragma unroll
                for (int n = 0; n < 2; ++n) { const f32x4 x = acc[ai][0][m][n]; s += (x[0] * x[0] + x[1] * x[1]) + (x[2] * x[2] + x[3] * x[3]); }
                s += __shfl_xor(s, 16); s += __shfl_xor(s, 32);
                if (fq == 0) P[(ai * 128 + wr * 64 + m * 16 + fr) * 4 + wc] = s; }
        asm volatile("s_waitcnt lgkmcnt(0)" ::: "memory"); __builtin_amdgcn_s_barrier(); asm volatile("" ::: "memory");
        const int h = u.pn;
        const f32x4 g0 = *(const f32x4*)(g + 32 * wc + 8 * fq), g1 = *(const f32x4*)(g + 32 * wc + 8 * fq + 4);
#pragma unroll
        for (int ai = 0; ai < 2; ++ai)
#pragma unroll
            for (int m = 0; m < 4; ++m) { const int rl = ai * 128 + wr * 64 + m * 16 + fr; const int row = u.pm * 256 + rl;
                const f32x4 pp = *(const LAS f32x4*)(P + rl * 4);
                const float r = rsqrtf((((pp.x + pp.y) + (pp.z + pp.w)) + KRSS[row]) * (1.f / 192.f) + EPS);
                bf16_t* kb = MK + ((size_t)h * S + row) * 192; bf16_t* vb = MV + ((size_t)h * S + row) * 128;
                { const f32x4 a0 = acc[ai][0][m][0] * r * g0, a1 = acc[ai][0][m][1] * r * g1;
                  u32x4 w; w.x = cvt_pk_bf16(a0[0], a0[1]); w.y = cvt_pk_bf16(a0[2], a0[3]); w.z = cvt_pk_bf16(a1[0], a1[1]); w.w = cvt_pk_bf16(a1[2], a1[3]);
                  *(u32x4*)(kb + 32 * wc + 8 * fq) = w; }
                { const f32x4 a0 = acc[ai][1][m][0], a1 = acc[ai][1][m][1];
                  u32x4 w; w.x = cvt_pk_bf16(a0[0], a0[1]); w.y = cvt_pk_bf16(a0[2], a0[3]); w.z = cvt_pk_bf16(a1[0], a1[1]); w.w = cvt_pk_bf16(a1[2], a1[3]);
                  *(u32x4*)(vb + 32 * wc + 8 * fq) = w; }
                { const f32x4 k4 = *(const f32x4*)(KRR + (size_t)row * 64 + 16 * wc + 4 * fq) * r;
                  typedef unsigned u32x2 __attribute__((ext_vector_type(2)));
                  u32x2 w; w.x = cvt_pk_bf16(k4[0], k4[1]); w.y = cvt_pk_bf16(k4[2], k4[3]);
                  *(u32x2*)(kb + 128 + 16 * wc + 4 * fq) = w; }
                asm volatile("" ::: "memory"); }
        asm volatile("s_waitcnt lgkmcnt(0)" ::: "memory"); __builtin_amdgcn_s_barrier(); asm volatile("" ::: "memory");
    }
};

__device__ __forceinline__ void gla_out_unit(const Frame& F, char* lds, int chunk, int l, ArgsP a) {
    using namespace att;
    typedef unsigned short bf16;
    const int w = F.wave, rb = w & 1, cp = w >> 1, row0 = chunk * 64;
    char* V_lds = lds + L_V; float* RS = (float*)(lds + L_WS);
    const bf16* PR = WSP(bf16, A_PROJ) + (size_t)row0 * NP;
    const bf16* QT = WSP(bf16, A_QT) + (size_t)row0 * 512; const bf16* KT = WSP(bf16, A_KT) + (size_t)row0 * 512;
    const float* gO = a->in[12] + l * 256;
#define PK4G(P, B_, OUT) do { unsigned a0 = cvtpk_c(P[B_+0], P[B_+1]), a1 = cvtpk_c(P[B_+2], P[B_+3]); unsigned b0 = cvtpk_c(P[B_+4], P[B_+5]), b1 = cvtpk_c(P[B_+6], P[B_+7]);        \
        auto r0 = __builtin_amdgcn_permlane32_swap(a0, b0, false, false); auto r1 = __builtin_amdgcn_permlane32_swap(a1, b1, false, false); \
        u32x4 w_ = {r0[0], r1[0], r0[1], r1[1]}; OUT = *reinterpret_cast<bf16x8*>(&w_); } while (0)
    for (int h = 0; h < 4; ++h) {
        const int tid = lnd_v(F.tid), lane = tid & 63, r32 = lane & 31, hi = lane >> 5;
        const int sr = tid >> 4, sc = (tid & 15) * 8, vst0 = v_st(sr, sc), vst1 = v_st(32 + sr, sc);
        const bf16x8 v00 = load8(PR + (size_t)sr * NP + P_GV + h * 256 + sc), v01 = load8(PR + (size_t)(32 + sr) * NP + P_GV + h * 256 + sc);
        const bf16x8 v10 = load8(PR + (size_t)sr * NP + P_GV + h * 256 + 128 + sc), v11 = load8(PR + (size_t)(32 + sr) * NP + P_GV + h * 256 + 128 + sc);
        bf16x8 qf[8];
#pragma unroll
        for (int d0 = 0; d0 < 8; ++d0) qf[d0] = load8(QT + (size_t)(rb * 32 + r32) * 512 + h * 128 + d0 * 16 + hi * 8);
        f32x16 p0 = {}, p1 = {};
        {   bf16x8 kf[8];
#pragma unroll
            for (int d0 = 0; d0 < 8; ++d0) kf[d0] = load8(KT + (size_t)r32 * 512 + h * 128 + d0 * 16 + hi * 8);
#pragma unroll
            for (int d0 = 0; d0 < 8; ++d0) p0 = __builtin_amdgcn_mfma_f32_32x32x16_bf16(kf[d0], qf[d0], p0, 0, 0, 0); }
        if (rb == 1) {
            bf16x8 kf[8];
#pragma unroll
            for (int d0 = 0; d0 < 8; ++d0) kf[d0] = load8(KT + (size_t)(32 + r32) * 512 + h * 128 + d0 * 16 + hi * 8);
#pragma unroll
            for (int d0 = 0; d0 < 8; ++d0) p1 = __builtin_amdgcn_mfma_f32_32x32x16_bf16(kf[d0], qf[d0], p1, 0, 0, 0);
        }
#pragma unroll
        for (int r = 0; r < 16; ++r) { const bool keep = ((r & 3) + 8 * (r >> 2) + 4 * hi) <= r32; if (rb == 0) { if (!keep) p0[r] = 0.f; } else { if (!keep) p1[r] = 0.f; } }
        bf16x8 pa0, pa1, pa2, pa3;
        PK4G(p0, 0, pa0); PK4G(p0, 8, pa1); PK4G(p1, 0, pa2); PK4G(p1, 8, pa3);
        *(bf16x8*)(V_lds + vst0) = v00; *(bf16x8*)(V_lds + vst1) = v01; *(bf16x8*)(V_lds + SHM_V + vst0) = v10; *(bf16x8*)(V_lds + SHM_V + vst1) = v11;
        __syncthreads();
        f32x16 o[2] = {};
#pragma unroll
        for (int cbi = 0; cbi < 2; ++cbi) {
            const int cb = 2 * cp + cbi;
            const int vb = (int)(uintptr_t)V_lds + v_rd_base(lane) + (cb >> 2) * SHM_V + (cb & 3) * 512;
#define TRRDG(dst, off) asm volatile("ds_read_b64_tr_b16 %0, %1 offset:%2" : "=&v"(dst) : "v"(vb), "i"(off) : "memory")
            s16x4 l0, l1, l2, l3, h0, h1, h2, h3;
            TRRDG(l0, 0); TRRDG(h0, 2048); TRRDG(l1, 4096); TRRDG(h1, 6144); TRRDG(l2, 8192); TRRDG(h2, 10240); TRRDG(l3, 12288); TRRDG(h3, 14336);
            asm volatile("s_waitcnt lgkmcnt(0)" ::: "memory"); SBAR();
            o[cbi] = __builtin_amdgcn_mfma_f32_32x32x16_bf16(pa0, (bf16x8){l0[0], l0[1], l0[2], l0[3], h0[0], h0[1], h0[2], h0[3]}, o[cbi], 0, 0, 0);
            o[cbi] = __builtin_amdgcn_mfma_f32_32x32x16_bf16(pa1, (bf16x8){l1[0], l1[1], l1[2], l1[3], h1[0], h1[1], h1[2], h1[3]}, o[cbi], 0, 0, 0);
            o[cbi] = __builtin_amdgcn_mfma_f32_32x32x16_bf16(pa2, (bf16x8){l2[0], l2[1], l2[2], l2[3], h2[0], h2[1], h2[2], h2[3]}, o[cbi], 0, 0, 0);
            o[cbi] = __builtin_amdgcn_mfma_f32_32x32x16_bf16(pa3, (bf16x8){l3[0], l3[1], l3[2], l3[3], h3[0], h3[1], h3[2], h3[3]}, o[cbi], 0, 0, 0);
#undef TRRDG
            const bf16* SPc = WSP(bf16, A_SPREV) + ((size_t)(chunk * 4 + h) * 256 + cb * 32 + r32) * 128 + hi * 8;
            bf16x8 sf[8];
#pragma unroll
            for (int d0 = 0; d0 < 8; ++d0) sf[d0] = load8(SPc + d0 * 16);
#pragma unroll
            for (int d0 = 0; d0 < 8; ++d0) o[cbi] = __builtin_amdgcn_mfma_f32_32x32x16_bf16(qf[d0], sf[d0], o[cbi], 0, 0, 0);
        }
        float ss[16];
#pragma unroll
        for (int r = 0; r < 16; ++r) { float s = o[0][r] * o[0][r] + o[1][r] * o[1][r];
            s += __shfl_xor(s, 1); s += __shfl_xor(s, 2); s += __shfl_xor(s, 4); s += __shfl_xor(s, 8); s += __shfl_xor(s, 16); ss[r] = s; }
        if (r32 == 0) {
#pragma unroll
            for (int r = 0; r < 16; ++r) RS[(rb * 32 + crow(r, hi)) * 4 + cp] = ss[r]; }
        __syncthreads();
        float grv[16][2];
#pragma unroll
        for (int r = 0; r < 16; ++r)
#pragma unroll
            for (int cbi = 0; cbi < 2; ++cbi) grv[r][cbi] = mk::bf2f(PR[(size_t)(rb * 32 + crow(r, hi)) * NP + P_GR + h * 256 + (2 * cp + cbi) * 32 + r32]);
        const float go0 = gO[(2 * cp) * 32 + r32], go1 = gO[(2 * cp + 1) * 32 + r32];
#pragma unroll
        for (int r = 0; r < 16; ++r) { const int rr = rb * 32 + crow(r, hi); const f32x4 t = *(const f32x4*)(RS + rr * 4);
            const float rs = rsqrtf(((t.x + t.y) + (t.z + t.w)) * (1.f / 256.f) + EPS);
#pragma unroll
            for (int cbi = 0; cbi < 2; ++cbi) { const int col = (2 * cp + cbi) * 32 + r32;
                const float gr = grv[r][cbi];
                const float v = o[cbi][r] * rs * (cbi ? go1 : go0) * (gr * fast_sigmoid(gr));
                const float vn = __shfl_xor(v, 1);
                if ((r32 & 1) == 0) *(unsigned*)(WSP(bf16, A_OB) + (size_t)(row0 + rr) * 1024 + h * 256 + col) = cvtpk(v, vn); } }
    }
    __syncthreads();
#undef PK4G
}

__device__ __forceinline__ void phase_attn(const Frame& F0, unsigned char* lds_generic, int l) {
    const Frame F = relaunder(F0);
    for (int it = lnd_s((int)blockIdx.x); it < 256; it += F.G) {
        ArgsP a = get_args();
        const int h = it & 7, idx = it >> 3, mixer = idx >> 4, x = idx & 15;
        if (mixer == 0) {
            const att::HeadRef H{WSP(bf16_t, A_MQ) + (size_t)h * S * 192, WSP(bf16_t, A_MK) + (size_t)h * S * 192, WSP(bf16_t, A_MV) + (size_t)h * S * 128, WSP(bf16_t, A_OA) + h * 128, nullptr};
            att::Seam<true> Sm;
            att::prime<true>(H, x, (char*)lds_generic, Sm);
            for (int pass = 0; pass < 2; ++pass) att::block<true>(H, pass ? 31 - x : x, 31 - x, (char*)lds_generic, Sm);
        } else {
            const att::HeadRef H{WSP(bf16_t, A_FQ) + (size_t)h * S * 128, WSP(bf16_t, A_FK) + (size_t)h * S * 128, WSP(bf16_t, A_PROJ) + P_FV + h * 128, WSP(bf16_t, A_OC) + h * 128, WSP(float, A_FCUM) + (size_t)h * S};
            att::Seam<false> Sm;
            att::prime<false>(H, x, (char*)lds_generic, Sm);
            for (int pass = 0; pass < 2; ++pass) att::block<false>(H, pass ? 31 - x : x, 31 - x, (char*)lds_generic, Sm);
        }
    }
}
__device__ __forceinline__ void phase_gla_out(const Frame& F0, unsigned char* lds_generic, int l) {
    const Frame F = relaunder(F0);
    for (int it = lnd_s((int)blockIdx.x); it < 256; it += F.G) {
        ArgsP a = get_args();
        const int h = it & 7, idx = it >> 3;
        if ((idx >> 4) == 1) gla_out_unit(F, (char*)lds_generic, h * 16 + (idx & 15), l, a);
    }
}

__global__ void __launch_bounds__(NTHREADS, 2) mk_fwd(Args args_unused) {
    extern __shared__ __attribute__((aligned(16))) unsigned char lds[];
    Frame F;
    F.lds = (LAS unsigned char*)lds; F.MISC = (volatile LAS unsigned*)(F.lds + MISC_OFF);
    F.tid = threadIdx.x; F.lane = F.tid & 63; F.wave = __builtin_amdgcn_readfirstlane(F.tid >> 6);
    F.G = gridDim.x; { const int bx = blockIdx.x; F.vcu = (F.G % 8 == 0) ? (bx % 8) * (F.G / 8) + bx / 8 : bx; }
    for (int u = F.tid; u < (LDS_BYTES - LDSCTL_OFF) / 4; u += NTHREADS) ((LAS unsigned*)(F.lds + LDSCTL_OFF))[u] = 0u;
    __syncthreads();
    XcdBarrier bar;
    { ArgsP a = get_args(); F.ctl = (gu32*)(a->ws + WS_CTL); bar = xcd_barrier_post((unsigned*)(F.ctl + CW_BAR) + a->li * XCD_BAR_WORDS, F.MISC + 8); }
    int l_lo, l_hi, lo, hi, lazy;
    { ArgsP a = get_args(); const int p0 = a->pro_lo, p1 = a->pro_hi; l_lo = a->l_lo; l_hi = a->l_hi; lo = a->ph_lo; hi = a->ph_hi; lazy = a->pad;
      if (p0 == 0 && p1 > 0) rope_tables(F);
      prologue_weights(F, p0, p1);
      if (p0 == 0 && p1 > 0 && l_lo == 0 && l_hi > 0 && lo == 0) phase_rms0(F, a->in[0], WSP(bf16_t, A_XR), WSP(float, A_SSPA));
      if (p1 > p0 && l_hi > l_lo) xcd_barrier(bar); }

#define IN(k) (lo <= (k) && (k) < hi)
#define SEAM(k) do { if (!(l == l_hi - 1 && (k) == hi - 1)) xcd_barrier(bar); } while (0)
#define WB(off) ((const bf16_t*)(a->ws + WS_W + (size_t)l * WSTRIDE + (off)))
    for (int l = l_lo; l < l_hi; ++l) {
        if (IN(1)) { { ArgsP a = get_args();
            pg8::Gemm g{WSP(bf16_t, A_XR), WB(LW_WIN), S, NP, DM, DM, DM}; pg8::StaticOrder So; So.init(S, NP, lnd_s(F.G), lnd_s((int)blockIdx.x));
            { const int pm0 = first_unit_pm(NP / 256, lnd_s(F.G), lnd_s((int)blockIdx.x)); if (pm0 >= 0) fill_rstd_table(F, WSP(float, A_SSPA), pm0); }
            EpiStoreBf16 E{WSP(bf16_t, A_PROJ), NP, (const LAS float*)(F.lds + RT_OFF)};
            pg8::gemm_phase<EpiStoreBf16, pg8::StaticOrder, true, true>(F.lds + RING_OFF, g, So, E); }
            if (lazy && (int)blockIdx.x >= 256 - CV_W1) convert_slice(F, l, CV_B1, (int)blockIdx.x - (256 - CV_W1), CV_W1, CV_R1);
            SEAM(1);
        }
        if (IN(2)) { phase_prep(F, l); SEAM(2); }
        if (IN(3)) { {
            gla_scan(F);
            pg8::StaticOrder So; So.init(S, 2048, lnd_s(F.G), lnd_s((int)blockIdx.x));
            { ArgsP a = get_args(); pg8::Gemm g{WSP(bf16_t, A_CQN), WB(LW_WUQ), S, 2048, 512, 1024, 512};
              EpiMlaQ E{WSP(bf16_t, A_MQ), a->in[8] + l * 192, WSP(float, A_CS)};
              pg8::gemm_phase<EpiMlaQ, pg8::StaticOrder, false, true>(F.lds + RING_OFF, g, So, E); }
            { ArgsP a = get_args(); pg8::Gemm g{WSP(bf16_t, A_CQN) + 512, WB(LW_WUKV), S, 2048, 512, 1024, 512};
              EpiMlaKV E{WSP(bf16_t, A_MK), WSP(bf16_t, A_MV), a->in[9] + l * 192, WSP(float, A_KRR), WSP(float, A_KRSS)};
              pg8::gemm_phase<EpiMlaKV, pg8::StaticOrder, false, true>(F.lds + RING_OFF, g, So, E); } }
            SEAM(3);
        }
        if (IN(4)) { { phase_attn(F, lds + RING_OFF, l); phase_gla_out(F, lds + RING_OFF, l); }
            if (lazy && (int)blockIdx.x < CV_W4) convert_slice(F, l, CV_B4, (int)blockIdx.x, CV_W4, CV_R4);
            SEAM(4); }
        if (IN(5)) { { ArgsP a = get_args();
            BranchOrder So; So.init(lnd_s(F.G), lnd_s((int)blockIdx.x));
            pg8::Gemm g{WSP(bf16_t, A_OA), WB(LW_WBR), 3 * S, 3 * DM, 1024, 1024, 1024};
            EpiGateMergeAll E{WSP(bf16_t, A_PROJ) + P_GATES, NP, WSP(bf16_t, A_MERGED), WSP(bf16_t, A_HN), DM};
            pg8::gemm_phase<EpiGateMergeAll, BranchOrder, true, true>(F.lds + RING_OFF, g, So, E); }
            SEAM(5);
        }
        if (IN(6)) { { ArgsP a = get_args();
            pg8::Gemm g{WSP(bf16_t, A_HN), WB(LW_WOUT), S, DM, DM, DM, DM}; pg8::StaticOrder So; So.init(S, DM, lnd_s(F.G), lnd_s((int)blockIdx.x));
            EpiResidNorm E{(l == 0) ? (const void*)a->in[0] : (const void*)WSP(bf16_t, A_XR), (void*)WSP(bf16_t, A_XR), DM, WSP(float, A_SSPB), 1, (l == 0) ? 0 : 1, 1};
            pg8::gemm_phase<EpiResidNorm, pg8::StaticOrder, false, true>(F.lds + RING_OFF, g, So, E); }
            SEAM(6);
        }
        if (IN(8)) { { ArgsP a = get_args();
            pg8::Gemm g{WSP(bf16_t, A_XR), WB(LW_WGU), S, 2 * FFH, DM, DM, DM}; pg8::StaticOrder So; So.init(S, 2 * FFH, lnd_s(F.G), lnd_s((int)blockIdx.x));
            { const int pm0 = first_unit_pm(2 * FFH / 256, lnd_s(F.G), lnd_s((int)blockIdx.x)); if (pm0 >= 0) fill_rstd_table(F, WSP(float, A_SSPB), pm0); }
            EpiSwiglu E{WSP(bf16_t, A_PROJ), FFH, (const LAS float*)(F.lds + RT_OFF)};
            pg8::gemm_phase<EpiSwiglu, pg8::StaticOrder, true, true>(F.lds + RING_OFF, g, So, E); }
            if (lazy && (int)blockIdx.x >= 256 - CV_W8) convert_slice(F, l + 1, CV_B8, (int)blockIdx.x - (256 - CV_W8), CV_W8, CV_R8);
            SEAM(8);
        }
        if (IN(9)) { { ArgsP a = get_args();
            pg8::Gemm g{WSP(bf16_t, A_PROJ), WB(LW_WDN), S, DM, FFH, FFH, FFH}; pg8::StaticOrder So; So.init(S, DM, lnd_s(F.G), lnd_s((int)blockIdx.x));
            EpiResidNorm E{(const void*)WSP(bf16_t, A_XR), (l + 1 < DEPTH) ? (void*)WSP(bf16_t, A_XR) : (void*)a->out, DM, WSP(float, A_SSPA), (l + 1 < DEPTH) ? 1 : 0, 1, (l + 1 < DEPTH) ? 1 : 0};
            pg8::gemm_phase<EpiResidNorm, pg8::StaticOrder, false, true>(F.lds + RING_OFF, g, So, E); }
            SEAM(9);
        }
    }
#undef IN
#undef SEAM
}

}

extern "C" void kernel_launch(void* const* d_in, const int* in_sizes, int n_in, void* d_out, int out_size, void* d_ws, size_t ws_size, hipStream_t stream) {
    static int grid = 0;
    if (grid == 0) {
        int dev = 0, cus = 0;
        if (n_in != 21 || out_size != S * DM || ws_size < mk::A_END) { fprintf(stderr, "kernel_launch: unexpected shapes / workspace (%d inputs, out %d, ws %zu < %zu)\n", n_in, out_size, ws_size, (size_t)mk::A_END); grid = -1; return; }
        if (hipGetDevice(&dev) != hipSuccess || hipDeviceGetAttribute(&cus, hipDeviceAttributeMultiprocessorCount, dev) != hipSuccess) { grid = -1; return; }
        if (hipFuncSetAttribute((const void*)mk::mk_fwd, hipFuncAttributeMaxDynamicSharedMemorySize, mk::LDS_BYTES) != hipSuccess) { fprintf(stderr, "hipFuncSetAttribute failed\n"); grid = -1; return; }
        int per_cu = 0;
        if (hipOccupancyMaxActiveBlocksPerMultiprocessor(&per_cu, (const void*)mk::mk_fwd, mk::NTHREADS, mk::LDS_BYTES) != hipSuccess || per_cu < 1) { fprintf(stderr, "occupancy query: %d blocks per CU\n", per_cu); (void)hipGetLastError(); }
        grid = cus;
        if (cus != 256) { fprintf(stderr, "kernel_launch: this kernel's unit deal (one 256x256 unit per workgroup in the N = 2048 GEMM phases, one row panel per workgroup in the wide ones) needs exactly 256 CUs, found %d\n", cus); grid = -1; return; }
    }
    if (grid < 0) return;
    (void)hipMemsetAsync((unsigned char*)d_ws + mk::WS_CTL, 0, mk::CTL_ZERO_BYTES, stream);
    mk::Args a{};
    for (int i = 0; i < 21; ++i) a.in[i] = (const float*)d_in[i];
    a.out = (float*)d_out; a.ws = (unsigned char*)d_ws;
    const int lazy = (grid == 256) ? 1 : 0;
    a.pro_lo = 0; a.pro_hi = lazy ? 1 : DEPTH; a.l_lo = 0; a.l_hi = DEPTH; a.ph_lo = 0; a.ph_hi = 10; a.li = 0; a.pad = lazy;
    mk::mk_fwd<<<dim3(grid), mk::NTHREADS, mk::LDS_BYTES, stream>>>(a);
}
```
